# Optimizing an MI355X kernel written in HIP

```python
import jax, jax.numpy as jnp
from jax import lax
import numpy as np

D_MODEL = 2048
BATCH = 2
SEQ = 8192
DEPTH = 1

CHUNK = 64
M_WIDTH = D_MODEL // 2
R_WIDTH = D_MODEL - M_WIDTH
M_HEADS = 4
M_HEAD_DIM = M_WIDTH // M_HEADS
R_BLOCKS = 8
R_BLOCK_DIM = R_WIDTH // R_BLOCKS
CONV_WIDTH = 4
LRU_C = 8.0
N_GROUPS = 4
EXPERTS_PER_GROUP = 8
N_EXPERTS = N_GROUPS * EXPERTS_PER_GROUP
TOP_K = 2
D_EXPERT = D_MODEL // 4
MOE_BLOCK = 128
EPS = 1e-6
IN_SPLITS = [M_WIDTH, M_WIDTH, M_WIDTH, M_WIDTH, M_HEADS, M_HEADS, R_WIDTH, R_WIDTH]
IN_WIDTH = sum(IN_SPLITS)

kernel_name = 'hybrid_mlstm_rglru_hmoe_block'


def rmsnorm(x):
    x32 = x.astype(jnp.float32)
    return (x32 * lax.rsqrt(jnp.mean(x32 * x32, axis=-1, keepdims=True) + EPS)).astype(x.dtype)


def causal_dwconv(x, w):
    return lax.conv_general_dilated(
        x, w[:, None, :].astype(x.dtype), window_strides=(1,),
        padding=[(CONV_WIDTH - 1, 0)], dimension_numbers=('NWC', 'WIO', 'NWC'),
        feature_group_count=x.shape[-1])


def mlstm_chunkwise(q, k, v, ig, lf):
    B, S, H, Dh = q.shape
    nc = S // CHUNK

    def to_chunks(t):
        t = t.reshape((B, nc, CHUNK, H) + t.shape[3:])
        return jnp.moveaxis(t, (1, 3), (0, 2))

    causal = jnp.tril(jnp.ones((CHUNK, CHUNK), dtype=bool))

    def step(carry, xs):
        C, n, m = carry
        qc, kc, vc, ic, fc = xs
        b = jnp.cumsum(fc, axis=-1)
        b_last = b[..., -1]
        dmat = b[..., :, None] - b[..., None, :] + ic[..., None, :]
        dmat = jnp.where(causal, dmat, -jnp.inf)
        inter = b + m[..., None]
        m_t = jnp.maximum(inter, jnp.max(dmat, axis=-1))
        s = jnp.einsum('bhtd,bhsd->bhts', qc, kc) * jnp.exp(dmat - m_t[..., None])
        e_inter = jnp.exp(inter - m_t)
        num = jnp.einsum('bhts,bhse->bhte', s, vc) + e_inter[..., None] * jnp.einsum('bhtd,bhde->bhte', qc, C)
        den = jnp.sum(s, axis=-1) + e_inter * jnp.einsum('bhtd,bhd->bht', qc, n)
        h = num / jnp.maximum(jnp.abs(den), jnp.exp(-m_t))[..., None]
        g = b_last[..., None] - b + ic
        m_new = jnp.maximum(b_last + m, jnp.max(g, axis=-1))
        wk = jnp.exp(g - m_new[..., None])
        decay = jnp.exp(b_last + m - m_new)
        kw = kc * wk[..., None]
        C_new = decay[..., None, None] * C + jnp.einsum('bhsd,bhse->bhde', kw, vc)
        n_new = decay[..., None] * n + jnp.sum(kw, axis=2)
        return (C_new, n_new, m_new), h

    init = (jnp.zeros((B, H, Dh, Dh), jnp.float32), jnp.zeros((B, H, Dh), jnp.float32),
            jnp.zeros((B, H), jnp.float32))
    _, hs = lax.scan(step, init, (to_chunks(q), to_chunks(k), to_chunks(v), to_chunks(ig), to_chunks(lf)))
    return jnp.moveaxis(hs, (0, 2), (1, 3)).reshape(B, S, H, Dh)


def lru_combine(e1, e2):
    a1, b1 = e1
    a2, b2 = e2
    return a1 * a2, a2 * b1 + b2


def hybrid_mixer(h, w_in, b_gates, conv_qk, mh_norm_g, lru_conv_w, lru_conv_b, w_lru_a, b_lru_a,
                 w_lru_x, b_lru_x, lru_lambda, lru_norm_g, w_out):
    B, S, _ = h.shape
    proj = h @ w_in
    q_raw, k_raw, v_raw, o_raw, i_raw, f_raw, xr_raw, gr_raw = jnp.split(
        proj, list(np.cumsum(IN_SPLITS)[:-1]), axis=-1)

    qk = jax.nn.silu(causal_dwconv(jnp.concatenate([q_raw, k_raw], axis=-1), conv_qk)).astype(jnp.float32)
    q = qk[..., :M_WIDTH].reshape(B, S, M_HEADS, M_HEAD_DIM)
    k = qk[..., M_WIDTH:].reshape(B, S, M_HEADS, M_HEAD_DIM) * (M_HEAD_DIM ** -0.5)
    v = v_raw.astype(jnp.float32).reshape(B, S, M_HEADS, M_HEAD_DIM)
    ig = i_raw.astype(jnp.float32) + b_gates[:M_HEADS]
    lf = jax.nn.log_sigmoid(f_raw.astype(jnp.float32) + b_gates[M_HEADS:])
    hm = mlstm_chunkwise(q, k, v, ig, lf)
    hm = hm * lax.rsqrt(jnp.mean(hm * hm, axis=-1, keepdims=True) + EPS)
    ym = hm.reshape(B, S, M_WIDTH) * mh_norm_g * jax.nn.sigmoid(o_raw.astype(jnp.float32))

    xr = (causal_dwconv(xr_raw, lru_conv_w) + lru_conv_b).astype(jnp.float32)
    xb = xr.reshape(B, S, R_BLOCKS, R_BLOCK_DIM)
    r_gate = jax.nn.sigmoid(jnp.einsum('bsnc,ncd->bsnd', xb, w_lru_a).reshape(B, S, R_WIDTH) + b_lru_a)
    i_gate = jax.nn.sigmoid(jnp.einsum('bsnc,ncd->bsnd', xb, w_lru_x).reshape(B, S, R_WIDTH) + b_lru_x)
    log_a = LRU_C * r_gate * jax.nn.log_sigmoid(lru_lambda.astype(jnp.float32))
    a = jnp.exp(log_a)
    u = jnp.sqrt(-jnp.expm1(2.0 * log_a)) * (i_gate * xr)
    _, hr = lax.associative_scan(lru_combine, (a, u), axis=1)
    yr = hr * jax.nn.gelu(gr_raw.astype(jnp.float32))
    yr = yr.reshape(B, S, R_BLOCKS, R_BLOCK_DIM)
    yr = (yr * lax.rsqrt(jnp.mean(yr * yr, axis=-1, keepdims=True) + EPS)).reshape(B, S, R_WIDTH) * lru_norm_g

    return jnp.concatenate([ym, yr], axis=-1).astype(h.dtype) @ w_out


def hier_moe(xt, w_group, b_group, w_router, b_router, w_e_gate, w_e_up, w_e_down):
    n_tok, d = xt.shape
    xf = xt.astype(jnp.float32)
    p_group = jax.nn.softmax(xf @ w_group + b_group, axis=-1)
    pg_sel, g_sel = lax.top_k(p_group, 1)
    e_logits = (xf @ w_router + b_router).reshape(n_tok, N_GROUPS, EXPERTS_PER_GROUP)
    idx = jnp.broadcast_to(g_sel[:, :, None], (n_tok, 1, EXPERTS_PER_GROUP))
    e_logits = jnp.take_along_axis(e_logits, idx, axis=1)[:, 0]
    pe_sel, e_sel = lax.top_k(jax.nn.softmax(e_logits, axis=-1), TOP_K)
    gate_w = pg_sel * pe_sel / jnp.sum(pe_sel, axis=-1, keepdims=True)
    expert_id = g_sel * EXPERTS_PER_GROUP + e_sel

    m = n_tok * TOP_K
    eid = expert_id.reshape(m)
    tok = jnp.repeat(jnp.arange(n_tok, dtype=jnp.int32), TOP_K)
    wts = gate_w.reshape(m)
    order = jnp.argsort(eid)
    eid_s, tok_s, w_s = eid[order], tok[order], wts[order]
    counts = jnp.bincount(eid, length=N_EXPERTS)
    starts = jnp.cumsum(counts) - counts
    padded = (counts + MOE_BLOCK - 1) // MOE_BLOCK * MOE_BLOCK
    pend = jnp.cumsum(padded)
    pstart = pend - padded
    dest = pstart[eid_s] + jnp.arange(m, dtype=jnp.int32) - starts[eid_s]
    n_slots = -(-m // MOE_BLOCK) * MOE_BLOCK + N_EXPERTS * MOE_BLOCK
    n_blocks = n_slots // MOE_BLOCK
    slot_tok = jnp.zeros((n_slots,), jnp.int32).at[dest].set(tok_s)
    slot_w = jnp.zeros((n_slots,), jnp.float32).at[dest].set(w_s)
    block_e = jnp.minimum(
        jnp.searchsorted(pend, jnp.arange(n_blocks, dtype=pend.dtype) * MOE_BLOCK, side='right'),
        N_EXPERTS - 1)

    def expert_block(args):
        toks, wb, e = args
        xb = xt[toks]
        hb = jax.nn.silu(xb @ w_e_gate[e]) * (xb @ w_e_up[e])
        return (hb @ w_e_down[e]).astype(jnp.float32) * wb[:, None]

    yb = lax.map(expert_block, (slot_tok.reshape(n_blocks, MOE_BLOCK),
                                slot_w.reshape(n_blocks, MOE_BLOCK), block_e))
    return jnp.zeros((n_tok, d), jnp.float32).at[slot_tok].add(yb.reshape(n_slots, d))


def setup_inputs(seed: int = 0) -> dict:
    key = jax.random.key(seed)
    ks = jax.random.split(key, 32)
    L, D, H = DEPTH, D_MODEL, M_HEADS
    nrm = lambda k, shape, s: jax.random.normal(k, shape, jnp.float32) * s
    u = jax.random.uniform(ks[14], (L, R_WIDTH), jnp.float32, minval=0.9, maxval=0.999)
    b_gates = jnp.concatenate([
        nrm(ks[4], (L, H), 0.1),
        jnp.broadcast_to(jnp.linspace(3.0, 6.0, H, dtype=jnp.float32), (L, H)) + nrm(ks[5], (L, H), 0.1)], axis=-1)
    return {
        'x': nrm(ks[0], (BATCH, SEQ, D), 1.0),
        'c': nrm(ks[1], (BATCH, D), 1.0),
        'w_ada': nrm(ks[2], (L, D, 6 * D), D ** -0.5),
        'b_ada': nrm(ks[3], (L, 6 * D), 0.02),
        'w_in': nrm(ks[6], (L, D, IN_WIDTH), D ** -0.5),
        'b_gates': b_gates,
        'conv_qk': nrm(ks[7], (L, CONV_WIDTH, 2 * M_WIDTH), CONV_WIDTH ** -0.5),
        'mh_norm_g': 1.0 + nrm(ks[8], (L, M_WIDTH), 0.02),
        'lru_conv_w': nrm(ks[9], (L, CONV_WIDTH, R_WIDTH), CONV_WIDTH ** -0.5),
        'lru_conv_b': nrm(ks[10], (L, R_WIDTH), 0.02),
        'w_lru_a': nrm(ks[11], (L, R_BLOCKS, R_BLOCK_DIM, R_BLOCK_DIM), R_BLOCK_DIM ** -0.5),
        'b_lru_a': nrm(ks[12], (L, R_WIDTH), 0.02),
        'w_lru_x': nrm(ks[13], (L, R_BLOCKS, R_BLOCK_DIM, R_BLOCK_DIM), R_BLOCK_DIM ** -0.5),
        'b_lru_x': nrm(ks[15], (L, R_WIDTH), 0.02),
        'lru_lambda': jnp.log(u) - jnp.log1p(-u),
        'lru_norm_g': 1.0 + nrm(ks[16], (L, R_WIDTH), 0.02),
        'w_out': nrm(ks[17], (L, D, D), D ** -0.5),
        'w_group': nrm(ks[18], (L, D, N_GROUPS), D ** -0.5),
        'b_group': nrm(ks[19], (L, N_GROUPS), 0.01),
        'w_router': nrm(ks[20], (L, D, N_EXPERTS), D ** -0.5),
        'b_router': nrm(ks[21], (L, N_EXPERTS), 0.01),
        'w_e_gate': nrm(ks[22], (L, N_EXPERTS, D, D_EXPERT), D ** -0.5),
        'w_e_up': nrm(ks[23], (L, N_EXPERTS, D, D_EXPERT), D ** -0.5),
        'w_e_down': nrm(ks[24], (L, N_EXPERTS, D_EXPERT, D), D_EXPERT ** -0.5),
        'final_g': 1.0 + nrm(ks[25], (D,), 0.02),
    }


def reference(x, c, w_ada, b_ada, w_in, b_gates, conv_qk, mh_norm_g, lru_conv_w, lru_conv_b,
              w_lru_a, b_lru_a, w_lru_x, b_lru_x, lru_lambda, lru_norm_g, w_out, w_group, b_group,
              w_router, b_router, w_e_gate, w_e_up, w_e_down, final_g):
    B, S, D = x.shape
    for l in range(DEPTH):
        mod = jax.nn.silu(c) @ w_ada[l] + b_ada[l]
        sh1, sc1, g1, sh2, sc2, g2 = jnp.split(mod, 6, axis=-1)
        hn = rmsnorm(x) * (1.0 + sc1[:, None]) + sh1[:, None]
        mix = hybrid_mixer(hn, w_in[l], b_gates[l], conv_qk[l], mh_norm_g[l], lru_conv_w[l], lru_conv_b[l],
                           w_lru_a[l], b_lru_a[l], w_lru_x[l], b_lru_x[l], lru_lambda[l], lru_norm_g[l], w_out[l])
        x = x + (g1[:, None] * mix).astype(x.dtype)
        hn = rmsnorm(x) * (1.0 + sc2[:, None]) + sh2[:, None]
        y = hier_moe(hn.reshape(B * S, D), w_group[l], b_group[l], w_router[l], b_router[l],
                     w_e_gate[l], w_e_up[l], w_e_down[l]).reshape(B, S, D)
        x = x + (g2[:, None] * y).astype(x.dtype)
    return rmsnorm(x) * final_g
```

```cpp
#define DBG_STAGE 0
#define N_LAUNCHES 1
#define DBG_RAW -1
#include <hip/hip_runtime.h>
#include <hip/hip_cooperative_groups.h>
#include <cstdio>
#include <cstdint>
#include <cmath>
#define LAS __attribute__((address_space(3)))
#define GAS __attribute__((address_space(1)))
typedef unsigned short bf16_t;
typedef short bf16x8 __attribute__((ext_vector_type(8)));
typedef float f32x4 __attribute__((ext_vector_type(4)));
typedef float f32x2 __attribute__((ext_vector_type(2)));
typedef float f32x16 __attribute__((ext_vector_type(16)));
typedef unsigned u32x4 __attribute__((ext_vector_type(4)));
typedef unsigned u32x2 __attribute__((ext_vector_type(2)));

__device__ __forceinline__ unsigned f2bf(float f) { unsigned u = __builtin_bit_cast(unsigned, f); return (u + 0x7fffu + ((u >> 16) & 1u)) >> 16; }
__device__ __forceinline__ unsigned pk2(float lo, float hi) { return f2bf(lo) | (f2bf(hi) << 16); }
__device__ __forceinline__ float bflo(unsigned u) { return __builtin_bit_cast(float, u << 16); }
__device__ __forceinline__ float bfhi(unsigned u) { return __builtin_bit_cast(float, u & 0xffff0000u); }
__device__ __forceinline__ float bf1(bf16_t b) { return __builtin_bit_cast(float, (unsigned)b << 16); }
__device__ __forceinline__ float wave_sum(float v) {
#pragma unroll
    for (int o = 1; o < 64; o <<= 1) v += __shfl_xor(v, o);
    return v;
}
__device__ __forceinline__ float frcp(float x) { return __builtin_amdgcn_rcpf(x); }
__device__ __forceinline__ float fsigmoid(float x) { return frcp(1.f + __expf(-x)); }
__device__ __forceinline__ float fsilu(float x) { return x * frcp(1.f + __expf(-x)); }
__device__ __forceinline__ float flogsigmoid(float x) { return fminf(x, 0.f) - log1pf(expf(-fabsf(x))); }
__device__ __forceinline__ float fgelu_tanh(float x) { const float u = 0.7978845608028654f * (x + 0.044715f * x * x * x); const float e = __expf(2.f * u); const float th = 1.f - 2.f * frcp(e + 1.f); return 0.5f * x * (1.f + th); }
template <int CTRL, int ROW_MASK> __device__ __forceinline__ float dpp_add(float x) { const int v = __builtin_amdgcn_update_dpp(0, __builtin_bit_cast(int, x), CTRL, ROW_MASK, 0xf, true); return x + __builtin_bit_cast(float, v); }
__device__ __forceinline__ float half_sum31(float x) {
    x = dpp_add<0x111, 0xf>(x);
    x = dpp_add<0x112, 0xf>(x);
    x = dpp_add<0x114, 0xf>(x);
    x = dpp_add<0x118, 0xf>(x);
    x = dpp_add<0x142, 0xa>(x);
    return x;
}

namespace pg8 {
constexpr int BM = 256, BK = 64, HALF = 128, HTB = HALF * BK * 2  , STAGE_BYTES = 8 * HTB, NXCD = 8, WGM = 8;
__host__ __device__ __forceinline__ int lds_byte(int r, int c) { const int st = (r >> 4) * 2 + (c >> 5), rr = r & 15, cc = c & 31, ob = rr * 64 + cc * 2; return st * 1024 + (ob ^ (((ob >> 9) & 1) << 5)); }
__host__ __device__ __forceinline__ void stage_rc(int b, int& R, int& C) { const int st = b / 1024, sb = b % 1024, swz = sb ^ (((sb >> 9) & 1) << 5); R = (st >> 1) * 16 + swz / 64; C = (st & 1) * 32 + (swz % 64) / 2; }
__host__ __device__ __forceinline__ int perm32(int rho) { const int n = rho >> 4, i = rho & 15; return 8 * (i >> 2) + 4 * n + (i & 3); }

struct Unit { int pm, pn, e, mt; };

template <class Epi, class Sched>
__device__ __forceinline__ void gemm_phase(LAS unsigned char* lds, const int K, const Sched& S, const Epi& E) {
    int tid_o = threadIdx.x; asm volatile("" : "+v"(tid_o));
    const int tid = tid_o, wid = __builtin_amdgcn_readfirstlane(tid >> 6), lane = tid & 63, wr = wid >> 2, wc = wid & 3, fr = lane & 15, fq = lane >> 4;
    const int nt = K / BK;
    int Rr[2], Cc[2]; unsigned voffB[2];
#pragma unroll
    for (int i = 0; i < 2; ++i) { stage_rc(tid * 16 + i * 8192, Rr[i], Cc[i]); const int Rb = Epi::PERM ? ((Rr[i] & ~31) + perm32(Rr[i] & 31)) : Rr[i]; voffB[i] = (unsigned)(Rb * K + Cc[i]) * 2u; }
    const size_t kstep = (size_t)(BK * 2);
    const size_t hstep = (size_t)HALF * K * 2;
    const unsigned ldsw = (unsigned)wid * 1024u;
    const int aoff = lds_byte(wr * 64 + fr, fq * 8), boff = lds_byte(wc * 32 + fr, fq * 8);
#define PG8_SA(b, h) (((b) * 2 + (h)) * HTB)
#define PG8_SB(b, h) ((4 + (b) * 2 + (h)) * HTB)
#define PG8_STAGE(bufoff, gbase, voff) do { const char* _gb = (const char*)(gbase); asm volatile("" : "+s"(_gb));     \
        _Pragma("unroll") for (int _i = 0; _i < 2; ++_i) \
        __builtin_amdgcn_global_load_lds((const unsigned*)(_gb + (voff)[_i]), (LAS unsigned*)(lds + (bufoff) + ldsw + _i * 8192), 16, 0, 0); } while (0)
#define PG8_LDA(dst, b, h) do { _Pragma("unroll") for (int m = 0; m < 4; ++m) _Pragma("unroll") for (int k = 0; k < 2; ++k) dst[m][k] = *(const LAS bf16x8*)(lds + PG8_SA(b, h) + aoff + m * 2048 + k * 1024); } while (0)
#define PG8_LDB(dst, b, h) do { _Pragma("unroll") for (int n = 0; n < 2; ++n) _Pragma("unroll") for (int k = 0; k < 2; ++k) dst[n][k] = *(const LAS bf16x8*)(lds + PG8_SB(b, h) + boff + n * 2048 + k * 1024); } while (0)
#define PG8_MMA(ai, bj, At, Bt) do { __builtin_amdgcn_s_setprio(1); _Pragma("unroll") for (int m = 0; m < 4; ++m) _Pragma("unroll") for (int n = 0; n < 2; ++n) _Pragma("unroll") for (int k = 0; k < 2; ++k) \
        acc[ai][bj][m][n] = __builtin_amdgcn_mfma_f32_16x16x32_bf16(Bt[n][k], At[m][k], acc[ai][bj][m][n], 0, 0, 0); __builtin_amdgcn_s_setprio(0); } while (0)
#define PG8_WAIT_V(n) asm volatile("s_waitcnt vmcnt(" #n ")" ::: "memory")
#define PG8_WAIT_L(n) asm volatile("s_waitcnt lgkmcnt(" #n ")" ::: "memory")
#define PG8_BAR __builtin_amdgcn_s_barrier()
#define PG8_SCHED __builtin_amdgcn_sched_barrier(0)
    Unit cur, nxt; int ui = 0;
    if (!S.next(0, cur)) return;
    f32x4 acc[2][2][4][2];
#pragma unroll
    for (int a = 0; a < 2; ++a)
#pragma unroll
        for (int b = 0; b < 2; ++b)
#pragma unroll
            for (int m = 0; m < 4; ++m)
#pragma unroll
                for (int n = 0; n < 2; ++n) acc[a][b][m][n] = (f32x4){0.f, 0.f, 0.f, 0.f};
    bf16x8 At[4][2], B0[2][2], B1[2][2];
    unsigned vA[2][2], nvA[2][2];
    typename Epi::State est; E.pre(est, cur, wr, fr);
    S.a_off(cur, Rr, Cc, K, vA);
    const char* cA = S.a_base(cur); const char* cB = S.b_base(cur);
    PG8_STAGE(PG8_SB(0, 0), cB, voffB); PG8_STAGE(PG8_SB(0, 1), cB + hstep, voffB); PG8_STAGE(PG8_SA(0, 0), cA, vA[0]); PG8_STAGE(PG8_SA(0, 1), cA, vA[1]);
    if (wr == 1) PG8_BAR;
    PG8_WAIT_V(2); PG8_BAR;
    PG8_STAGE(PG8_SB(1, 0), cB + kstep, voffB); PG8_STAGE(PG8_SA(1, 0), cA + kstep, vA[0]); PG8_STAGE(PG8_SB(1, 1), cB + hstep + kstep, voffB);
    PG8_WAIT_V(6); PG8_BAR;
    for (;;) {
        const bool has_next = S.next(ui + 1, nxt);
        if (!has_next) nxt = cur;
        const char* nA = S.a_base(nxt); const char* nB = S.b_base(nxt);
        S.a_off(nxt, Rr, Cc, K, nvA);
        for (int t = 0; t < nt; t += 2) {
            const bool last = (t == nt - 2);
            const char* a1 = cA + (size_t)(t + 1) * kstep;
            const char* a2 = last ? nA : cA + (size_t)(t + 2) * kstep; const char* b2 = last ? nB : cB + (size_t)(t + 2) * kstep;
            const char* a3 = a2 + kstep; const char* b3 = b2 + kstep;
            unsigned w0[2], w1[2];
#pragma unroll
            for (int i = 0; i < 2; ++i) { w0[i] = last ? nvA[0][i] : vA[0][i]; w1[i] = last ? nvA[1][i] : vA[1][i]; }
            PG8_LDB(B0, 0, 0); PG8_LDB(B1, 0, 1); PG8_SCHED; PG8_LDA(At, 0, 0); PG8_STAGE(PG8_SA(1, 1), a1, vA[1]);
            PG8_WAIT_V(8); PG8_WAIT_L(0); PG8_BAR; PG8_MMA(0, 0, At, B0); PG8_MMA(0, 1, At, B1); PG8_BAR; PG8_SCHED;
            PG8_LDA(At, 0, 1); PG8_STAGE(PG8_SB(0, 0), b2, voffB); PG8_STAGE(PG8_SB(0, 1), b2 + hstep, voffB); PG8_STAGE(PG8_SA(0, 0), a2, w0);
            PG8_WAIT_V(8); PG8_WAIT_L(0); PG8_BAR; PG8_MMA(1, 0, At, B0); PG8_MMA(1, 1, At, B1); PG8_BAR; PG8_SCHED;
            PG8_LDB(B0, 1, 0); PG8_LDB(B1, 1, 1); PG8_SCHED; PG8_LDA(At, 1, 0); PG8_STAGE(PG8_SA(0, 1), a2, w1);
            PG8_WAIT_V(8); PG8_WAIT_L(0); PG8_BAR; PG8_MMA(0, 0, At, B0); PG8_MMA(0, 1, At, B1); PG8_BAR; PG8_SCHED;
            PG8_LDA(At, 1, 1); PG8_STAGE(PG8_SB(1, 0), b3, voffB); PG8_STAGE(PG8_SB(1, 1), b3 + hstep, voffB); PG8_STAGE(PG8_SA(1, 0), a3, w0);
            PG8_WAIT_V(8); PG8_WAIT_L(0); PG8_BAR; PG8_MMA(1, 0, At, B0); PG8_MMA(1, 1, At, B1); PG8_BAR; PG8_SCHED;
        }
        if (wr == 0) PG8_BAR;
        E(acc, cur, wr, wc, fr, fq, est);
        if (!has_next) break;
#pragma unroll
        for (int a = 0; a < 2; ++a)
#pragma unroll
            for (int b = 0; b < 2; ++b)
#pragma unroll
                for (int m = 0; m < 4; ++m)
#pragma unroll
                    for (int n = 0; n < 2; ++n) acc[a][b][m][n] = (f32x4){0.f, 0.f, 0.f, 0.f};
        cur = nxt; cA = nA; cB = nB; ++ui; E.pre(est, cur, wr, fr);
#pragma unroll
        for (int h = 0; h < 2; ++h)
#pragma unroll
            for (int i = 0; i < 2; ++i) vA[h][i] = nvA[h][i];
        if (wr == 1) PG8_BAR;
    }
    PG8_WAIT_V(0);
    PG8_BAR;
#undef PG8_SA
#undef PG8_SB
#undef PG8_STAGE
#undef PG8_LDA
#undef PG8_LDB
#undef PG8_MMA
#undef PG8_WAIT_V
#undef PG8_WAIT_L
#undef PG8_BAR
#undef PG8_SCHED
}
}
namespace fk {
constexpr int T = 16384, SEQ = 8192, DM = 2048, NPROJ = 6144, INW = 6152;
constexpr float EPS = 1e-6f;
constexpr size_t MiB = 1u << 20, KiB = 1u << 10;
constexpr size_t WS_CTL = 0, WS_DONE = 1024, WS_BAR = 4096, CTL_ZERO_BYTES = 32768;
constexpr size_t WS_MODP = 1 * MiB;
constexpr size_t WS_MOD = 2 * MiB;
constexpr size_t WS_WG8 = 2 * MiB + 256 * KiB;
constexpr size_t WS_WRH = 2 * MiB + 512 * KiB, WS_WRL = WS_WRH + 192 * KiB;
constexpr size_t WS_GTB = 3 * MiB, WS_GTW = 3 * MiB + 256 * KiB, WS_GTA = 3 * MiB + 512 * KiB;
constexpr size_t WS_BLAST = 3 * MiB + 768 * KiB, WS_ALAST = WS_BLAST + 4 * KiB, WS_DTOT = WS_BLAST + 8 * KiB, WS_CVEC = WS_BLAST + 9 * KiB;
constexpr size_t WS_LNS = 4 * MiB;
constexpr size_t WS_LRUA = 4 * MiB + 256 * KiB, WS_LRUH = 4 * MiB + 512 * KiB, WS_LRUC = 4 * MiB + 768 * KiB;
constexpr size_t WS_ROUTE = 5 * MiB;
constexpr size_t WS_LIST = 6 * MiB;
constexpr size_t WS_LW = 2 * MiB + 896 * KiB;
constexpr size_t WS_LISTW = 553 * MiB;
constexpr size_t WS_WLRU = 8 * MiB;
constexpr size_t WS_WIN = 9 * MiB;
constexpr size_t WS_WOUT = 33 * MiB;
constexpr size_t WS_WGU = 41 * MiB;
constexpr size_t WS_WDN = 169 * MiB;
constexpr size_t WS_HN = 233 * MiB;
constexpr size_t WS_PROJ = 297 * MiB;
constexpr size_t WS_HEXP = WS_PROJ, WS_YS = WS_PROJ + 40 * MiB;
constexpr size_t WS_LST = 489 * MiB;
constexpr size_t WS_X1B = WS_LST;
constexpr size_t WS_HLOC = 555 * MiB, WS_ACUM = 587 * MiB;
constexpr size_t WS_END = 619 * MiB;
constexpr int LDS_BYTES = 163840;
constexpr int L_CTL = 160 * 1024 - 1024;

struct Args { const float* in[25]; float* out; unsigned char* ws; int ph_lo, ph_hi; };
enum { I_X = 0, I_C, I_WADA, I_BADA, I_WIN, I_BGATES, I_CONVQK, I_MHG, I_LCW, I_LCB, I_WLA, I_BLA, I_WLX, I_BLX, I_LAM, I_LNG, I_WOUT, I_WGRP, I_BGRP, I_WRT, I_BRT, I_WEG, I_WEU, I_WED, I_FG };

#define LDS_WAIT() asm volatile("s_waitcnt lgkmcnt(0)" ::: "memory")
#define NT_LD(p) __builtin_nontemporal_load(p)
#define NT_ST(v, p) __builtin_nontemporal_store(v, p)
__device__ __forceinline__ void wt_st16(void* p, u32x4 v) { asm volatile("global_store_dwordx4 %0, %1, off sc1\n\ts_nop 1" :: "v"(p), "v"(v)); }
#define WT_ST(v, p) wt_st16((void*)(p), (v))
typedef __bf16 bf16x2_t __attribute__((ext_vector_type(2)));
__device__ __forceinline__ unsigned cvtpk(float lo, float hi) { f32x2 v = {lo, hi}; bf16x2_t b = __builtin_convertvector(v, bf16x2_t); return __builtin_bit_cast(unsigned, b); }

__device__ __forceinline__ void tr_item(const float* __restrict__ W, int ldw, int k0, int n0src, bf16_t* WT, int ldt, int rowdst0, LAS float* scr, int lane) {
    f32x4 v[16];
#pragma unroll
    for (int i = 0; i < 16; ++i) v[i] = NT_LD((const f32x4*)(W + (size_t)(k0 + 4 * i + (lane >> 4)) * ldw + n0src + (lane & 15) * 4));
#pragma unroll
    for (int i = 0; i < 16; ++i) { LAS float* sp = scr + (4 * i + (lane >> 4)) * 65 + (lane & 15) * 4; sp[0] = v[i].x; sp[1] = v[i].y; sp[2] = v[i].z; sp[3] = v[i].w; }
    LDS_WAIT(); asm volatile("" ::: "memory");
#pragma unroll
    for (int j = 0; j < 8; ++j) { const int pair = lane + 64 * j, c = pair & 7, n = pair >> 3; const LAS float* s = scr + (8 * c) * 65 + n;
        u32x4 o; o.x = cvtpk(s[0 * 65], s[1 * 65]); o.y = cvtpk(s[2 * 65], s[3 * 65]); o.z = cvtpk(s[4 * 65], s[5 * 65]); o.w = cvtpk(s[6 * 65], s[7 * 65]);
        WT_ST(o, (WT + (size_t)(rowdst0 + n) * ldt + k0 + 8 * c)); }
    LDS_WAIT(); asm volatile("" ::: "memory");
}
__device__ __forceinline__ void p0_prologue(const Args& a, LAS unsigned char* lds, int vcu, int G) {
    int tid_o = threadIdx.x; asm volatile("" : "+v"(tid_o));
    const int tid = tid_o, lane = tid & 63, wave = __builtin_amdgcn_readfirstlane(tid >> 6);
    LAS float* scr = (LAS float*)(lds + wave * 16896);
    const int gw = vcu * 8 + wave, NGW = G * 8;
    unsigned char* ws = a.ws;
    const int nGw = (2 * G < 384) ? 2 * G : 384;
    const bool isG = wave < 2 && (vcu * 2 + wave) < 384;
    if (wave < 2) for (int task = vcu * 2 + wave; task < 384; task += 2 * G) {
        const int cg = task % 48, ks = task / 48, n = cg * 256 + lane * 4;
        const float* c = a.in[I_C]; const float* wada = a.in[I_WADA];
        f32x4 a0 = {0.f, 0.f, 0.f, 0.f}, a1 = {0.f, 0.f, 0.f, 0.f};
#pragma unroll 1
        for (int k0 = ks * 256; k0 < ks * 256 + 256; k0 += 16) { f32x4 w[16];
#pragma unroll
            for (int q = 0; q < 16; ++q) w[q] = NT_LD((const f32x4*)(wada + (size_t)(k0 + q) * 12288 + n));
#pragma unroll
            for (int q = 0; q < 16; ++q) { const float s0 = fsilu(c[k0 + q]), s1 = fsilu(c[2048 + k0 + q]); a0 += s0 * w[q]; a1 += s1 * w[q]; } }
        float* modp = (float*)(ws + WS_MODP);
        *(f32x4*)(modp + (size_t)(ks * 2 + 0) * 12288 + n) = a0; *(f32x4*)(modp + (size_t)(ks * 2 + 1) * 12288 + n) = a1;
    }
    constexpr int I_IN = 32 * 96, I_OUT = 32 * 32, I_G = 32 * 256, I_U = I_G, I_D = 32 * 256, I_L = 64;
    constexpr int NITEMS = I_IN + I_OUT + I_G + I_U + I_D + I_L;
    const int N1 = (G == 256) ? 5 * NGW : NITEMS;
    const int before = (2 * vcu + (wave < 2 ? wave : 2)) < nGw ? (2 * vcu + (wave < 2 ? wave : 2)) : nGw;
    const int it2_0 = N1 + (gw - before), it2_s = NGW - nGw;
    for (int pass = 0; pass < 2; ++pass)
    for (int it = pass ? it2_0 : gw; it < (pass ? NITEMS : N1); it += (pass ? it2_s : NGW)) {
        if (pass && isG) break;
        int r = it;
        if (r < I_IN) { const int kb = r / 96, nb = r % 96, n0 = 64 * nb; tr_item(a.in[I_WIN], INW, 64 * kb, n0 + (n0 >= 4096 ? 8 : 0), (bf16_t*)(ws + WS_WIN), 2048, n0, scr, lane); continue; } r -= I_IN;
        if (r < I_OUT) { const int kb = r / 32, nb = r % 32; tr_item(a.in[I_WOUT], 2048, 64 * kb, 64 * nb, (bf16_t*)(ws + WS_WOUT), 2048, 64 * nb, scr, lane); continue; } r -= I_OUT;
        if (r < I_G) { const int e = r / 256, q = r % 256, kb = q / 8, nb = q % 8, n0 = 64 * nb;
            tr_item(a.in[I_WEG] + (size_t)e * 2048 * 512, 512, 64 * kb, n0, (bf16_t*)(ws + WS_WGU), 2048, e * 1024 + (n0 / 128) * 256 + (n0 % 128), scr, lane); continue; } r -= I_G;
        if (r < I_U) { const int e = r / 256, q = r % 256, kb = q / 8, nb = q % 8, n0 = 64 * nb;
            tr_item(a.in[I_WEU] + (size_t)e * 2048 * 512, 512, 64 * kb, n0, (bf16_t*)(ws + WS_WGU), 2048, e * 1024 + (n0 / 128) * 256 + 128 + (n0 % 128), scr, lane); continue; } r -= I_U;
        if (r < I_D) { const int e = r / 256, q = r % 256, kb = q / 32, nb = q % 32;
            tr_item(a.in[I_WED] + (size_t)e * 512 * 2048, 2048, 64 * kb, 64 * nb, (bf16_t*)(ws + WS_WDN), 512, e * 2048 + 64 * nb, scr, lane); continue; } r -= I_D;
        { const int mi = r / 4, q = r % 4, kb = q / 2, nb = q % 2, n = mi >> 1, g = mi & 1;
            tr_item((g ? a.in[I_WLX] : a.in[I_WLA]) + (size_t)n * 16384, 128, 64 * kb, 64 * nb, (bf16_t*)(ws + WS_WLRU), 128, (n * 2 + g) * 128 + 64 * nb, scr, lane); }
    }
    const int gt = vcu * 512 + tid, NGT = G * 512;
    float* wg8 = (float*)(ws + WS_WG8); bf16_t* wrh = (bf16_t*)(ws + WS_WRH); bf16_t* wrl = (bf16_t*)(ws + WS_WRL);
    for (int i = gt; i < 8 * 2048; i += NGT) { const int g = i >> 11, k = i & 2047; wg8[i] = a.in[I_WIN][(size_t)k * INW + 4096 + g]; }
    for (int i = gt; i < 48 * 2048; i += NGT) { const int c = i >> 11, k = i & 2047; const float w = c < 4 ? a.in[I_WGRP][k * 4 + c] : (c < 36 ? a.in[I_WRT][k * 32 + (c - 4)] : 0.f);
        const unsigned hi = f2bf(w); wrh[i] = (bf16_t)hi; wrl[i] = (bf16_t)f2bf(w - bf1((bf16_t)hi)); }
}

__device__ __forceinline__ void p1_hn_gates(const Args& a, LAS unsigned char* lds, int vcu, int G) {
    int tid_o = threadIdx.x; asm volatile("" : "+v"(tid_o));
    const int tid = tid_o, lane = tid & 63, wave = __builtin_amdgcn_readfirstlane(tid >> 6);
    unsigned char* ws = a.ws;
    LAS float* modv = (LAS float*)lds;
    LAS float* wgs = (LAS float*)(lds + 16384);
    LAS float* gts = (LAS float*)(lds + 16384 + 65536);
    const float* modp = (const float*)(ws + WS_MODP); const float* bada = a.in[I_BADA];
    for (int i = tid; i < 8 * 2048; i += 512) wgs[i] = ((const float*)(ws + WS_WG8))[i];
    for (int ch = vcu; ch < 256; ch += G) {
        const int b = ch >> 7;
        __syncthreads();
        for (int i = tid; i < 4096; i += 512) { float v = bada[i]; for (int ks = 0; ks < 8; ++ks) v += modp[(size_t)(ks * 2 + b) * 12288 + i]; modv[i] = v; }
        if (ch < 72) {
            const int bb = ch / 36, n = ch % 36; float p = 0.f;
            for (int k = tid; k < 2048; k += 512) { float sh = bada[6144 + k]; for (int ks = 0; ks < 8; ++ks) sh += modp[(size_t)(ks * 2 + bb) * 12288 + 6144 + k];
                p += sh * (n < 4 ? a.in[I_WGRP][k * 4 + n] : a.in[I_WRT][k * 32 + (n - 4)]); }
            p = wave_sum(p); LAS float* red = gts + 512;
            if (lane == 0) red[wave] = p;
            __syncthreads();
            if (tid == 0) { float q = 0.f; for (int w = 0; w < 8; ++w) q += red[w]; ((float*)(ws + WS_CVEC))[bb * 48 + n] = q + (n < 4 ? a.in[I_BGRP][n] : a.in[I_BRT][n - 4]); }
        }
        if (tid < 96) { const int o = ch * 96 + tid, bb = o / 12288, col = o % 12288; float v = bada[col]; for (int ks = 0; ks < 8; ++ks) v += modp[(size_t)(ks * 2 + bb) * 12288 + col]; ((float*)(ws + WS_MOD))[o] = v; }
        __syncthreads();
#pragma unroll 1
        for (int i4 = 0; i4 < 2; ++i4) {
            const int rowb = ch * 64 + wave * 8 + i4 * 4;
            f32x4 v[4][8]; float rs[4];
#pragma unroll
            for (int r = 0; r < 4; ++r) { const f32x4* xr = (const f32x4*)(a.in[I_X] + (size_t)(rowb + r) * DM) + lane;
#pragma unroll
                for (int j = 0; j < 8; ++j) v[r][j] = NT_LD(xr + 64 * j); }
#pragma unroll
            for (int r = 0; r < 4; ++r) { float s = 0.f;
#pragma unroll
                for (int j = 0; j < 8; ++j) s += (v[r][j].x * v[r][j].x + v[r][j].y * v[r][j].y) + (v[r][j].z * v[r][j].z + v[r][j].w * v[r][j].w);
                rs[r] = rsqrtf(wave_sum(s) * (1.f / DM) + EPS); }
#pragma unroll
            for (int j = 0; j < 8; ++j) { const f32x4 sh = *(const LAS f32x4*)(modv + 4 * lane + 256 * j), sc = *(const LAS f32x4*)(modv + 2048 + 4 * lane + 256 * j) + 1.f;
#pragma unroll
                for (int r = 0; r < 4; ++r) { v[r][j] = v[r][j] * rs[r] * sc + sh;
                    u32x2* o8 = (u32x2*)((bf16_t*)(ws + WS_HN) + (size_t)(rowb + r) * DM) + lane; o8[64 * j] = (u32x2){cvtpk(v[r][j].x, v[r][j].y), cvtpk(v[r][j].z, v[r][j].w)}; } }
            float gv[4] = {0.f, 0.f, 0.f, 0.f};
#pragma unroll
            for (int g = 0; g < 8; ++g) { float p[4] = {0.f, 0.f, 0.f, 0.f};
#pragma unroll
                for (int j = 0; j < 8; ++j) { const f32x4 w = *(const LAS f32x4*)(wgs + g * 2048 + 4 * lane + 256 * j);
#pragma unroll
                    for (int r = 0; r < 4; ++r) p[r] += (v[r][j].x * w.x + v[r][j].y * w.y) + (v[r][j].z * w.z + v[r][j].w * w.w); }
#pragma unroll
                for (int r = 0; r < 4; ++r) { const float q = wave_sum(p[r]); if (lane == g) gv[r] = q; } }
#pragma unroll
            for (int r = 0; r < 4; ++r) if (lane < 8) gts[(wave * 8 + i4 * 4 + r) * 8 + lane] = gv[r];
        }
        __syncthreads();
        if (wave < 4) {
            const int h = wave, row = ch * 64 + lane; const float* bg = a.in[I_BGATES];
            const float ig = gts[lane * 8 + h] + bg[h]; const float lf = flogsigmoid(gts[lane * 8 + 4 + h] + bg[4 + h]);
            float bc = lf;
#pragma unroll
            for (int o = 1; o < 64; o <<= 1) { const float t = __shfl_up(bc, o); if (lane >= o) bc += t; }
            const float w = ig - bc; float am = w;
#pragma unroll
            for (int o = 1; o < 64; o <<= 1) { const float t = __shfl_up(am, o); if (lane >= o) am = fmaxf(am, t); }
            ((float*)(ws + WS_GTB))[row * 4 + h] = bc; ((float*)(ws + WS_GTW))[row * 4 + h] = w; ((float*)(ws + WS_GTA))[row * 4 + h] = am;
            if (lane == 63) { const int bh = b * 4 + h, c = ch & 127; ((float*)(ws + WS_BLAST))[bh * 128 + c] = bc; ((float*)(ws + WS_ALAST))[bh * 128 + c] = am; }
        }
    }
    __syncthreads();
}

struct DenseSched {
    static constexpr bool GATHER = false;
    const char* A; const char* Bt; int K, nM, nN, nwg, G, c;
    __device__ __forceinline__ void init(const void* A_, const void* Bt_, int M, int N, int K_, int G_, int c_) { A = (const char*)A_; Bt = (const char*)Bt_; K = K_; nM = M / 256; nN = N / 256; nwg = nM * nN; G = G_; c = c_; }
    __device__ __forceinline__ bool next(int i, pg8::Unit& u) const {
        const long L = (long)i * G + c; if (L >= nwg) return false;
        int wgid = (int)L; { const int q = nwg / 8, r = nwg % 8, xcd = wgid % 8, off = wgid / 8; wgid = (xcd < r ? xcd * (q + 1) : r * (q + 1) + (xcd - r) * q) + off; }
        const int nig = 8 * nN, gid = wgid / nig, fm = gid * 8, gsz = (nM - fm) < 8 ? (nM - fm) : 8;
        u.pm = fm + ((wgid % nig) % gsz); u.pn = (wgid % nig) / gsz; u.e = 0; u.mt = 0; return true;
    }
    __device__ __forceinline__ const char* a_base(const pg8::Unit& u) const { return A + (size_t)u.pm * 256 * K * 2; }
    __device__ __forceinline__ const char* b_base(const pg8::Unit& u) const { return Bt + (size_t)u.pn * 256 * K * 2; }
    __device__ __forceinline__ void a_off(const pg8::Unit&, const int (&R)[2], const int (&C)[2], int K_, unsigned (&v)[2][2]) const {
#pragma unroll
        for (int h = 0; h < 2; ++h)
#pragma unroll
            for (int i = 0; i < 2; ++i) v[h][i] = (unsigned)((128 * h + R[i]) * K_ + C[i]) * 2u;
    }
};
#define EPI_NOSTATE struct State {}; __device__ __forceinline__ void pre(State&, const pg8::Unit&, int, int) const {}
struct EpiProj {
    static constexpr bool PERM = true; EPI_NOSTATE
    bf16_t* O; int ldc;
    __device__ __forceinline__ void operator()(const f32x4 (&acc)[2][2][4][2], const pg8::Unit& u, int wr, int wc, int fr, int fq, const State& est) const {
        const int row0 = u.pm * 256 + wr * 64 + fr, col0 = u.pn * 256 + wc * 32 + 8 * fq;
#pragma unroll
        for (int ai = 0; ai < 2; ++ai)
#pragma unroll
            for (int m = 0; m < 4; ++m) { bf16_t* rowp = O + (size_t)(row0 + ai * 128 + m * 16) * ldc + col0;
#pragma unroll
                for (int bj = 0; bj < 2; ++bj) { const f32x4 v0 = acc[ai][bj][m][0], v1 = acc[ai][bj][m][1];
                    u32x4 w; w.x = cvtpk(v0[0], v0[1]); w.y = cvtpk(v0[2], v0[3]); w.z = cvtpk(v1[0], v1[1]); w.w = cvtpk(v1[2], v1[3]);
                    WT_ST(w, rowp + bj * 128); } }
    }
};
struct EpiX1 {
    static constexpr bool PERM = true; EPI_NOSTATE
    const float* x; const float* mod; bf16_t* x1b;
    __device__ __forceinline__ void operator()(const f32x4 (&acc)[2][2][4][2], const pg8::Unit& u, int wr, int wc, int fr, int fq, const State& est) const {
        const int row0 = u.pm * 256 + wr * 64 + fr, col0 = u.pn * 256 + wc * 32 + 8 * fq;
        const float* g1 = mod + (size_t)((u.pm * 256) / SEQ) * 12288 + 4096;
#pragma unroll
        for (int bj = 0; bj < 2; ++bj) { const int col = col0 + bj * 128; const f32x4 ga = *(const f32x4*)(g1 + col), gb = *(const f32x4*)(g1 + col + 4);
#pragma unroll
            for (int ai = 0; ai < 2; ++ai)
#pragma unroll
                for (int m = 0; m < 4; ++m) { const size_t off = (size_t)(row0 + ai * 128 + m * 16) * DM + col; const f32x4 xa = NT_LD((const f32x4*)(x + off)), xb = NT_LD((const f32x4*)(x + off + 4));
                    const f32x4 va = xa + ga * acc[ai][bj][m][0], vb = xb + gb * acc[ai][bj][m][1];
                    WT_ST(((u32x4){cvtpk(va.x, va.y), cvtpk(va.z, va.w), cvtpk(vb.x, vb.y), cvtpk(vb.z, vb.w)}), x1b + off); } }
    }
};
template <int NT, bool GATH>
struct MoeSched {
    static constexpr bool GATHER = GATH;
    const LAS int* tp; const int* cnt; const int* list; const char* A; const char* Bt; int K, first, stride, end;
    __device__ __forceinline__ bool next(int i, pg8::Unit& u) const {
        const int L = first + i * stride; if (L >= end) return false;
        const int tile = L / NT; u.pn = L % NT;
        const int e = __builtin_amdgcn_readfirstlane((int)((const LAS unsigned short*)(tp + 160))[tile]);
        u.e = e; u.mt = tile - tp[e]; u.pm = tile; return true;
    }
    __device__ __forceinline__ const char* a_base(const pg8::Unit& u) const { return GATH ? A : A + (size_t)u.pm * 256 * K * 2; }
    __device__ __forceinline__ const char* b_base(const pg8::Unit& u) const { return Bt + ((size_t)u.e * NT + u.pn) * 256 * K * 2; }
    __device__ __forceinline__ void a_off(const pg8::Unit& u, const int (&R)[2], const int (&C)[2], int K_, unsigned (&v)[2][2]) const {
        if (GATH) { const int n = cnt[u.e]; const int* lp = list + (size_t)u.e * T + u.mt * 256;
#pragma unroll
            for (int h = 0; h < 2; ++h)
#pragma unroll
                for (int i = 0; i < 2; ++i) { const int r = 128 * h + R[i]; const int tok = (u.mt * 256 + r < n) ? (lp[r] >> 1) : 0; v[h][i] = (unsigned)(tok * K_ + C[i]) * 2u; }
        } else {
#pragma unroll
            for (int h = 0; h < 2; ++h)
#pragma unroll
                for (int i = 0; i < 2; ++i) v[h][i] = (unsigned)((128 * h + R[i]) * K_ + C[i]) * 2u;
        }
    }
};
struct EpiGateUp {
    static constexpr bool PERM = true; EPI_NOSTATE
    bf16_t* H;
    __device__ __forceinline__ void operator()(const f32x4 (&acc)[2][2][4][2], const pg8::Unit& u, int wr, int wc, int fr, int fq, const State& est) const {
        const int row0 = u.pm * 256 + wr * 64 + fr, col0 = u.pn * 128 + wc * 32 + 8 * fq;
#pragma unroll
        for (int ai = 0; ai < 2; ++ai)
#pragma unroll
            for (int m = 0; m < 4; ++m) { bf16_t* rowp = H + (size_t)(row0 + ai * 128 + m * 16) * 512 + col0;
                const f32x4 g0 = acc[ai][0][m][0], g1 = acc[ai][0][m][1], u0 = acc[ai][1][m][0], u1 = acc[ai][1][m][1];
                u32x4 w; w.x = cvtpk(fsilu(g0[0]) * u0[0], fsilu(g0[1]) * u0[1]); w.y = cvtpk(fsilu(g0[2]) * u0[2], fsilu(g0[3]) * u0[3]);
                w.z = cvtpk(fsilu(g1[0]) * u1[0], fsilu(g1[1]) * u1[1]); w.w = cvtpk(fsilu(g1[2]) * u1[2], fsilu(g1[3]) * u1[3]);
                WT_ST(w, rowp); }
    }
};
struct EpiDown {
    static constexpr bool PERM = true;
    struct State { unsigned pk[2][4]; };
    bf16_t* Y; const int* cnt; const int* list; const float* listw;
    __device__ __forceinline__ void pre(State& st, const pg8::Unit& u, int wr, int fr) const {
        const int n = cnt[u.e]; const size_t base = (size_t)u.e * T + u.mt * 256;
#pragma unroll
        for (int ai = 0; ai < 2; ++ai)
#pragma unroll
            for (int m = 0; m < 4; ++m) { const int r = ai * 128 + wr * 64 + m * 16 + fr; const bool ok = u.mt * 256 + r < n;
                const unsigned d = ok ? (unsigned)list[base + r] : 0xFFFFu; const float g = ok ? listw[base + r] : 0.f; st.pk[ai][m] = (cvtpk(0.f, g) & 0xffff0000u) | d; }
    }
    __device__ __forceinline__ void operator()(const f32x4 (&acc)[2][2][4][2], const pg8::Unit& u, int wr, int wc, int fr, int fq, const State& st) const {
        const int col0 = u.pn * 256 + wc * 32 + 8 * fq;
#pragma unroll
        for (int ai = 0; ai < 2; ++ai)
#pragma unroll
            for (int m = 0; m < 4; ++m) { const unsigned pk = st.pk[ai][m]; const unsigned dst = pk & 0xffffu;
                if (dst != 0xFFFFu) { const float gw = bfhi(pk); bf16_t* rowp = Y + (size_t)dst * DM + col0;
#pragma unroll
                    for (int bj = 0; bj < 2; ++bj) { const f32x4 v0 = acc[ai][bj][m][0] * gw, v1 = acc[ai][bj][m][1] * gw;
                        u32x4 w; w.x = cvtpk(v0[0], v0[1]); w.y = cvtpk(v0[2], v0[3]); w.z = cvtpk(v1[0], v1[1]); w.w = cvtpk(v1[2], v1[3]);
                        WT_ST(w, rowp + bj * 128); } } }
    }
};

constexpr int L_KWT = 0, L_VT = 36864, L_QS = 73728, L_KS = 107520, L_PS = 141312, L_F = 150528;
constexpr int L_WEXP = L_F, L_MT = L_F + 256, L_EI = L_F + 512, L_RDN = L_F + 768, L_BT = L_F + 1024, L_WK = L_F + 1280, L_NS = L_F + 1536, L_RSS = L_F + 2560, L_MCH = L_F + 4608, L_RN = L_F + 5248, L_GW = L_F + 5504, L_GA = L_GW + 1024, L_GB = L_GA + 1024, L_AL = L_GB + 1024;
static_assert(L_AL + 16 <= L_CTL, "mixer LDS map");

#define MLSTM_LOAD_RAW(cc) do { const int c_ = (cc), r0c_ = b * SEQ + c_ * 64, dp_ = tid & 127, tg_ = tid >> 7, d0_ = 2 * dp_, s0_ = 16 * tg_, tt0_ = c_ * 64 + s0_; \
          _Pragma("unroll") for (int q = 0; q < 19; ++q) { const int ti = tt0_ - 3 + q; rawk[q] = ti >= 0 ? (FULL ? NT_LD((const unsigned*)(PROJ + (size_t)(r0c_ + s0_ - 3 + q) * NPROJ + 1024 + h * 256 + d0_)) : *(const unsigned*)(PROJ + (size_t)(r0c_ + s0_ - 3 + q) * NPROJ + 1024 + h * 256 + d0_)) : 0u; } \
          } while (0)
#define MLSTM_LOAD_RAWV(cc) do { const int c_ = (cc), r0c_ = b * SEQ + c_ * 64, dp_ = tid & 127, tg_ = tid >> 7, d0_ = 2 * dp_, s0_ = 16 * tg_; \
          _Pragma("unroll") for (int q = 0; q < 16; ++q) rawv[q] = FULL ? NT_LD((const unsigned*)(PROJ + (size_t)(r0c_ + s0_ + q) * NPROJ + 2048 + h * 256 + d0_)) : *(const unsigned*)(PROJ + (size_t)(r0c_ + s0_ + q) * NPROJ + 2048 + h * 256 + d0_); } while (0)
#define MLSTM_LOAD_RAWQ(cc) do { const int c_ = (cc), r0c_ = b * SEQ + c_ * 64, dp_ = tid & 127, tg_ = tid >> 7, d0_ = 2 * dp_, s0_ = 16 * tg_, tt0_ = c_ * 64 + s0_; \
          _Pragma("unroll") for (int q = 0; q < 19; ++q) { const int ti = tt0_ - 3 + q; rawq[q] = ti >= 0 ? NT_LD((const unsigned*)(PROJ + (size_t)(r0c_ + s0_ - 3 + q) * NPROJ + h * 256 + d0_)) : 0u; } } while (0)
template <bool FULL>
__device__ __forceinline__ void mlstm_unit(const Args& a, LAS unsigned char* lds, int bh, int j) {
    int tid_o0 = threadIdx.x; asm volatile("" : "+v"(tid_o0));
    const int tid = tid_o0, lane = tid & 63, wave = __builtin_amdgcn_readfirstlane(tid >> 6), hh = lane >> 5, l31 = lane & 31;
    const int b = bh >> 2, h = bh & 3;
    unsigned char* ws = a.ws;
    const bf16_t* PROJ = (const bf16_t*)(ws + WS_PROJ);
    const float* BLAST = (const float*)(ws + WS_BLAST); const float* ALAST = (const float*)(ws + WS_ALAST);
    LAS float* mch = (LAS float*)(lds + L_MCH); LAS float* nsv = (LAS float*)(lds + L_NS);
    LAS float* WEXP = (LAS float*)(lds + L_WEXP); LAS float* MT = (LAS float*)(lds + L_MT); LAS float* EI = (LAS float*)(lds + L_EI); LAS float* RDN = (LAS float*)(lds + L_RDN);
    LAS float* BT = (LAS float*)(lds + L_BT); LAS float* WK = (LAS float*)(lds + L_WK); LAS float* RSS = (LAS float*)(lds + L_RSS); LAS float* RN = (LAS float*)(lds + L_RN);
    const int unit = bh * 32 + j;
    __syncthreads();
    if (wave == 0) {
        const float pa = BLAST[bh * 128 + 2 * lane], qa = ALAST[bh * 128 + 2 * lane] + pa, pb = BLAST[bh * 128 + 2 * lane + 1], qb = ALAST[bh * 128 + 2 * lane + 1] + pb;
        float P = pa + pb, Q = fmaxf(qa + pb, qb);
#pragma unroll
        for (int o = 1; o < 64; o <<= 1) { const float oP = __shfl_up(P, o), oQ = __shfl_up(Q, o); if (lane >= o) { Q = fmaxf(oQ + P, Q); P = oP + P; } }
        float eP = __shfl_up(P, 1), eQ = __shfl_up(Q, 1); if (lane == 0) { eP = 0.f; eQ = -INFINITY; }
        const float m0 = fmaxf(eP, eQ), m1 = fmaxf(m0 + pa, qa);
        mch[2 * lane] = m0; mch[2 * lane + 1] = m1;
    }
    f32x16 C[8];
#pragma unroll
    for (int dt = 0; dt < 8; ++dt)
#pragma unroll
        for (int r = 0; r < 16; ++r) C[dt][r] = 0.f;
    if (FULL && j > 0) {
        const bf16_t* st = (const bf16_t*)(ws + WS_LST) + (size_t)(unit - 1) * 65536;
#pragma unroll
        for (int dt = 0; dt < 8; ++dt)
#pragma unroll
            for (int q = 0; q < 2; ++q) { const u32x4 v = NT_LD((const u32x4*)(st + ((dt * 2 + q) * 512 + tid) * 8)); C[dt][8 * q] = bflo(v.x); C[dt][8 * q + 1] = bfhi(v.x); C[dt][8 * q + 2] = bflo(v.y); C[dt][8 * q + 3] = bfhi(v.y); C[dt][8 * q + 4] = bflo(v.z); C[dt][8 * q + 5] = bfhi(v.z); C[dt][8 * q + 6] = bflo(v.w); C[dt][8 * q + 7] = bfhi(v.w); }
    }
    if (tid < 256) nsv[tid] = (FULL && j > 0) ? ((const float*)(ws + WS_LNS))[(size_t)(unit - 1) * 256 + tid] : 0.f;
    if (tid < 256) { const int row = b * SEQ + j * 256 + tid;
        ((LAS float*)(lds + L_GW))[tid] = ((const float*)(ws + WS_GTW))[row * 4 + h]; ((LAS float*)(lds + L_GA))[tid] = ((const float*)(ws + WS_GTA))[row * 4 + h]; ((LAS float*)(lds + L_GB))[tid] = ((const float*)(ws + WS_GTB))[row * 4 + h]; }
    if (tid < 4) ((LAS float*)(lds + L_AL))[tid] = ALAST[bh * 128 + 4 * j + tid];
    float dtot_log = 0.f;
    __syncthreads();
#pragma unroll 1
    for (int i = 0; i < 4; ++i) {
        int tid_o = threadIdx.x; asm volatile("" : "+v"(tid_o));
        const int tid = tid_o, lane = tid & 63, hh = lane >> 5, l31 = lane & 31;
        const int c = 4 * j + i; const int r0c = b * SEQ + c * 64;
        const float mc = mch[c]; const float M63 = fmaxf(mc, ((const LAS float*)(lds + L_AL))[i]); const float decay = __expf(mc - M63);
        dtot_log += mc - M63;
        unsigned rawk[19], rawv[16], rawq[19]; MLSTM_LOAD_RAW(c); MLSTM_LOAD_RAWV(c); if (FULL) MLSTM_LOAD_RAWQ(c);
        float cwk[4][2], cwq[4][2];
        { const float* cw = a.in[I_CONVQK]; const int d0 = 2 * (tid & 127);
#pragma unroll
          for (int q = 0; q < 4; ++q) { cwk[q][0] = cw[q * 2048 + 1024 + h * 256 + d0]; cwk[q][1] = cw[q * 2048 + 1024 + h * 256 + d0 + 1]; if (FULL) { cwq[q][0] = cw[q * 2048 + h * 256 + d0]; cwq[q][1] = cw[q * 2048 + h * 256 + d0 + 1]; } } }
        if (tid < 64) { const float w = ((const LAS float*)(lds + L_GW))[i * 64 + tid], am = ((const LAS float*)(lds + L_GA))[i * 64 + tid], bt = ((const LAS float*)(lds + L_GB))[i * 64 + tid];
            const float Mt = fmaxf(mc, am); WEXP[tid] = w; MT[tid] = Mt; EI[tid] = __expf(mc - Mt); BT[tid] = bt; WK[tid] = __expf(w - M63); }
        __syncthreads();
        {
            const int dp = tid & 127, tg = tid >> 7, d0 = 2 * dp, s0 = 16 * tg;
            const int tt0 = c * 64 + s0;
            const float* cw = a.in[I_CONVQK];
            {
                const float (&w)[4][2] = cwk;
                const unsigned (&raw)[19] = rawk;
                unsigned pa[8], pb[8]; float ka = 0.f, kb = 0.f;
#pragma unroll
                for (int s = 0; s < 16; ++s) { float x0 = 0.f, x1 = 0.f;
#pragma unroll
                    for (int q = 0; q < 4; ++q) { x0 += w[q][0] * bflo(raw[s + q]); x1 += w[q][1] * bfhi(raw[s + q]); }
                    x0 = fsilu(x0) * 0.0625f; x1 = fsilu(x1) * 0.0625f;
                    if (FULL) *(LAS unsigned*)(lds + L_KS + (s0 + s) * 528 + d0 * 2) = cvtpk(x0, x1);
                    const float wk = WK[s0 + s]; x0 *= wk; x1 *= wk;
                    if (s & 1) { pa[s >> 1] = cvtpk(ka, x0); pb[s >> 1] = cvtpk(kb, x1); } else { ka = x0; kb = x1; } }
                *(LAS u32x4*)(lds + L_KWT + d0 * 144 + s0 * 2) = (u32x4){pa[0], pa[1], pa[2], pa[3]}; *(LAS u32x4*)(lds + L_KWT + d0 * 144 + s0 * 2 + 16) = (u32x4){pa[4], pa[5], pa[6], pa[7]};
                *(LAS u32x4*)(lds + L_KWT + (d0 + 1) * 144 + s0 * 2) = (u32x4){pb[0], pb[1], pb[2], pb[3]}; *(LAS u32x4*)(lds + L_KWT + (d0 + 1) * 144 + s0 * 2 + 16) = (u32x4){pb[4], pb[5], pb[6], pb[7]};
            }
            __builtin_amdgcn_sched_barrier(0);
            {
                const unsigned (&raw)[16] = rawv;
                unsigned pa[8], pb[8];
#pragma unroll
                for (int q = 0; q < 8; ++q) { pa[q] = (raw[2 * q] & 0xffffu) | (raw[2 * q + 1] << 16); pb[q] = (raw[2 * q] >> 16) | (raw[2 * q + 1] & 0xffff0000u); }
                *(LAS u32x4*)(lds + L_VT + d0 * 144 + s0 * 2) = (u32x4){pa[0], pa[1], pa[2], pa[3]}; *(LAS u32x4*)(lds + L_VT + d0 * 144 + s0 * 2 + 16) = (u32x4){pa[4], pa[5], pa[6], pa[7]};
                *(LAS u32x4*)(lds + L_VT + (d0 + 1) * 144 + s0 * 2) = (u32x4){pb[0], pb[1], pb[2], pb[3]}; *(LAS u32x4*)(lds + L_VT + (d0 + 1) * 144 + s0 * 2 + 16) = (u32x4){pb[4], pb[5], pb[6], pb[7]};
            }
            __builtin_amdgcn_sched_barrier(0);
            if (FULL) {
                const float (&w)[4][2] = cwq;
                const unsigned (&raw)[19] = rawq;
#pragma unroll
                for (int s = 0; s < 16; ++s) { float x0 = 0.f, x1 = 0.f;
#pragma unroll
                    for (int q = 0; q < 4; ++q) { x0 += w[q][0] * bflo(raw[s + q]); x1 += w[q][1] * bfhi(raw[s + q]); }
                    *(LAS unsigned*)(lds + L_QS + (s0 + s) * 528 + d0 * 2) = cvtpk(fsilu(x0), fsilu(x1)); }
            }
        }
        __syncthreads();
        if (FULL) {
            {
                const int tr = wave >> 1, tc0 = 2 * (wave & 1), fr = lane & 15, fq = lane >> 4;
                f32x4 s0 = {0.f, 0.f, 0.f, 0.f}, s1 = {0.f, 0.f, 0.f, 0.f};
#pragma unroll
                for (int ks = 0; ks < 8; ++ks) {
                    const bf16x8 af = *(const LAS bf16x8*)(lds + L_QS + (16 * tr + fr) * 528 + (32 * ks + 8 * fq) * 2);
                    const bf16x8 b0 = *(const LAS bf16x8*)(lds + L_KS + (16 * tc0 + fr) * 528 + (32 * ks + 8 * fq) * 2);
                    const bf16x8 b1 = *(const LAS bf16x8*)(lds + L_KS + (16 * (tc0 + 1) + fr) * 528 + (32 * ks + 8 * fq) * 2);
                    s0 = __builtin_amdgcn_mfma_f32_16x16x32_bf16(af, b0, s0, 0, 0, 0); s1 = __builtin_amdgcn_mfma_f32_16x16x32_bf16(af, b1, s1, 0, 0, 0);
                }
                const float we0 = WEXP[16 * tc0 + fr], we1 = WEXP[16 * (tc0 + 1) + fr];
#pragma unroll
                for (int r = 0; r < 4; ++r) { const int t = 16 * tr + 4 * fq + r; const float Mt = MT[t];
                    { const int s = 16 * tc0 + fr; const float ex = __expf(fminf(we0 - Mt, 0.f)); const float p = (s <= t) ? s0[r] * ex : 0.f; *(LAS bf16_t*)(lds + L_PS + t * 144 + s * 2) = (bf16_t)cvtpk(p, 0.f); }
                    { const int s = 16 * (tc0 + 1) + fr; const float ex = __expf(fminf(we1 - Mt, 0.f)); const float p = (s <= t) ? s1[r] * ex : 0.f; *(LAS bf16_t*)(lds + L_PS + t * 144 + s * 2) = (bf16_t)cvtpk(p, 0.f); } }
            }
            __syncthreads();
            u32x4 oreg[4];
#pragma unroll
            for (int q = 0; q < 4; ++q) { const int idx = q * 512 + tid, t = idx >> 5, ch = idx & 31; oreg[q] = NT_LD((const u32x4*)(PROJ + (size_t)(r0c + t) * NPROJ + 3072 + h * 256 + ch * 8)); }
            {
                const int t = tid >> 3, p = tid & 7;
                const u32x4 pv = *(const LAS u32x4*)(lds + L_PS + t * 144 + p * 16);
                float sp = (bflo(pv.x) + bfhi(pv.x)) + (bflo(pv.y) + bfhi(pv.y)) + (bflo(pv.z) + bfhi(pv.z)) + (bflo(pv.w) + bfhi(pv.w));
                float qn = 0.f;
#pragma unroll
                for (int q = 0; q < 4; ++q) { const u32x4 qv = *(const LAS u32x4*)(lds + L_QS + t * 528 + (32 * p + 8 * q) * 2); const LAS float* np = nsv + 32 * p + 8 * q;
                    qn += bflo(qv.x) * np[0] + bfhi(qv.x) * np[1] + bflo(qv.y) * np[2] + bfhi(qv.y) * np[3] + bflo(qv.z) * np[4] + bfhi(qv.z) * np[5] + bflo(qv.w) * np[6] + bfhi(qv.w) * np[7]; }
                sp += __shfl_xor(sp, 1); sp += __shfl_xor(sp, 2); sp += __shfl_xor(sp, 4);
                qn += __shfl_xor(qn, 1); qn += __shfl_xor(qn, 2); qn += __shfl_xor(qn, 4);
                if (p == 0) { const float den = sp + EI[t] * qn; RDN[t] = frcp(fmaxf(fabsf(den), __expf(-(BT[t] + MT[t])))); }
            }
            f32x16 nacc[2];
#pragma unroll
            for (int tt = 0; tt < 2; ++tt)
#pragma unroll
                for (int r = 0; r < 16; ++r) nacc[tt][r] = 0.f;
#pragma unroll
            for (int dt = 0; dt < 8; ++dt)
#pragma unroll
                for (int sp = 0; sp < 2; ++sp) {
                    __builtin_amdgcn_sched_barrier(0);
                    bf16x8 bfr; { u32x4 t4; t4.x = cvtpk(C[dt][8 * sp + 0], C[dt][8 * sp + 1]); t4.y = cvtpk(C[dt][8 * sp + 2], C[dt][8 * sp + 3]); t4.z = cvtpk(C[dt][8 * sp + 4], C[dt][8 * sp + 5]); t4.w = cvtpk(C[dt][8 * sp + 6], C[dt][8 * sp + 7]); bfr = __builtin_bit_cast(bf16x8, t4); }
#pragma unroll
                    for (int tt = 0; tt < 2; ++tt) {
                        const u32x2 lo = *(const LAS u32x2*)(lds + L_QS + (32 * tt + l31) * 528 + (32 * dt + 16 * sp + 4 * hh) * 2);
                        const u32x2 hi = *(const LAS u32x2*)(lds + L_QS + (32 * tt + l31) * 528 + (32 * dt + 16 * sp + 8 + 4 * hh) * 2);
                        const u32x4 a4 = {lo.x, lo.y, hi.x, hi.y};
                        nacc[tt] = __builtin_amdgcn_mfma_f32_32x32x16_bf16(__builtin_bit_cast(bf16x8, a4), bfr, nacc[tt], 0, 0, 0);
                    }
                }
#pragma unroll
            for (int tt = 0; tt < 2; ++tt)
#pragma unroll
                for (int r = 0; r < 16; ++r) nacc[tt][r] *= EI[32 * tt + (r & 3) + 8 * (r >> 2) + 4 * hh];
#pragma unroll
            for (int ks = 0; ks < 4; ++ks) {
                __builtin_amdgcn_sched_barrier(0);
                const bf16x8 bfr = *(const LAS bf16x8*)(lds + L_VT + (32 * wave + l31) * 144 + (16 * ks + 8 * hh) * 2);
#pragma unroll
                for (int tt = 0; tt < 2; ++tt) { const bf16x8 afr = *(const LAS bf16x8*)(lds + L_PS + (32 * tt + l31) * 144 + (16 * ks + 8 * hh) * 2);
                    nacc[tt] = __builtin_amdgcn_mfma_f32_32x32x16_bf16(afr, bfr, nacc[tt], 0, 0, 0); }
            }
#pragma unroll
            for (int q = 0; q < 4; ++q) { const int idx = q * 512 + tid, t = idx >> 5, ch = idx & 31; *(LAS u32x4*)(lds + L_KS + t * 528 + ch * 16) = oreg[q]; }
            __syncthreads();
#pragma unroll
            for (int tt = 0; tt < 2; ++tt)
#pragma unroll
                for (int r = 0; r < 16; ++r) { const int t = 32 * tt + (r & 3) + 8 * (r >> 2) + 4 * hh; const float hv = nacc[tt][r] * RDN[t]; nacc[tt][r] = hv;
                    const float q = half_sum31(hv * hv);
                    if (l31 == 31) RSS[wave * 64 + t] = q; }
            __syncthreads();
            if (tid < 64) { float q = 0.f;
#pragma unroll
                for (int w = 0; w < 8; ++w) q += RSS[w * 64 + tid];
                RN[tid] = rsqrtf(q * (1.f / 256.f) + EPS); }
            __syncthreads();
            {
                const int e = 32 * wave + l31; const float g = a.in[I_MHG][h * 256 + e];
#pragma unroll
                for (int tt = 0; tt < 2; ++tt)
#pragma unroll
                    for (int r = 0; r < 16; ++r) { const int t = 32 * tt + (r & 3) + 8 * (r >> 2) + 4 * hh;
                        const float o = bf1(*(const LAS bf16_t*)(lds + L_KS + t * 528 + e * 2));
                        *(LAS bf16_t*)(lds + L_QS + t * 528 + e * 2) = (bf16_t)cvtpk(nacc[tt][r] * RN[t] * g * fsigmoid(o), 0.f); }
            }
            __syncthreads();
            {
                bf16_t* ymr = (bf16_t*)(ws + WS_HN);
#pragma unroll
                for (int q = 0; q < 4; ++q) { const int idx = q * 512 + tid, t = idx >> 5, ch = idx & 31;
                    WT_ST(*(const LAS u32x4*)(lds + L_QS + t * 528 + ch * 16), ymr + (size_t)(r0c + t) * DM + h * 256 + ch * 8); }
            }
        }
#pragma unroll
        for (int dt = 0; dt < 8; ++dt)
#pragma unroll
            for (int r = 0; r < 16; ++r) C[dt][r] *= decay;
#pragma unroll
        for (int ks = 0; ks < 4; ++ks) {
            __builtin_amdgcn_sched_barrier(0);
            const bf16x8 bfr = *(const LAS bf16x8*)(lds + L_VT + (32 * wave + l31) * 144 + (16 * ks + 8 * hh) * 2);
#pragma unroll
            for (int dt = 0; dt < 8; ++dt) { const bf16x8 afr = *(const LAS bf16x8*)(lds + L_KWT + (32 * dt + l31) * 144 + (16 * ks + 8 * hh) * 2);
                C[dt] = __builtin_amdgcn_mfma_f32_32x32x16_bf16(afr, bfr, C[dt], 0, 0, 0); }
        }
        if (tid < 256) { float sk = 0.f;
#pragma unroll
            for (int q = 0; q < 8; ++q) { const u32x4 kv = *(const LAS u32x4*)(lds + L_KWT + tid * 144 + q * 16); sk += (bflo(kv.x) + bfhi(kv.x)) + (bflo(kv.y) + bfhi(kv.y)) + (bflo(kv.z) + bfhi(kv.z)) + (bflo(kv.w) + bfhi(kv.w)); }
            nsv[tid] = decay * nsv[tid] + sk; }
        __syncthreads();
    }
    if (!FULL) {
        bf16_t* st = (bf16_t*)(ws + WS_LST) + (size_t)unit * 65536;
#pragma unroll
        for (int dt = 0; dt < 8; ++dt)
#pragma unroll
            for (int q = 0; q < 2; ++q) WT_ST(((u32x4){cvtpk(C[dt][8 * q], C[dt][8 * q + 1]), cvtpk(C[dt][8 * q + 2], C[dt][8 * q + 3]), cvtpk(C[dt][8 * q + 4], C[dt][8 * q + 5]), cvtpk(C[dt][8 * q + 6], C[dt][8 * q + 7])}), st + ((dt * 2 + q) * 512 + tid) * 8);
        if (tid < 256) ((float*)(ws + WS_LNS))[(size_t)unit * 256 + tid] = nsv[tid];
        if (tid == 0) ((float*)(ws + WS_DTOT))[unit] = __expf(dtot_log);
    }
}

constexpr int L_XS = 0, L_SEG = 69632, L_WL = L_SEG + 16384;
static_assert(L_WL + 2 * 128 * 272 <= L_CTL, "lru LDS map");
__device__ __forceinline__ void lru_unit(const Args& a, LAS unsigned char* lds, int b, int j, int n, bool load_w) {
    int tid_o = threadIdx.x; asm volatile("" : "+v"(tid_o));
    const int tid = tid_o, lane = tid & 63, wave = __builtin_amdgcn_readfirstlane(tid >> 6), hh = lane >> 5, l31 = lane & 31;
    unsigned char* ws = a.ws;
    const bf16_t* PROJ = (const bf16_t*)(ws + WS_PROJ);
    const int r0 = b * SEQ + j * 256, c0 = n * 128;
    const int unit = (b * 32 + j) * 8 + n;
    LAS float* SEG = (LAS float*)(lds + L_SEG);
    __syncthreads();
    if (load_w) {
        const bf16_t* WL = (const bf16_t*)(ws + WS_WLRU) + (size_t)n * 2 * 128 * 128;
#pragma unroll
        for (int q = 0; q < 8; ++q) { const int idx = q * 512 + tid, row = idx >> 4, ch = idx & 15;
            *(LAS u32x4*)(lds + L_WL + row * 272 + ch * 16) = *(const u32x4*)(WL + (size_t)row * 128 + ch * 8); }
    }
    {
        const int cp = tid & 63, tg = tid >> 6, c = 2 * cp, s0 = 32 * tg;
        const float* cw = a.in[I_LCW]; const float* cb = a.in[I_LCB];
        float w[4][2];
#pragma unroll
        for (int q = 0; q < 4; ++q) { w[q][0] = cw[q * 1024 + c0 + c]; w[q][1] = cw[q * 1024 + c0 + c + 1]; }
        const float b0 = cb[c0 + c], b1 = cb[c0 + c + 1];
        unsigned raw[35];
#pragma unroll
        for (int q = 0; q < 35; ++q) { const int ti = j * 256 + s0 - 3 + q; raw[q] = ti >= 0 ? NT_LD((const unsigned*)(PROJ + (size_t)(r0 + s0 - 3 + q) * NPROJ + 4096 + c0 + c)) : 0u; }
#pragma unroll
        for (int s = 0; s < 32; ++s) { float x0 = b0, x1 = b1;
#pragma unroll
            for (int q = 0; q < 4; ++q) { x0 += w[q][0] * bflo(raw[s + q]); x1 += w[q][1] * bfhi(raw[s + q]); }
            *(LAS unsigned*)(lds + L_XS + (s0 + s) * 272 + c * 2) = cvtpk(x0, x1); }
    }
    __syncthreads();
    float gba[4], gbx[4], glam[4];
#pragma unroll
    for (int nt = 0; nt < 4; ++nt) { const int c = c0 + 32 * nt + l31; gba[nt] = a.in[I_BLA][c]; gbx[nt] = a.in[I_BLX][c]; glam[nt] = a.in[I_LAM][c]; }
    f32x16 ar[4], ai[4];
#pragma unroll
    for (int nt = 0; nt < 4; ++nt)
#pragma unroll
        for (int r = 0; r < 16; ++r) { ar[nt][r] = 0.f; ai[nt][r] = 0.f; }
    {
        const int tau = 16 * ((l31 >> 2) & 1) + 4 * (l31 >> 3) + (l31 & 3);
#pragma unroll
        for (int ks = 0; ks < 8; ++ks) {
            const bf16x8 afr = *(const LAS bf16x8*)(lds + L_XS + (32 * wave + tau) * 272 + (16 * ks + 8 * hh) * 2);
#pragma unroll
            for (int nt = 0; nt < 4; ++nt) {
                const bf16x8 br = *(const LAS bf16x8*)(lds + L_WL + (32 * nt + l31) * 272 + (16 * ks + 8 * hh) * 2);
                const bf16x8 bi = *(const LAS bf16x8*)(lds + L_WL + (128 + 32 * nt + l31) * 272 + (16 * ks + 8 * hh) * 2);
                ar[nt] = __builtin_amdgcn_mfma_f32_32x32x16_bf16(afr, br, ar[nt], 0, 0, 0); ai[nt] = __builtin_amdgcn_mfma_f32_32x32x16_bf16(afr, bi, ai[nt], 0, 0, 0);
            }
        }
    }
#pragma unroll
    for (int nt = 0; nt < 4; ++nt) {
        __builtin_amdgcn_sched_barrier(0);
        const int d = 32 * nt + l31;
        const float ba = gba[nt], bx = gbx[nt], lsl = flogsigmoid(glam[nt]);
        float A = 1.f, H = 0.f;
#pragma unroll
        for (int r = 0; r < 16; ++r) {
            const int t = 32 * wave + 16 * hh + r;
            const float rg = fsigmoid(ar[nt][r] + ba), ig = fsigmoid(ai[nt][r] + bx);
            const float la = 8.f * rg * lsl; const float av = __expf(la);
            const float xr = bf1(*(const LAS bf16_t*)(lds + L_XS + t * 272 + d * 2));
            const float x2 = 2.f * la; const float om = (x2 > -0.02f) ? -x2 * (1.f + x2 * (0.5f + x2 * (1.f / 6.f))) : 1.f - __expf(x2);
            const float u = __builtin_amdgcn_sqrtf(om) * (ig * xr);
            ar[nt][r] = av; ai[nt][r] = u;
            A *= av; H = av * H + u;
        }
        SEG[((2 * wave + hh) * 128 + d) * 2] = A; SEG[((2 * wave + hh) * 128 + d) * 2 + 1] = H;
    }
    __syncthreads();
    if (tid < 128) {
        float hc = 0.f, At = 1.f;
#pragma unroll
        for (int sg = 0; sg < 16; ++sg) { const float A = SEG[(sg * 128 + tid) * 2], H = SEG[(sg * 128 + tid) * 2 + 1]; SEG[(sg * 128 + tid) * 2] = hc; SEG[(sg * 128 + tid) * 2 + 1] = At; hc = A * hc + H; At *= A; }
        ((float*)(ws + WS_LRUA))[(size_t)unit * 128 + tid] = At; ((float*)(ws + WS_LRUH))[(size_t)unit * 128 + tid] = hc;
    }
    __syncthreads();
#pragma unroll 1
    for (int round = 0; round < 2; ++round) {
#pragma unroll
        for (int nt = 0; nt < 4; ++nt) { const int d = 32 * nt + l31;
            float v = SEG[((2 * wave + hh) * 128 + d) * 2 + round];
#pragma unroll
            for (int r = 0; r < 16; ++r) { const int t = 32 * wave + 16 * hh + r;
                v = round ? v * ar[nt][r] : ar[nt][r] * v + ai[nt][r];
                *(LAS bf16_t*)(lds + L_XS + t * 272 + d * 2) = (bf16_t)cvtpk(v, 0.f); } }
        __syncthreads();
        bf16_t* dstb = (bf16_t*)(ws + (round ? WS_ACUM : WS_HLOC));
#pragma unroll
        for (int q = 0; q < 8; ++q) { const int idx = q * 512 + tid, t = idx >> 4, ch = idx & 15;
            WT_ST(*(const LAS u32x4*)(lds + L_XS + t * 272 + ch * 16), dstb + (size_t)(r0 + t) * 1024 + c0 + ch * 8); }
        __syncthreads();
    }
}
__device__ __forceinline__ void lru_out_unit(const Args& a, int b, int j, int n) {
    int tid_o = threadIdx.x; asm volatile("" : "+v"(tid_o));
    const int tid = tid_o, d8 = tid & 15;
    unsigned char* ws = a.ws;
    const bf16_t* PROJ = (const bf16_t*)(ws + WS_PROJ); const bf16_t* HL = (const bf16_t*)(ws + WS_HLOC); const bf16_t* AC = (const bf16_t*)(ws + WS_ACUM);
    const int r0 = b * SEQ + j * 256, c0 = n * 128 + 8 * d8;
    const float* cp = (const float*)(ws + WS_LRUC) + (size_t)(b * 32 + j) * 1024 + c0; const float* gp = a.in[I_LNG] + c0;
    const f32x4 ca = *(const f32x4*)cp, cb = *(const f32x4*)(cp + 4), ga = *(const f32x4*)gp, gb = *(const f32x4*)(gp + 4);
    u32x4 hl[8], ac[8], gr[8];
#pragma unroll
    for (int q = 0; q < 8; ++q) { const size_t t = (size_t)(r0 + (tid >> 4) + 32 * q);
        hl[q] = NT_LD((const u32x4*)(HL + t * 1024 + c0)); ac[q] = NT_LD((const u32x4*)(AC + t * 1024 + c0)); gr[q] = NT_LD((const u32x4*)(PROJ + t * NPROJ + 5120 + c0)); }
    bf16_t* ymr = (bf16_t*)(ws + WS_HN);
#pragma unroll
    for (int q = 0; q < 8; ++q) { const size_t t = (size_t)(r0 + (tid >> 4) + 32 * q);
        f32x4 ya = (f32x4){bflo(hl[q].x), bfhi(hl[q].x), bflo(hl[q].y), bfhi(hl[q].y)} + (f32x4){bflo(ac[q].x), bfhi(ac[q].x), bflo(ac[q].y), bfhi(ac[q].y)} * ca;
        f32x4 yb = (f32x4){bflo(hl[q].z), bfhi(hl[q].z), bflo(hl[q].w), bfhi(hl[q].w)} + (f32x4){bflo(ac[q].z), bfhi(ac[q].z), bflo(ac[q].w), bfhi(ac[q].w)} * cb;
        ya = ya * (f32x4){fgelu_tanh(bflo(gr[q].x)), fgelu_tanh(bfhi(gr[q].x)), fgelu_tanh(bflo(gr[q].y)), fgelu_tanh(bfhi(gr[q].y))};
        yb = yb * (f32x4){fgelu_tanh(bflo(gr[q].z)), fgelu_tanh(bfhi(gr[q].z)), fgelu_tanh(bflo(gr[q].w)), fgelu_tanh(bfhi(gr[q].w))};
        float ss = (ya.x * ya.x + ya.y * ya.y) + (ya.z * ya.z + ya.w * ya.w) + (yb.x * yb.x + yb.y * yb.y) + (yb.z * yb.z + yb.w * yb.w);
        ss += __shfl_xor(ss, 1); ss += __shfl_xor(ss, 2); ss += __shfl_xor(ss, 4); ss += __shfl_xor(ss, 8);
        const float rn = rsqrtf(ss * (1.f / 128.f) + EPS);
        ya = ya * rn * ga; yb = yb * rn * gb;
        WT_ST(((u32x4){cvtpk(ya.x, ya.y), cvtpk(ya.z, ya.w), cvtpk(yb.x, yb.y), cvtpk(yb.z, yb.w)}), ymr + t * DM + 1024 + c0); }
}

__device__ __forceinline__ void mixer_scan(const Args& a, int vcu, int G) {
    unsigned char* ws = a.ws; int tid_o = threadIdx.x; asm volatile("" : "+v"(tid_o)); const int tid = tid_o;
    const float* DT = (const float*)(ws + WS_DTOT);
    if (tid < 256) for (int g = vcu * 256 + tid; g < 65536; g += G * 256) {
        const int bh = g >> 13, i8 = g & 8191; bf16_t* base = (bf16_t*)(ws + WS_LST) + (size_t)bh * 32 * 65536 + (size_t)i8 * 8;
        f32x4 Sa = {0.f, 0.f, 0.f, 0.f}, Sb = {0.f, 0.f, 0.f, 0.f}; u32x4 Lr[31];
#pragma unroll
        for (int j = 0; j < 31; ++j) Lr[j] = NT_LD((const u32x4*)(base + (size_t)j * 65536));
#pragma unroll
        for (int j = 0; j < 31; ++j) { const float d = DT[bh * 32 + j]; const u32x4 L = Lr[j];
            Sa = d * Sa + (f32x4){bflo(L.x), bfhi(L.x), bflo(L.y), bfhi(L.y)}; Sb = d * Sb + (f32x4){bflo(L.z), bfhi(L.z), bflo(L.w), bfhi(L.w)};
            WT_ST(((u32x4){cvtpk(Sa.x, Sa.y), cvtpk(Sa.z, Sa.w), cvtpk(Sb.x, Sb.y), cvtpk(Sb.z, Sb.w)}), base + (size_t)j * 65536); }
    }
    if (tid >= 264 && tid < 266) for (int g = vcu * 2 + (tid - 264); g < 8 * 64; g += G * 2) {
        const int bh = g >> 6, i4 = g & 63; float* base = (float*)(ws + WS_LNS) + (size_t)bh * 32 * 256 + (size_t)i4 * 4;
        f32x4 S = {0.f, 0.f, 0.f, 0.f};
#pragma unroll 8
        for (int j = 0; j < 31; ++j) { const f32x4 L = *(const f32x4*)(base + (size_t)j * 256); S = DT[bh * 32 + j] * S + L; *(f32x4*)(base + (size_t)j * 256) = S; }
    }
    if (tid >= 256 && tid < 264) for (int g = vcu * 8 + (tid - 256); g < 2048; g += G * 8) {
        const int b = g >> 10, ch = g & 1023, n = ch >> 7, d = ch & 127; float hc = 0.f;
        const float* LA = (const float*)(ws + WS_LRUA); const float* LH = (const float*)(ws + WS_LRUH); float* LC = (float*)(ws + WS_LRUC);
#pragma unroll 8
        for (int j = 0; j < 32; ++j) { const size_t u = (size_t)((b * 32 + j) * 8 + n) * 128 + d; LC[(size_t)(b * 32 + j) * 1024 + ch] = hc; hc = LA[u] * hc + LH[u]; }
    }
}

__device__ __forceinline__ void p5_hn2_route(const Args& a, LAS unsigned char* lds, int vcu, int G) {
    int tid_o = threadIdx.x; asm volatile("" : "+v"(tid_o));
    const int tid = tid_o, lane = tid & 63, wave = __builtin_amdgcn_readfirstlane(tid >> 6), fr = lane & 15, kq = lane >> 4;
    unsigned char* ws = a.ws;
    LAS float* part = (LAS float*)lds;
    LAS float* rstds = (LAS float*)(lds + 49152);
    LAS float* lgs = (LAS float*)(lds + 49152 + 128);
    const float* mod = (const float*)(ws + WS_MOD); const float* cvec = (const float*)(ws + WS_CVEC);
    const bf16_t* WRH = (const bf16_t*)(ws + WS_WRH); const bf16_t* WRL = (const bf16_t*)(ws + WS_WRL);
    int* cnt = (int*)(ws + WS_CTL); int* list = (int*)(ws + WS_LIST); float* route = (float*)(ws + WS_ROUTE);
    for (int task = vcu; task < T / 32; task += G) {
        int lane_o = tid_o & 63; asm volatile("" : "+v"(lane_o));
        const int lane = lane_o, fr = lane & 15, kq = lane >> 4;
        const int row0 = task * 32, b = row0 / SEQ;
        const float* sh2 = mod + (size_t)b * 12288 + 6144; const float* sc2 = mod + (size_t)b * 12288 + 8192;
        __syncthreads();
        const bf16_t* X1 = (const bf16_t*)(ws + WS_X1B);
        f32x4 acc[2][3];
#pragma unroll
        for (int rt = 0; rt < 2; ++rt)
#pragma unroll
            for (int nt = 0; nt < 3; ++nt) acc[rt][nt] = (f32x4){0.f, 0.f, 0.f, 0.f};
        {
            u32x4 xb[8][2];
#pragma unroll
            for (int st = 0; st < 8; ++st)
#pragma unroll
                for (int rt = 0; rt < 2; ++rt) xb[st][rt] = *(const u32x4*)(X1 + (size_t)(row0 + 16 * rt + fr) * DM + 256 * wave + 32 * st + 8 * kq);
            bf16x8 Bhs[2][3], Bls[2][3]; f32x4 s0s[2], s1s[2];
#define RT_LOADB(set, stp) do { const int c0_ = 256 * wave + 32 * (stp) + 8 * kq; s0s[set] = *(const f32x4*)(sc2 + c0_); s1s[set] = *(const f32x4*)(sc2 + c0_ + 4); \
                _Pragma("unroll") for (int nt = 0; nt < 3; ++nt) { Bhs[set][nt] = *(const bf16x8*)(WRH + (size_t)(16 * nt + fr) * 2048 + c0_); Bls[set][nt] = *(const bf16x8*)(WRL + (size_t)(16 * nt + fr) * 2048 + c0_); } } while (0)
            RT_LOADB(0, 0);
#pragma unroll
            for (int st = 0; st < 8; ++st) {
                __builtin_amdgcn_sched_barrier(0);
                if (st < 7) RT_LOADB((st + 1) & 1, st + 1);
                const f32x4 s0 = s0s[st & 1] + 1.f, s1 = s1s[st & 1] + 1.f;
                bf16x8 Ah[2], Al[2];
#pragma unroll
                for (int rt = 0; rt < 2; ++rt) {
                    const u32x4 r4 = xb[st][rt];
                    const f32x4 x0 = (f32x4){bflo(r4.x), bfhi(r4.x), bflo(r4.y), bfhi(r4.y)} * s0, x1 = (f32x4){bflo(r4.z), bfhi(r4.z), bflo(r4.w), bfhi(r4.w)} * s1;
                    u32x4 h; h.x = cvtpk(x0.x, x0.y); h.y = cvtpk(x0.z, x0.w); h.z = cvtpk(x1.x, x1.y); h.w = cvtpk(x1.z, x1.w);
                    u32x4 l; l.x = cvtpk(x0.x - bflo(h.x), x0.y - bfhi(h.x)); l.y = cvtpk(x0.z - bflo(h.y), x0.w - bfhi(h.y)); l.z = cvtpk(x1.x - bflo(h.z), x1.y - bfhi(h.z)); l.w = cvtpk(x1.z - bflo(h.w), x1.w - bfhi(h.w));
                    Ah[rt] = __builtin_bit_cast(bf16x8, h); Al[rt] = __builtin_bit_cast(bf16x8, l);
                }
#pragma unroll
                for (int nt = 0; nt < 3; ++nt) {
                    const bf16x8 Bh = Bhs[st & 1][nt], Bl = Bls[st & 1][nt];
#pragma unroll
                    for (int rt = 0; rt < 2; ++rt) {
                        acc[rt][nt] = __builtin_amdgcn_mfma_f32_16x16x32_bf16(Ah[rt], Bh, acc[rt][nt], 0, 0, 0);
                        acc[rt][nt] = __builtin_amdgcn_mfma_f32_16x16x32_bf16(Al[rt], Bh, acc[rt][nt], 0, 0, 0);
                        acc[rt][nt] = __builtin_amdgcn_mfma_f32_16x16x32_bf16(Ah[rt], Bl, acc[rt][nt], 0, 0, 0);
                    }
                }
            }
        }
#undef RT_LOADB
        __builtin_amdgcn_sched_barrier(0);
        {
            u32x4 v[4][4]; float rs[4];
#pragma unroll
            for (int r = 0; r < 4; ++r)
#pragma unroll
                for (int jj = 0; jj < 4; ++jj) v[r][jj] = NT_LD((const u32x4*)(X1 + (size_t)(row0 + wave * 4 + r) * DM + 8 * lane + 512 * jj));
#pragma unroll
            for (int r = 0; r < 4; ++r) { float ssum = 0.f;
#pragma unroll
                for (int jj = 0; jj < 4; ++jj) { const u32x4 q = v[r][jj]; const float a0 = bflo(q.x), a1 = bfhi(q.x), a2 = bflo(q.y), a3 = bfhi(q.y), a4 = bflo(q.z), a5 = bfhi(q.z), a6 = bflo(q.w), a7 = bfhi(q.w);
                    ssum += ((a0 * a0 + a1 * a1) + (a2 * a2 + a3 * a3)) + ((a4 * a4 + a5 * a5) + (a6 * a6 + a7 * a7)); }
                rs[r] = rsqrtf(wave_sum(ssum) * (1.f / DM) + EPS); if (lane == 0) rstds[wave * 4 + r] = rs[r]; }
#pragma unroll
            for (int jj = 0; jj < 4; ++jj) { __builtin_amdgcn_sched_barrier(0);
                const f32x4 sha = *(const f32x4*)(sh2 + 8 * lane + 512 * jj), shb = *(const f32x4*)(sh2 + 8 * lane + 512 * jj + 4);
                const f32x4 sca = *(const f32x4*)(sc2 + 8 * lane + 512 * jj) + 1.f, scb = *(const f32x4*)(sc2 + 8 * lane + 512 * jj + 4) + 1.f;
#pragma unroll
                for (int r = 0; r < 4; ++r) { const u32x4 q = v[r][jj];
                    const f32x4 ha = (f32x4){bflo(q.x), bfhi(q.x), bflo(q.y), bfhi(q.y)} * rs[r] * sca + sha, hb = (f32x4){bflo(q.z), bfhi(q.z), bflo(q.w), bfhi(q.w)} * rs[r] * scb + shb;
                    WT_ST(((u32x4){cvtpk(ha.x, ha.y), cvtpk(ha.z, ha.w), cvtpk(hb.x, hb.y), cvtpk(hb.z, hb.w)}), (bf16_t*)(ws + WS_HN) + (size_t)(row0 + wave * 4 + r) * DM + 8 * lane + 512 * jj); } }
        }
#pragma unroll
        for (int rt = 0; rt < 2; ++rt)
#pragma unroll
            for (int nt = 0; nt < 3; ++nt)
#pragma unroll
                for (int r = 0; r < 4; ++r) part[(wave * 32 + 16 * rt + 4 * kq + r) * 48 + 16 * nt + fr] = acc[rt][nt][r];
        __syncthreads();
        for (int idx = tid; idx < 32 * 36; idx += 512) { const int r = idx / 36, n = idx % 36; float q = 0.f;
#pragma unroll
            for (int w = 0; w < 8; ++w) q += part[(w * 32 + r) * 48 + n];
            lgs[r * 40 + n] = rstds[r] * q + cvec[b * 48 + n]; }
        __syncthreads();
        if (tid < 32) {
            const int t = row0 + tid; const LAS float* lg = lgs + tid * 40;
            int g = 0; float mx = lg[0];
#pragma unroll
            for (int i = 1; i < 4; ++i) { const float x = lg[i]; if (x > mx) { mx = x; g = i; } }
            float sg = 0.f;
#pragma unroll
            for (int i = 0; i < 4; ++i) sg += __expf(lg[i] - mx);
            const float pg = 1.f / sg;
            int e0 = 0; float m0 = lg[4 + g * 8];
            for (int i = 1; i < 8; ++i) { const float x = lg[4 + g * 8 + i]; if (x > m0) { m0 = x; e0 = i; } }
            int e1 = -1; float m1 = -INFINITY;
            for (int i = 0; i < 8; ++i) { const float x = lg[4 + g * 8 + i]; if (i != e0 && x > m1) { m1 = x; e1 = i; } }
            const float x1 = __expf(m1 - m0); const float w0 = pg / (1.f + x1), w1 = pg * x1 / (1.f + x1);
            const int E0 = g * 8 + e0, E1 = g * 8 + e1;
            *(f32x4*)(route + (size_t)t * 4) = (f32x4){w0, w1, (float)E0, (float)E1};
            LAS int* lcnt = (LAS int*)(lds + 49152 + 128 + 5120); LAS int* lbase = lcnt + 32;
            lcnt[tid] = 0;
            LDS_WAIT(); asm volatile("" ::: "memory");
            const int rk0 = __hip_atomic_fetch_add(lcnt + E0, 1, __ATOMIC_RELAXED, __HIP_MEMORY_SCOPE_WORKGROUP);
            const int rk1 = __hip_atomic_fetch_add(lcnt + E1, 1, __ATOMIC_RELAXED, __HIP_MEMORY_SCOPE_WORKGROUP);
            LDS_WAIT(); asm volatile("" ::: "memory");
            const int lc = lcnt[tid];
            lbase[tid] = lc ? atomicAdd(&cnt[tid], lc) : 0;
            LDS_WAIT(); asm volatile("" ::: "memory");
            float* listw = (float*)(ws + WS_LISTW);
            { const size_t p0 = (size_t)E0 * T + lbase[E0] + rk0, p1 = (size_t)E1 * T + lbase[E1] + rk1;
              list[p0] = t * 2; listw[p0] = w0; list[p1] = t * 2 + 1; listw[p1] = w1; }
        }
    }
}

__device__ __forceinline__ void p9_final(const Args& a, int vcu, int G, float* dstbase) {
    int tid_o = threadIdx.x; asm volatile("" : "+v"(tid_o));
    const int tid = tid_o, lane = tid & 63, wave = __builtin_amdgcn_readfirstlane(tid >> 6);
    unsigned char* ws = a.ws; const float* mod = (const float*)(ws + WS_MOD); const bf16_t* YS = (const bf16_t*)(ws + WS_YS);
    const bf16_t* X1 = (const bf16_t*)(ws + WS_X1B);
    for (int rp = vcu * 8 + wave; rp < T / 2; rp += G * 8) {
        const int b = (2 * rp) / SEQ; const float* g2 = mod + (size_t)b * 12288 + 10240;
        u32x4 xr[2][4], y0[2][4], y1[2][4];
#pragma unroll
        for (int q = 0; q < 2; ++q)
#pragma unroll
            for (int jj = 0; jj < 4; ++jj) { const int row = 2 * rp + q; xr[q][jj] = NT_LD((const u32x4*)(X1 + (size_t)row * DM + 8 * lane + 512 * jj)); y0[q][jj] = NT_LD((const u32x4*)(YS + (size_t)(2 * row) * DM + 8 * lane + 512 * jj)); y1[q][jj] = NT_LD((const u32x4*)(YS + (size_t)(2 * row + 1) * DM + 8 * lane + 512 * jj)); }
#pragma unroll
        for (int q = 0; q < 2; ++q) {
            const int row = 2 * rp + q; f32x4 v[4][2]; float s = 0.f;
#pragma unroll
            for (int jj = 0; jj < 4; ++jj) { const f32x4 ga = *(const f32x4*)(g2 + 8 * lane + 512 * jj), gb = *(const f32x4*)(g2 + 8 * lane + 512 * jj + 4);
                const u32x4 x = xr[q][jj], p0 = y0[q][jj], p1 = y1[q][jj];
                v[jj][0] = (f32x4){bflo(x.x), bfhi(x.x), bflo(x.y), bfhi(x.y)} + ga * (f32x4){bflo(p0.x) + bflo(p1.x), bfhi(p0.x) + bfhi(p1.x), bflo(p0.y) + bflo(p1.y), bfhi(p0.y) + bfhi(p1.y)};
                v[jj][1] = (f32x4){bflo(x.z), bfhi(x.z), bflo(x.w), bfhi(x.w)} + gb * (f32x4){bflo(p0.z) + bflo(p1.z), bfhi(p0.z) + bfhi(p1.z), bflo(p0.w) + bflo(p1.w), bfhi(p0.w) + bfhi(p1.w)};
#pragma unroll
                for (int z = 0; z < 2; ++z) s += (v[jj][z].x * v[jj][z].x + v[jj][z].y * v[jj][z].y) + (v[jj][z].z * v[jj][z].z + v[jj][z].w * v[jj][z].w); }
            const float rstd = rsqrtf(wave_sum(s) * (1.f / DM) + EPS);
#pragma unroll
            for (int jj = 0; jj < 4; ++jj) { const f32x4 fa = *(const f32x4*)(a.in[I_FG] + 8 * lane + 512 * jj), fb = *(const f32x4*)(a.in[I_FG] + 8 * lane + 512 * jj + 4);
                float* dr = dstbase + (size_t)row * DM + 8 * lane + 512 * jj; NT_ST(v[jj][0] * rstd * fa, (f32x4*)dr); NT_ST(v[jj][1] * rstd * fb, (f32x4*)(dr + 4)); }
        }
    }
}
}
namespace fk {
#define XB_TMO      128
#define XB_XCNT(j)  (256  + 64 * (j))
#define XB_XSUB(j)  (1280 + 64 * (j))
#define XB_XGEN(j)  (2304 + 64 * (j))
#define XB_TOP      3328
#define XB_TOPGEN   3392
#define XCD_BAR_WORDS 3456
#define XB_SPIN_CAP (1u << 18)

__device__ __forceinline__ unsigned xb_ld(unsigned* p)              { return __hip_atomic_load(p, __ATOMIC_RELAXED, __HIP_MEMORY_SCOPE_AGENT); }
__device__ __forceinline__ unsigned xb_add(unsigned* p, unsigned v) { return __hip_atomic_fetch_add(p, v, __ATOMIC_RELAXED, __HIP_MEMORY_SCOPE_AGENT); }
__device__ __forceinline__ unsigned xb_xcc_id() { return (unsigned)__builtin_amdgcn_s_getreg((3 << 11) | 20) & 0xFu; }
#define XB_SPIN(cond, bar) do { unsigned _sp = 0; while (cond) { __builtin_amdgcn_s_sleep(1); \
    if ((++_sp & 255u) == 0u) { if (xb_ld(&(bar)[XB_TMO])) break; if (_sp > XB_SPIN_CAP) { atomicAdd(&(bar)[XB_TMO], 1u); break; } } } } while (0)

struct XcdBarrier {
    unsigned* bar; unsigned x;
    volatile LAS unsigned* st;
};

__device__ __forceinline__ XcdBarrier xcd_barrier_post(unsigned* bar, volatile LAS unsigned* st) {
    XcdBarrier b; b.bar = bar; b.x = xb_xcc_id(); b.st = st;
    if (threadIdx.x == 0) (void)xb_add(&bar[XB_XCNT(b.x)], 1u);
    return b;
}
__device__ __forceinline__ void xcd_barrier_complete(unsigned* bar, unsigned x, unsigned& nloc, unsigned& nx) {
    const unsigned G = gridDim.x * gridDim.y * gridDim.z;
    unsigned sum, cnt, mine, sp = 0u;
    for (;;) {
        sum = 0u; cnt = 0u; mine = 0u;
#pragma unroll
        for (unsigned j = 0; j < 16; ++j) { const unsigned c = xb_ld(&bar[XB_XCNT(j)]); sum += c; cnt += (c > 0u) ? 1u : 0u; mine = (j == x) ? c : mine; }
        if (sum == G) break;
        __builtin_amdgcn_s_sleep(1);
        if ((++sp & 255u) == 0u) { if (xb_ld(&bar[XB_TMO])) break; if (sp > XB_SPIN_CAP) { atomicAdd(&bar[XB_TMO], 1u); break; } }
    }
    nloc = mine > 0u ? mine : 1u; nx = cnt > 0u ? cnt : 1u;
}

__device__ __forceinline__ void xcd_barrier(const XcdBarrier& b) {
    asm volatile("s_waitcnt vmcnt(0)" ::: "memory");
    __syncthreads();
    if (threadIdx.x == 0) {
        unsigned* bar = b.bar;
        __builtin_amdgcn_s_waitcnt(0);
        unsigned nloc = b.st[0], nx = b.st[1];
        if (nloc == 0u) { xcd_barrier_complete(bar, b.x, nloc, nx); b.st[0] = nloc; b.st[1] = nx; }
        const unsigned old = xb_add(&bar[XB_XSUB(b.x)], 1u);
        const unsigned gen = old / nloc;
        if (old + 1u == (gen + 1u) * nloc) {
            __builtin_amdgcn_fence(__ATOMIC_RELEASE, "agent");
            asm volatile("s_waitcnt vmcnt(0)" ::: "memory");
            const unsigned og = xb_add(&bar[XB_TOP], 1u);
            const unsigned tg = og / nx;
            if (og + 1u == (tg + 1u) * nx) xb_add(&bar[XB_TOPGEN], 1u);
            else XB_SPIN(xb_ld(&bar[XB_TOPGEN]) == tg, bar);
            __builtin_amdgcn_fence(__ATOMIC_ACQUIRE, "agent");
            xb_add(&bar[XB_XGEN(b.x)], 1u);
            asm volatile("s_waitcnt vmcnt(0)" ::: "memory");
        } else {
            XB_SPIN(xb_ld(&bar[XB_XGEN(b.x)]) == gen, bar);
            __builtin_amdgcn_fence(__ATOMIC_ACQUIRE, "agent");
            asm volatile("s_waitcnt vmcnt(0)" ::: "memory");
        }
    }
    __syncthreads();
}
}
namespace fk {
constexpr int NPHASE = 11;
__global__ void __launch_bounds__(512, 2) fwd(Args a) {
    extern __shared__ __attribute__((aligned(16))) unsigned char lds_raw[];
    LAS unsigned char* lds = (LAS unsigned char*)lds_raw;
    const int G = gridDim.x, bx = blockIdx.x, tid = threadIdx.x;
    const int vcu = (G % 8 == 0) ? (bx % 8) * (G / 8) + bx / 8 : bx;
    const int lo = a.ph_lo, hi = a.ph_hi;
    unsigned char* ws = a.ws;
    volatile LAS unsigned* bst = (volatile LAS unsigned*)(lds + L_CTL + 512);
    if (tid < 2) bst[tid] = 0u;
    __syncthreads();
    XcdBarrier bar; bar.bar = (unsigned*)(ws + WS_BAR); bar.x = 0; bar.st = bst;
    if (hi - lo > 1) bar = xcd_barrier_post((unsigned*)(ws + WS_BAR), bst);
#ifndef PH_ONLY
#define PH_ONLY -1
#endif
#define IN(k) ((PH_ONLY < 0 || PH_ONLY == (k)) && lo <= (k) && (k) < hi)
#define GSYNC() xcd_barrier(bar)
#define SYNC(k) do { if (IN(k) && IN((k) + 1)) GSYNC(); } while (0)
#ifndef REP_PHASE
#define REP_PHASE -1
#endif
#ifndef REP_SKIPL
#define REP_SKIPL 0
#endif
#define REP(k) _Pragma("unroll 1") for (int rep_ = 0; rep_ < ((REP_PHASE == (k)) ? 2 : 1); ++rep_)
#define RSYNC() do { if (rep_) GSYNC(); } while (0)
    REP(0) { RSYNC(); if (IN(0)) { p0_prologue(a, lds, vcu, G); } } SYNC(0);
    REP(1) { RSYNC(); if (IN(1)) { p1_hn_gates(a, lds, vcu, G); } } SYNC(1);
    REP(2) { RSYNC(); if (IN(2)) { DenseSched S; S.init(ws + WS_HN, ws + WS_WIN, T, NPROJ, DM, G, bx); EpiProj E{(bf16_t*)(ws + WS_PROJ), NPROJ}; pg8::gemm_phase<EpiProj, DenseSched>(lds, DM, S, E); } } SYNC(2);
    REP(34) { RSYNC(); REP(3) { RSYNC(); if (IN(3)) {
#ifndef NO_MLSTM
                 for (int u = vcu; u < 256; u += G) mlstm_unit<false>(a, lds, u >> 5, u & 31);
#endif
#ifndef NO_LRU
                 if (!(REP_SKIPL && rep_)) for (int u = vcu, pn_ = -1; u < 512; u += G) { lru_unit(a, lds, u >> 8, (u >> 3) & 31, u & 7, (u & 7) != pn_); pn_ = u & 7; }
#endif
    } } SYNC(3);
    if (IN(4)) { mixer_scan(a, vcu, G); } } SYNC(4);
    REP(5) { RSYNC(); if (IN(5)) {
                 if (vcu & 1) { for (int u = vcu; u < 512; u += G) lru_out_unit(a, u >> 8, (u >> 3) & 31, u & 7); }
                 for (int u = vcu; u < 256; u += G) mlstm_unit<true>(a, lds, u >> 5, u & 31);
                 if (!(vcu & 1)) { for (int u = vcu; u < 512; u += G) lru_out_unit(a, u >> 8, (u >> 3) & 31, u & 7); }
    } } SYNC(5);
    REP(6) { RSYNC(); if (IN(6)) { __syncthreads(); DenseSched S; S.init(ws + WS_HN, ws + WS_WOUT, T, DM, DM, G, bx); EpiX1 E{a.in[I_X], (const float*)(ws + WS_MOD), (bf16_t*)(ws + WS_X1B)}; pg8::gemm_phase<EpiX1, DenseSched>(lds, DM, S, E); } } SYNC(6);
    REP(7) { if (rep_) { GSYNC(); if (bx == 0 && tid < 32) ((int*)(ws + WS_CTL))[tid] = 0; GSYNC(); }
        if (IN(7)) { p5_hn2_route(a, lds, vcu, G); } } SYNC(7);
    if (IN(8) || IN(9)) {
        LAS int* tp = (LAS int*)(lds + L_CTL); const int* cnt = (const int*)(ws + WS_CTL);
        __syncthreads();
        if (tid == 0) { int s = 0; for (int e = 0; e < 32; ++e) { tp[e] = s; s += (cnt[e] + 255) >> 8; } tp[32] = s; }
        __syncthreads();
        if (tid < 192) { int e = 0; for (int q = 1; q < 32; ++q) e += (tp[q] <= tid) ? 1 : 0; ((LAS unsigned short*)(tp + 160))[tid] = (unsigned short)e; }
        __syncthreads();
    }
    if (IN(8)) { const LAS int* tp = (const LAS int*)(lds + L_CTL); const int nGU = tp[32] * 4, R = nGU / G, rem = nGU - R * G, Ne = G - rem;
        { MoeSched<4, true> S{tp, (const int*)(ws + WS_CTL), (const int*)(ws + WS_LIST), (const char*)(ws + WS_HN), (const char*)(ws + WS_WGU), DM, vcu, G, R * G};
          EpiGateUp E{(bf16_t*)(ws + WS_HEXP)}; pg8::gemm_phase<EpiGateUp, MoeSched<4, true>>(lds, DM, S, E); }
        if (rem > 0) {
            GSYNC();
            if (vcu < rem) { MoeSched<4, true> S{tp, (const int*)(ws + WS_CTL), (const int*)(ws + WS_LIST), (const char*)(ws + WS_HN), (const char*)(ws + WS_WGU), DM, R * G + vcu, G, nGU};
                EpiGateUp E{(bf16_t*)(ws + WS_HEXP)}; pg8::gemm_phase<EpiGateUp, MoeSched<4, true>>(lds, DM, S, E); }
            else if (R >= 1) { MoeSched<8, false> S{tp, (const int*)(ws + WS_CTL), (const int*)(ws + WS_LIST), (const char*)(ws + WS_HEXP), (const char*)(ws + WS_WDN), 512, vcu - rem, Ne, 2 * Ne};
                EpiDown E{(bf16_t*)(ws + WS_YS), (const int*)(ws + WS_CTL), (const int*)(ws + WS_LIST), (const float*)(ws + WS_LISTW)}; pg8::gemm_phase<EpiDown, MoeSched<8, false>>(lds, 512, S, E); }
        }
    } SYNC(8);
    if (IN(9)) { const LAS int* tp = (const LAS int*)(lds + L_CTL); const int nGU = tp[32] * 4, R = nGU / G, rem = nGU - R * G, Ne = G - rem;
        MoeSched<8, false> S{tp, (const int*)(ws + WS_CTL), (const int*)(ws + WS_LIST), (const char*)(ws + WS_HEXP), (const char*)(ws + WS_WDN), 512, ((rem > 0 && R >= 1) ? 2 * Ne : 0) + vcu, G, tp[32] * 8};
        EpiDown E{(bf16_t*)(ws + WS_YS), (const int*)(ws + WS_CTL), (const int*)(ws + WS_LIST), (const float*)(ws + WS_LISTW)}; pg8::gemm_phase<EpiDown, MoeSched<8, false>>(lds, 512, S, E); } SYNC(9);
#if REP_PHASE == 10
    if (IN(10)) { p9_final(a, vcu, G, (float*)(ws + WS_WGU)); GSYNC(); }
#endif
#if REP_PHASE == 99
    for (int q = 0; q < 20; ++q) GSYNC();
#endif
    if (IN(10)) { p9_final(a, vcu, G, a.out); }
#undef IN
#undef SYNC
}

static int g_grid = 0;
static bool setup() {
    if (g_grid) return g_grid > 0;
    int dev = 0, cus = 0, per_cu = 0;
    if (hipGetDevice(&dev) != hipSuccess || hipDeviceGetAttribute(&cus, hipDeviceAttributeMultiprocessorCount, dev) != hipSuccess) { g_grid = -1; return false; }
    if (hipFuncSetAttribute((const void*)fwd, hipFuncAttributeMaxDynamicSharedMemorySize, LDS_BYTES) != hipSuccess) { fprintf(stderr, "hipFuncSetAttribute failed\n"); g_grid = -1; return false; }
    if (hipOccupancyMaxActiveBlocksPerMultiprocessor(&per_cu, (const void*)fwd, 512, LDS_BYTES) != hipSuccess || per_cu < 1) { fprintf(stderr, "occupancy query: %d\n", per_cu); (void)hipGetLastError(); g_grid = -1; return false; }
    g_grid = cus;
    return true;
}
static void run(void* const* d_in, float* out, unsigned char* ws, hipStream_t st, int lo, int hi, bool coop) {
    if (!setup()) return;
    (void)hipMemsetAsync(ws + WS_CTL, 0, CTL_ZERO_BYTES, st);
    Args a{};
    for (int i = 0; i < 25; ++i) a.in[i] = (const float*)d_in[i];
    a.out = out; a.ws = ws;
    if (coop) { a.ph_lo = lo; a.ph_hi = hi;
        hipLaunchKernelGGL(fwd, dim3(g_grid), dim3(512), LDS_BYTES, st, a);
    } else {
        for (int p = lo; p < hi; ++p) { a.ph_lo = p; a.ph_hi = p + 1; hipLaunchKernelGGL(fwd, dim3(g_grid), dim3(512), LDS_BYTES, st, a); }
    }
}
}
#ifndef DBG_STAGE
#define DBG_STAGE 0
#endif
#ifndef N_LAUNCHES
#define N_LAUNCHES 1
#endif
#if DBG_STAGE
namespace dbg {
template <typename TIn> __global__ void k_sample(const TIn* src, int ld, int col0, int ncols, int stride, float* dst) {
    const int i = blockIdx.x; const size_t row = (size_t)i * stride;
    for (int c = threadIdx.x; c < ncols; c += blockDim.x) { float v; if (sizeof(TIn) == 2) v = __builtin_bit_cast(float, (unsigned)(*(const unsigned short*)&src[row * ld + col0 + c]) << 16); else v = (float)(*(const float*)&src[row * ld + col0 + c]); dst[(size_t)i * ncols + c] = v; }
}
__global__ void k_cmp(const float* smp, int sld, int scol0, int n, int stride, const float* ref, int ldr, int rcol0, const float* rowscale, float* acc) {
    __shared__ float r0[256], r1[256];
    const int i = blockIdx.x; const size_t row = (size_t)i * stride; const float sc = rowscale ? rowscale[row] : 1.f;
    float d2 = 0.f, f2 = 0.f;
    for (int c = threadIdx.x; c < n; c += blockDim.x) { const float r = ref[row * ldr + rcol0 + c] * sc, s = smp[(size_t)i * sld + scol0 + c]; const float d = s - r; d2 += d * d; f2 += r * r; }
    r0[threadIdx.x] = d2; r1[threadIdx.x] = f2; __syncthreads();
    for (int o = 128; o > 0; o >>= 1) { if (threadIdx.x < o) { r0[threadIdx.x] += r0[threadIdx.x + o]; r1[threadIdx.x] += r1[threadIdx.x + o]; } __syncthreads(); }
    if (threadIdx.x == 0) { atomicAdd(&acc[0], r0[0]); atomicAdd(&acc[1], r1[0]); }
}
__global__ void k_scale(float* out, const float* acc, int nchk, int raw, float tol) {
    float delta = 0.f;
    if (raw >= 0) { const float e = sqrtf(acc[2 * raw] / fmaxf(acc[2 * raw + 1], 1e-30f)); delta = 4.f * fminf(e, 2.f); if (!(e == e)) delta = 9.f; }
    else for (int i = 0; i < nchk; ++i) { const float e = sqrtf(acc[2 * i] / fmaxf(acc[2 * i + 1], 1e-30f)); if (!(e <= tol)) { delta = 0.1f * (i + 1) + 0.05f * ((e == e) ? fminf(e, 1.f) : 1.f); break; } }
    const size_t idx = (size_t)blockIdx.x * blockDim.x + threadIdx.x;
    out[idx] *= (1.f + delta);
}
struct Ctx { unsigned char* ws; float* out; float* smp; float* acc; };
#ifndef DBG_RAW
#define DBG_RAW -1
#endif
#ifndef DBG_TOL
#define DBG_TOL 0.02f
#endif
constexpr size_t SM0 = 0, SM1 = 2 * 1024 * 1024 + 65536;
static void hook(int stage, void* vctx, hipStream_t st) {
    Ctx& c = *(Ctx*)vctx; unsigned char* ws = c.ws;
    const float* bufA = (const float*)(ws + nv::W_A); const float* proj = (const float*)(ws + nv::W_B); const float* ymr = (const float*)(ws + nv::W_C);
#if DBG_STAGE == 3
    if (stage == 2) k_cmp<<<964, 256, 0, st>>>(c.smp + SM0, 2048, 0, 2048, 17, bufA, 2048, 0, nullptr, c.acc + 0);
    if (stage == 3) { k_cmp<<<529, 256, 0, st>>>(c.smp + SM1, 6144, 0, 4096, 31, proj, nv::INW, 0, nullptr, c.acc + 2);
                      k_cmp<<<529, 256, 0, st>>>(c.smp + SM1, 6144, 4096, 2048, 31, proj, nv::INW, 4104, nullptr, c.acc + 4); }
#elif DBG_STAGE == 6
    if (stage == 6) { k_cmp<<<964, 256, 0, st>>>(c.smp + SM0, 2048, 0, 1024, 17, ymr, 2048, 0, nullptr, c.acc + 0);
                      k_cmp<<<964, 256, 0, st>>>(c.smp + SM0, 2048, 1024, 1024, 17, ymr, 2048, 1024, nullptr, c.acc + 2); }
#elif DBG_STAGE == 7
    if (stage == 7) k_cmp<<<964, 256, 0, st>>>(c.smp + SM0, 2048, 0, 2048, 17, c.out, 2048, 0, nullptr, c.acc + 0);
#elif DBG_STAGE == 8
    if (stage == 8) k_cmp<<<964, 256, 0, st>>>(c.smp + SM0, 2048, 0, 2048, 17, bufA, 2048, 0, nullptr, c.acc + 0);
    if (stage == 9) { k_cmp<<<964, 256, 0, st>>>(c.smp + SM1, 4, 0, 2, 17, (const float*)(ws + nv::W_R4), 4, 0, nullptr, c.acc + 2);
                      k_cmp<<<964, 256, 0, st>>>(c.smp + SM1, 4, 2, 2, 17, (const float*)(ws + nv::W_R4), 4, 2, nullptr, c.acc + 4); }
#elif DBG_STAGE == 10
    if (stage == 10) k_cmp<<<1928, 256, 0, st>>>(c.smp + SM0, 2048, 0, 2048, 17, proj + (size_t)4 * nv::T_ * 512, 2048, 0, (const float*)(ws + nv::W_GW), c.acc + 0);
#endif
}
}
#endif

extern "C" void kernel_launch(void* const* d_in, const int* in_sizes, int n_in, void* d_out, int out_size, void* d_ws, size_t ws_size, hipStream_t stream) {
    if (n_in != 25 || ws_size < fk::WS_END) { fprintf(stderr, "kernel_launch: unexpected n_in %d / ws_size %zu\n", n_in, ws_size); return; }
    unsigned char* ws = (unsigned char*)d_ws; float* out = (float*)d_out;
#if DBG_STAGE == 0
    fk::run(d_in, out, ws, stream, 0, fk::NPHASE, N_LAUNCHES == 1);
#else
    if (ws_size < nv::W_END + 24 * nv::MiB_) { fprintf(stderr, "debug build: ws too small\n"); return; }
    float* smp = (float*)(ws + ws_size - 24 * nv::MiB_); float* acc = smp + 6 * 1024 * 1024 - 64;
    (void)hipMemsetAsync(acc, 0, 256, stream);
#if DBG_STAGE == 3
    fk::run(d_in, out, ws, stream, 0, 3, N_LAUNCHES == 1);
    dbg::k_sample<unsigned short><<<964, 256, 0, stream>>>((const unsigned short*)(ws + fk::WS_HN), 2048, 0, 2048, 17, smp + dbg::SM0);
    dbg::k_sample<unsigned short><<<529, 256, 0, stream>>>((const unsigned short*)(ws + fk::WS_PROJ), 6144, 0, 6144, 31, smp + dbg::SM1);
    const int nchk = 3;
#elif DBG_STAGE == 6
    fk::run(d_in, out, ws, stream, 0, 6, N_LAUNCHES == 1);
    dbg::k_sample<unsigned short><<<964, 256, 0, stream>>>((const unsigned short*)(ws + fk::WS_HN), 2048, 0, 2048, 17, smp + dbg::SM0);
    const int nchk = 2;
#elif DBG_STAGE == 7
    fk::run(d_in, out, ws, stream, 0, 7, N_LAUNCHES == 1);
    dbg::k_sample<float><<<964, 256, 0, stream>>>(out, 2048, 0, 2048, 17, smp + dbg::SM0);
    const int nchk = 1;
#elif DBG_STAGE == 8
    fk::run(d_in, out, ws, stream, 0, 8, N_LAUNCHES == 1);
    dbg::k_sample<unsigned short><<<964, 256, 0, stream>>>((const unsigned short*)(ws + fk::WS_HN), 2048, 0, 2048, 17, smp + dbg::SM0);
    dbg::k_sample<float><<<964, 256, 0, stream>>>((const float*)(ws + fk::WS_ROUTE), 4, 0, 4, 17, smp + dbg::SM1);
    const int nchk = 3;
#elif DBG_STAGE == 10
    fk::run(d_in, out, ws, stream, 0, 10, N_LAUNCHES == 1);
    dbg::k_sample<unsigned short><<<1928, 256, 0, stream>>>((const unsigned short*)(ws + fk::WS_YS), 2048, 0, 2048, 17, smp + dbg::SM0);
    const int nchk = 1;
#endif
    nv::In I; { const float** p = (const float**)&I; for (int i = 0; i < 25; ++i) p[i] = (const float*)d_in[i]; }
    dbg::Ctx ctx{ws, out, smp, acc};
    nv::run(I, out, ws, stream, dbg::hook, &ctx);
    dbg::k_scale<<<(fk::T * fk::DM) / 256, 256, 0, stream>>>(out, acc, nchk, DBG_RAW, DBG_TOL);
#endif
}
```

```cpp
#define DBG_STAGE 0
#define N_LAUNCHES 1
#define DBG_RAW -1
#include <hip/hip_runtime.h>
#include <hip/hip_cooperative_groups.h>
#include <cstdio>
#include <cstdint>
#include <cmath>
#define LAS __attribute__((address_space(3)))
#define GAS __attribute__((address_space(1)))
typedef unsigned short bf16_t;
typedef short bf16x8 __attribute__((ext_vector_type(8)));
typedef float f32x4 __attribute__((ext_vector_type(4)));
typedef float f32x2 __attribute__((ext_vector_type(2)));
typedef float f32x16 __attribute__((ext_vector_type(16)));
typedef unsigned u32x4 __attribute__((ext_vector_type(4)));
typedef unsigned u32x2 __attribute__((ext_vector_type(2)));

__device__ __forceinline__ unsigned f2bf(float f) { unsigned u = __builtin_bit_cast(unsigned, f); return (u + 0x7fffu + ((u >> 16) & 1u)) >> 16; }
__device__ __forceinline__ unsigned pk2(float lo, float hi) { return f2bf(lo) | (f2bf(hi) << 16); }
__device__ __forceinline__ float bflo(unsigned u) { return __builtin_bit_cast(float, u << 16); }
__device__ __forceinline__ float bfhi(unsigned u) { return __builtin_bit_cast(float, u & 0xffff0000u); }
__device__ __forceinline__ float bf1(bf16_t b) { return __builtin_bit_cast(float, (unsigned)b << 16); }
__device__ __forceinline__ float wave_sum(float v) {
#pragma unroll
    for (int o = 1; o < 64; o <<= 1) v += __shfl_xor(v, o);
    return v;
}
__device__ __forceinline__ float frcp(float x) { return __builtin_amdgcn_rcpf(x); }
__device__ __forceinline__ float fsigmoid(float x) { return frcp(1.f + __expf(-x)); }
__device__ __forceinline__ float fsilu(float x) { return x * frcp(1.f + __expf(-x)); }
__device__ __forceinline__ float flogsigmoid(float x) { return fminf(x, 0.f) - log1pf(expf(-fabsf(x))); }
__device__ __forceinline__ float fgelu_tanh(float x) { const float u = 0.7978845608028654f * (x + 0.044715f * x * x * x); const float e = __expf(2.f * u); const float th = 1.f - 2.f * frcp(e + 1.f); return 0.5f * x * (1.f + th); }
template <int CTRL, int ROW_MASK> __device__ __forceinline__ float dpp_add(float x) { const int v = __builtin_amdgcn_update_dpp(0, __builtin_bit_cast(int, x), CTRL, ROW_MASK, 0xf, true); return x + __builtin_bit_cast(float, v); }
__device__ __forceinline__ float half_sum31(float x) {
    x = dpp_add<0x111, 0xf>(x);
    x = dpp_add<0x112, 0xf>(x);
    x = dpp_add<0x114, 0xf>(x);
    x = dpp_add<0x118, 0xf>(x);
    x = dpp_add<0x142, 0xa>(x);
    return x;
}

namespace pg8 {
constexpr int BM = 256, BK = 64, HALF = 128, HTB = HALF * BK * 2  , STAGE_BYTES = 8 * HTB, NXCD = 8, WGM = 8;
__host__ __device__ __forceinline__ int lds_byte(int r, int c) { const int st = (r >> 4) * 2 + (c >> 5), rr = r & 15, cc = c & 31, ob = rr * 64 + cc * 2; return st * 1024 + (ob ^ (((ob >> 9) & 1) << 5)); }
__host__ __device__ __forceinline__ void stage_rc(int b, int& R, int& C) { const int st = b / 1024, sb = b % 1024, swz = sb ^ (((sb >> 9) & 1) << 5); R = (st >> 1) * 16 + swz / 64; C = (st & 1) * 32 + (swz % 64) / 2; }
__host__ __device__ __forceinline__ int perm32(int rho) { const int n = rho >> 4, i = rho & 15; return 8 * (i >> 2) + 4 * n + (i & 3); }

struct Unit { int pm, pn, e, mt; };

template <class Epi, class Sched>
__device__ __forceinline__ void gemm_phase(LAS unsigned char* lds, const int K, const Sched& S, const Epi& E) {
    int tid_o = threadIdx.x; asm volatile("" : "+v"(tid_o));
    const int tid = tid_o, wid = __builtin_amdgcn_readfirstlane(tid >> 6), lane = tid & 63, wr = wid >> 2, wc = wid & 3, fr = lane & 15, fq = lane >> 4;
    const int nt = K / BK;
    int Rr[2], Cc[2]; unsigned voffB[2];
#pragma unroll
    for (int i = 0; i < 2; ++i) { stage_rc(tid * 16 + i * 8192, Rr[i], Cc[i]); const int Rb = Epi::PERM ? ((Rr[i] & ~31) + perm32(Rr[i] & 31)) : Rr[i]; voffB[i] = (unsigned)(Rb * K + Cc[i]) * 2u; }
    const size_t kstep = (size_t)(BK * 2);
    const size_t hstep = (size_t)HALF * K * 2;
    const unsigned ldsw = (unsigned)wid * 1024u;
    const int aoff = lds_byte(wr * 64 + fr, fq * 8), boff = lds_byte(wc * 32 + fr, fq * 8);
#define PG8_SA(b, h) (((b) * 2 + (h)) * HTB)
#define PG8_SB(b, h) ((4 + (b) * 2 + (h)) * HTB)
#define PG8_STAGE(bufoff, gbase, voff) do { const char* _gb = (const char*)(gbase); asm volatile("" : "+s"(_gb));     \
        _Pragma("unroll") for (int _i = 0; _i < 2; ++_i) \
        __builtin_amdgcn_global_load_lds((const unsigned*)(_gb + (voff)[_i]), (LAS unsigned*)(lds + (bufoff) + ldsw + _i * 8192), 16, 0, 0); } while (0)
#define PG8_LDA(dst, b, h) do { _Pragma("unroll") for (int m = 0; m < 4; ++m) _Pragma("unroll") for (int k = 0; k < 2; ++k) dst[m][k] = *(const LAS bf16x8*)(lds + PG8_SA(b, h) + aoff + m * 2048 + k * 1024); } while (0)
#define PG8_LDB(dst, b, h) do { _Pragma("unroll") for (int n = 0; n < 2; ++n) _Pragma("unroll") for (int k = 0; k < 2; ++k) dst[n][k] = *(const LAS bf16x8*)(lds + PG8_SB(b, h) + boff + n * 2048 + k * 1024); } while (0)
#define PG8_MMA(ai, bj, At, Bt) do { __builtin_amdgcn_s_setprio(1); _Pragma("unroll") for (int m = 0; m < 4; ++m) _Pragma("unroll") for (int n = 0; n < 2; ++n) _Pragma("unroll") for (int k = 0; k < 2; ++k) \
        acc[ai][bj][m][n] = __builtin_amdgcn_mfma_f32_16x16x32_bf16(Bt[n][k], At[m][k], acc[ai][bj][m][n], 0, 0, 0); __builtin_amdgcn_s_setprio(0); } while (0)
#define PG8_WAIT_V(n) asm volatile("s_waitcnt vmcnt(" #n ")" ::: "memory")
#define PG8_WAIT_L(n) asm volatile("s_waitcnt lgkmcnt(" #n ")" ::: "memory")
#define PG8_BAR __builtin_amdgcn_s_barrier()
#define PG8_SCHED __builtin_amdgcn_sched_barrier(0)
    Unit cur, nxt; int ui = 0;
    if (!S.next(0, cur)) return;
    f32x4 acc[2][2][4][2];
#pragma unroll
    for (int a = 0; a < 2; ++a)
#pragma unroll
        for (int b = 0; b < 2; ++b)
#pragma unroll
            for (int m = 0; m < 4; ++m)
#pragma unroll
                for (int n = 0; n < 2; ++n) acc[a][b][m][n] = (f32x4){0.f, 0.f, 0.f, 0.f};
    bf16x8 At[4][2], B0[2][2], B1[2][2];
    unsigned vA[2][2], nvA[2][2];
    typename Epi::State est; E.pre(est, cur, wr, fr);
    S.a_off(cur, Rr, Cc, K, vA);
    const char* cA = S.a_base(cur); const char* cB = S.b_base(cur);
    PG8_STAGE(PG8_SB(0, 0), cB, voffB); PG8_STAGE(PG8_SB(0, 1), cB + hstep, voffB); PG8_STAGE(PG8_SA(0, 0), cA, vA[0]); PG8_STAGE(PG8_SA(0, 1), cA, vA[1]);
    if (wr == 1) PG8_BAR;
    PG8_WAIT_V(2); PG8_BAR;
    PG8_STAGE(PG8_SB(1, 0), cB + kstep, voffB); PG8_STAGE(PG8_SA(1, 0), cA + kstep, vA[0]); PG8_STAGE(PG8_SB(1, 1), cB + hstep + kstep, voffB);
    PG8_WAIT_V(6); PG8_BAR;
    for (;;) {
        const bool has_next = S.next(ui + 1, nxt);
        if (!has_next) nxt = cur;
        const char* nA = S.a_base(nxt); const char* nB = S.b_base(nxt);
        S.a_off(nxt, Rr, Cc, K, nvA);
        for (int t = 0; t < nt; t += 2) {
            const bool last = (t == nt - 2);
            const char* a1 = cA + (size_t)(t + 1) * kstep;
            const char* a2 = last ? nA : cA + (size_t)(t + 2) * kstep; const char* b2 = last ? nB : cB + (size_t)(t + 2) * kstep;
            const char* a3 = a2 + kstep; const char* b3 = b2 + kstep;
            unsigned w0[2], w1[2];
#pragma unroll
            for (int i = 0; i < 2; ++i) { w0[i] = last ? nvA[0][i] : vA[0][i]; w1[i] = last ? nvA[1][i] : vA[1][i]; }
            PG8_LDB(B0, 0, 0); PG8_LDB(B1, 0, 1); PG8_SCHED; PG8_LDA(At, 0, 0); PG8_STAGE(PG8_SA(1, 1), a1, vA[1]);
            PG8_WAIT_V(8); PG8_WAIT_L(0); PG8_BAR; PG8_MMA(0, 0, At, B0); PG8_MMA(0, 1, At, B1); PG8_BAR; PG8_SCHED;
            PG8_LDA(At, 0, 1); PG8_STAGE(PG8_SB(0, 0), b2, voffB); PG8_STAGE(PG8_SB(0, 1), b2 + hstep, voffB); PG8_STAGE(PG8_SA(0, 0), a2, w0);
            PG8_WAIT_V(8); PG8_WAIT_L(0); PG8_BAR; PG8_MMA(1, 0, At, B0); PG8_MMA(1, 1, At, B1); PG8_BAR; PG8_SCHED;
            PG8_LDB(B0, 1, 0); PG8_LDB(B1, 1, 1); PG8_SCHED; PG8_LDA(At, 1, 0); PG8_STAGE(PG8_SA(0, 1), a2, w1);
            PG8_WAIT_V(8); PG8_WAIT_L(0); PG8_BAR; PG8_MMA(0, 0, At, B0); PG8_MMA(0, 1, At, B1); PG8_BAR; PG8_SCHED;
            PG8_LDA(At, 1, 1); PG8_STAGE(PG8_SB(1, 0), b3, voffB); PG8_STAGE(PG8_SB(1, 1), b3 + hstep, voffB); PG8_STAGE(PG8_SA(1, 0), a3, w0);
            PG8_WAIT_V(8); PG8_WAIT_L(0); PG8_BAR; PG8_MMA(1, 0, At, B0); PG8_MMA(1, 1, At, B1); PG8_BAR; PG8_SCHED;
        }
        if (wr == 0) PG8_BAR;
        E(acc, cur, wr, wc, fr, fq, est);
        if (!has_next) break;
#pragma unroll
        for (int a = 0; a < 2; ++a)
#pragma unroll
            for (int b = 0; b < 2; ++b)
#pragma unroll
                for (int m = 0; m < 4; ++m)
#pragma unroll
                    for (int n = 0; n < 2; ++n) acc[a][b][m][n] = (f32x4){0.f, 0.f, 0.f, 0.f};
        cur = nxt; cA = nA; cB = nB; ++ui; E.pre(est, cur, wr, fr);
#pragma unroll
        for (int h = 0; h < 2; ++h)
#pragma unroll
            for (int i = 0; i < 2; ++i) vA[h][i] = nvA[h][i];
        if (wr == 1) PG8_BAR;
    }
    PG8_WAIT_V(0);
    PG8_BAR;
#undef PG8_SA
#undef PG8_SB
#undef PG8_STAGE
#undef PG8_LDA
#undef PG8_LDB
#undef PG8_MMA
#undef PG8_WAIT_V
#undef PG8_WAIT_L
#undef PG8_BAR
#undef PG8_SCHED
}
}
namespace fk {
constexpr int T = 16384, SEQ = 8192, DM = 2048, NPROJ = 6144, INW = 6152;
constexpr float EPS = 1e-6f;
constexpr size_t MiB = 1u << 20, KiB = 1u << 10;
constexpr size_t WS_CTL = 0, WS_DONE = 1024, WS_BAR = 4096, CTL_ZERO_BYTES = 32768;
constexpr size_t WS_MODP = 1 * MiB;
constexpr size_t WS_MOD = 2 * MiB;
constexpr size_t WS_WG8 = 2 * MiB + 256 * KiB;
constexpr size_t WS_WRH = 2 * MiB + 512 * KiB, WS_WRL = WS_WRH + 192 * KiB;
constexpr size_t WS_GTB = 3 * MiB, WS_GTW = 3 * MiB + 256 * KiB, WS_GTA = 3 * MiB + 512 * KiB;
constexpr size_t WS_BLAST = 3 * MiB + 768 * KiB, WS_ALAST = WS_BLAST + 4 * KiB, WS_DTOT = WS_BLAST + 8 * KiB, WS_CVEC = WS_BLAST + 9 * KiB;
constexpr size_t WS_LNS = 4 * MiB;
constexpr size_t WS_LRUA = 4 * MiB + 256 * KiB, WS_LRUH = 4 * MiB + 512 * KiB, WS_LRUC = 4 * MiB + 768 * KiB;
constexpr size_t WS_ROUTE = 5 * MiB;
constexpr size_t WS_LIST = 6 * MiB;
constexpr size_t WS_LW = 2 * MiB + 896 * KiB;
constexpr size_t WS_LISTW = 553 * MiB;
constexpr size_t WS_WLRU = 8 * MiB;
constexpr size_t WS_WIN = 9 * MiB;
constexpr size_t WS_WOUT = 33 * MiB;
constexpr size_t WS_WGU = 41 * MiB;
constexpr size_t WS_WDN = 169 * MiB;
constexpr size_t WS_HN = 233 * MiB;
constexpr size_t WS_PROJ = 297 * MiB;
constexpr size_t WS_HEXP = WS_PROJ, WS_YS = WS_PROJ + 40 * MiB;
constexpr size_t WS_LST = 489 * MiB;
constexpr size_t WS_X1B = WS_LST;
constexpr size_t WS_HLOC = 555 * MiB, WS_ACUM = 587 * MiB;
constexpr size_t WS_END = 619 * MiB;
constexpr int LDS_BYTES = 163840;
constexpr int L_CTL = 160 * 1024 - 1024;

struct Args { const float* in[25]; float* out; unsigned char* ws; int ph_lo, ph_hi; };
enum { I_X = 0, I_C, I_WADA, I_BADA, I_WIN, I_BGATES, I_CONVQK, I_MHG, I_LCW, I_LCB, I_WLA, I_BLA, I_WLX, I_BLX, I_LAM, I_LNG, I_WOUT, I_WGRP, I_BGRP, I_WRT, I_BRT, I_WEG, I_WEU, I_WED, I_FG };

#define LDS_WAIT() asm volatile("s_waitcnt lgkmcnt(0)" ::: "memory")
#define NT_LD(p) __builtin_nontemporal_load(p)
#define NT_ST(v, p) __builtin_nontemporal_store(v, p)
typedef __bf16 bf16x2_t __attribute__((ext_vector_type(2)));
__device__ __forceinline__ unsigned cvtpk(float lo, float hi) { f32x2 v = {lo, hi}; bf16x2_t b = __builtin_convertvector(v, bf16x2_t); return __builtin_bit_cast(unsigned, b); }

struct TrItem { const float* W; bf16_t* WT; int ldw, ldt; };
__device__ __forceinline__ void tr_load(const TrItem& t, f32x4 (&v)[16], int lane) {
#pragma unroll
    for (int i = 0; i < 16; ++i) v[i] = NT_LD((const f32x4*)(t.W + (size_t)(4 * i + (lane >> 4)) * t.ldw + (lane & 15) * 4));
}
__device__ __forceinline__ void tr_store(const TrItem& t, const f32x4 (&v)[16], LAS float* scr, int lane) {
#pragma unroll
    for (int i = 0; i < 16; ++i) { LAS float* sp = scr + (4 * i + (lane >> 4)) * 65 + (lane & 15) * 4; sp[0] = v[i].x; sp[1] = v[i].y; sp[2] = v[i].z; sp[3] = v[i].w; }
    LDS_WAIT(); asm volatile("" ::: "memory");
#pragma unroll
    for (int j = 0; j < 8; ++j) { const int pair = lane + 64 * j, c = pair & 7, n = pair >> 3; const LAS float* s = scr + (8 * c) * 65 + n;
        u32x4 o; o.x = cvtpk(s[0 * 65], s[1 * 65]); o.y = cvtpk(s[2 * 65], s[3 * 65]); o.z = cvtpk(s[4 * 65], s[5 * 65]); o.w = cvtpk(s[6 * 65], s[7 * 65]);
        NT_ST(o, (u32x4*)(t.WT + (size_t)n * t.ldt + 8 * c)); }
    LDS_WAIT(); asm volatile("" ::: "memory");
}
constexpr int TR_IN = 32 * 96, TR_OUT = 32 * 32, TR_L = 64, TR_G = 32 * 256, TR_U = TR_G, TR_D = 32 * 256;
#ifndef TR_KEEP
#define TR_KEEP 4480
#endif
constexpr int TR_EARLY = TR_IN + TR_OUT + TR_L + TR_KEEP, TR_ALL = TR_IN + TR_OUT + TR_L + TR_G + TR_U + TR_D;
__device__ __forceinline__ TrItem tr_mk(const float* W, int ldw, int k0, int n0src, bf16_t* WT, int ldt, int rowdst0) { TrItem t; t.W = W + (size_t)k0 * ldw + n0src; t.WT = WT + (size_t)rowdst0 * ldt + k0; t.ldw = ldw; t.ldt = ldt; return t; }
__device__ __forceinline__ TrItem tr_decode(const Args& a, int it) {
    unsigned char* ws = a.ws; int r = it;
    if (r < TR_IN) { const int kb = r / 96, nb = r % 96, n0 = 64 * nb; return tr_mk(a.in[I_WIN], INW, 64 * kb, n0 + (n0 >= 4096 ? 8 : 0), (bf16_t*)(ws + WS_WIN), 2048, n0); } r -= TR_IN;
    if (r < TR_OUT) { const int kb = r / 32, nb = r % 32; return tr_mk(a.in[I_WOUT], 2048, 64 * kb, 64 * nb, (bf16_t*)(ws + WS_WOUT), 2048, 64 * nb); } r -= TR_OUT;
    if (r < TR_L) { const int mi = r / 4, q = r % 4, kb = q / 2, nb = q % 2, n = mi >> 1, g = mi & 1;
        return tr_mk((g ? a.in[I_WLX] : a.in[I_WLA]) + (size_t)n * 16384, 128, 64 * kb, 64 * nb, (bf16_t*)(ws + WS_WLRU), 128, (n * 2 + g) * 128 + 64 * nb); } r -= TR_L;
    if (r < TR_G) { const int e = r / 256, q = r % 256, kb = q / 8, nb = q % 8, n0 = 64 * nb;
        return tr_mk(a.in[I_WEG] + (size_t)e * 2048 * 512, 512, 64 * kb, n0, (bf16_t*)(ws + WS_WGU), 2048, e * 1024 + (n0 / 128) * 256 + (n0 % 128)); } r -= TR_G;
    if (r < TR_U) { const int e = r / 256, q = r % 256, kb = q / 8, nb = q % 8, n0 = 64 * nb;
        return tr_mk(a.in[I_WEU] + (size_t)e * 2048 * 512, 512, 64 * kb, n0, (bf16_t*)(ws + WS_WGU), 2048, e * 1024 + (n0 / 128) * 256 + 128 + (n0 % 128)); } r -= TR_U;
    { const int e = r / 256, q = r % 256, kb = q / 32, nb = q % 32;
        return tr_mk(a.in[I_WED] + (size_t)e * 512 * 2048, 2048, 64 * kb, 64 * nb, (bf16_t*)(ws + WS_WDN), 512, e * 2048 + 64 * nb); }
}
__device__ __forceinline__ void p2_convert(const Args& a, LAS unsigned char* lds, int cw, int ncw) {
    int tid_o = threadIdx.x; asm volatile("" : "+v"(tid_o));
    const int lane = tid_o & 63, wave = __builtin_amdgcn_readfirstlane(tid_o >> 6);
    LAS float* scr = (LAS float*)(lds + wave * 16896);
    int it = TR_EARLY + cw; if (it >= TR_ALL) return;
    f32x4 va[16], vb[16]; TrItem ta = tr_decode(a, it), tb = ta; tr_load(ta, va, lane);
#pragma unroll 1
    for (;;) {
        it += ncw; const bool hb = it < TR_ALL; if (hb) { tb = tr_decode(a, it); tr_load(tb, vb, lane); }
        tr_store(ta, va, scr, lane); if (!hb) break;
        it += ncw; const bool ha = it < TR_ALL; if (ha) { ta = tr_decode(a, it); tr_load(ta, va, lane); }
        tr_store(tb, vb, scr, lane); if (!ha) break;
    }
}
__device__ __forceinline__ void p0_prologue(const Args& a, LAS unsigned char* lds, int vcu, int G, int nconv) {
    int tid_o = threadIdx.x; asm volatile("" : "+v"(tid_o));
    const int tid = tid_o, lane = tid & 63, wave = __builtin_amdgcn_readfirstlane(tid >> 6);
    LAS float* scr = (LAS float*)(lds + wave * 16896);
    const int gw = vcu * 8 + wave, NGW = G * 8;
    unsigned char* ws = a.ws;
    const int nGw = (2 * G < 384) ? 2 * G : 384;
    const bool isG = wave < 2 && (vcu * 2 + wave) < 384;
    if (wave < 2) for (int task = vcu * 2 + wave; task < 384; task += 2 * G) {
        const int cg = task % 48, ks = task / 48, n = cg * 256 + lane * 4;
        const float* c = a.in[I_C]; const float* wada = a.in[I_WADA];
        f32x4 a0 = {0.f, 0.f, 0.f, 0.f}, a1 = {0.f, 0.f, 0.f, 0.f};
#pragma unroll 1
        for (int k0 = ks * 256; k0 < ks * 256 + 256; k0 += 16) { f32x4 w[16];
#pragma unroll
            for (int q = 0; q < 16; ++q) w[q] = NT_LD((const f32x4*)(wada + (size_t)(k0 + q) * 12288 + n));
#pragma unroll
            for (int q = 0; q < 16; ++q) { const float s0 = fsilu(c[k0 + q]), s1 = fsilu(c[2048 + k0 + q]); a0 += s0 * w[q]; a1 += s1 * w[q]; } }
        float* modp = (float*)(ws + WS_MODP);
        *(f32x4*)(modp + (size_t)(ks * 2 + 0) * 12288 + n) = a0; *(f32x4*)(modp + (size_t)(ks * 2 + 1) * 12288 + n) = a1;
    }
    const int NITEMS = nconv ? TR_EARLY : TR_ALL;
    const int N1 = nconv ? 0 : ((G == 256) ? 5 * NGW : NITEMS);
    const int before = (2 * vcu + (wave < 2 ? wave : 2)) < nGw ? (2 * vcu + (wave < 2 ? wave : 2)) : nGw;
    const int it2_0 = N1 + (gw - before), it2_s = NGW - nGw;
    for (int pass = 0; pass < 2; ++pass)
    for (int it = pass ? it2_0 : gw; it < (pass ? NITEMS : N1); it += (pass ? it2_s : NGW)) {
        if (pass && isG) break;
        TrItem t = tr_decode(a, it); f32x4 v[16]; tr_load(t, v, lane); tr_store(t, v, scr, lane);
    }
    const int gt = vcu * 512 + tid, NGT = G * 512;
    float* wg8 = (float*)(ws + WS_WG8); bf16_t* wrh = (bf16_t*)(ws + WS_WRH); bf16_t* wrl = (bf16_t*)(ws + WS_WRL);
    for (int i = gt; i < 8 * 2048; i += NGT) { const int g = i >> 11, k = i & 2047; wg8[i] = a.in[I_WIN][(size_t)k * INW + 4096 + g]; }
    for (int i = gt; i < 48 * 2048; i += NGT) { const int c = i >> 11, k = i & 2047; const float w = c < 4 ? a.in[I_WGRP][k * 4 + c] : (c < 36 ? a.in[I_WRT][k * 32 + (c - 4)] : 0.f);
        const unsigned hi = f2bf(w); wrh[i] = (bf16_t)hi; wrl[i] = (bf16_t)f2bf(w - bf1((bf16_t)hi)); }
}

__device__ __forceinline__ void p1_hn_gates(const Args& a, LAS unsigned char* lds, int vcu, int G) {
    int tid_o = threadIdx.x; asm volatile("" : "+v"(tid_o));
    const int tid = tid_o, lane = tid & 63, wave = __builtin_amdgcn_readfirstlane(tid >> 6);
    unsigned char* ws = a.ws;
    LAS float* modv = (LAS float*)lds;
    LAS float* wgs = (LAS float*)(lds + 16384);
    LAS float* gts = (LAS float*)(lds + 16384 + 65536);
    const float* modp = (const float*)(ws + WS_MODP); const float* bada = a.in[I_BADA];
    for (int i = tid; i < 8 * 2048; i += 512) wgs[i] = ((const float*)(ws + WS_WG8))[i];
    for (int ch = vcu; ch < 256; ch += G) {
        const int b = ch >> 7;
        __syncthreads();
        for (int i = tid; i < 4096; i += 512) { float v = bada[i]; for (int ks = 0; ks < 8; ++ks) v += modp[(size_t)(ks * 2 + b) * 12288 + i]; modv[i] = v; }
        if (ch < 72) {
            const int bb = ch / 36, n = ch % 36; float p = 0.f;
            for (int k = tid; k < 2048; k += 512) { float sh = bada[6144 + k]; for (int ks = 0; ks < 8; ++ks) sh += modp[(size_t)(ks * 2 + bb) * 12288 + 6144 + k];
                p += sh * (n < 4 ? a.in[I_WGRP][k * 4 + n] : a.in[I_WRT][k * 32 + (n - 4)]); }
            p = wave_sum(p); LAS float* red = gts + 512;
            if (lane == 0) red[wave] = p;
            __syncthreads();
            if (tid == 0) { float q = 0.f; for (int w = 0; w < 8; ++w) q += red[w]; ((float*)(ws + WS_CVEC))[bb * 48 + n] = q + (n < 4 ? a.in[I_BGRP][n] : a.in[I_BRT][n - 4]); }
        }
        if (tid < 96) { const int o = ch * 96 + tid, bb = o / 12288, col = o % 12288; float v = bada[col]; for (int ks = 0; ks < 8; ++ks) v += modp[(size_t)(ks * 2 + bb) * 12288 + col]; ((float*)(ws + WS_MOD))[o] = v; }
        __syncthreads();
#pragma unroll 1
        for (int i4 = 0; i4 < 2; ++i4) {
            const int rowb = ch * 64 + wave * 8 + i4 * 4;
            f32x4 v[4][8]; float rs[4];
#pragma unroll
            for (int r = 0; r < 4; ++r) { const f32x4* xr = (const f32x4*)(a.in[I_X] + (size_t)(rowb + r) * DM) + lane;
#pragma unroll
                for (int j = 0; j < 8; ++j) v[r][j] = NT_LD(xr + 64 * j); }
#pragma unroll
            for (int r = 0; r < 4; ++r) { float s = 0.f;
#pragma unroll
                for (int j = 0; j < 8; ++j) s += (v[r][j].x * v[r][j].x + v[r][j].y * v[r][j].y) + (v[r][j].z * v[r][j].z + v[r][j].w * v[r][j].w);
                rs[r] = rsqrtf(wave_sum(s) * (1.f / DM) + EPS); }
#pragma unroll
            for (int j = 0; j < 8; ++j) { const f32x4 sh = *(const LAS f32x4*)(modv + 4 * lane + 256 * j), sc = *(const LAS f32x4*)(modv + 2048 + 4 * lane + 256 * j) + 1.f;
#pragma unroll
                for (int r = 0; r < 4; ++r) { v[r][j] = v[r][j] * rs[r] * sc + sh;
                    u32x2* o8 = (u32x2*)((bf16_t*)(ws + WS_HN) + (size_t)(rowb + r) * DM) + lane; o8[64 * j] = (u32x2){cvtpk(v[r][j].x, v[r][j].y), cvtpk(v[r][j].z, v[r][j].w)}; } }
            float gv[4] = {0.f, 0.f, 0.f, 0.f};
#pragma unroll
            for (int g = 0; g < 8; ++g) { float p[4] = {0.f, 0.f, 0.f, 0.f};
#pragma unroll
                for (int j = 0; j < 8; ++j) { const f32x4 w = *(const LAS f32x4*)(wgs + g * 2048 + 4 * lane + 256 * j);
#pragma unroll
                    for (int r = 0; r < 4; ++r) p[r] += (v[r][j].x * w.x + v[r][j].y * w.y) + (v[r][j].z * w.z + v[r][j].w * w.w); }
#pragma unroll
                for (int r = 0; r < 4; ++r) { const float q = wave_sum(p[r]); if (lane == g) gv[r] = q; } }
#pragma unroll
            for (int r = 0; r < 4; ++r) if (lane < 8) gts[(wave * 8 + i4 * 4 + r) * 8 + lane] = gv[r];
        }
        __syncthreads();
        if (wave < 4) {
            const int h = wave, row = ch * 64 + lane; const float* bg = a.in[I_BGATES];
            const float ig = gts[lane * 8 + h] + bg[h]; const float lf = flogsigmoid(gts[lane * 8 + 4 + h] + bg[4 + h]);
            float bc = lf;
#pragma unroll
            for (int o = 1; o < 64; o <<= 1) { const float t = __shfl_up(bc, o); if (lane >= o) bc += t; }
            const float w = ig - bc; float am = w;
#pragma unroll
            for (int o = 1; o < 64; o <<= 1) { const float t = __shfl_up(am, o); if (lane >= o) am = fmaxf(am, t); }
            ((float*)(ws + WS_GTB))[row * 4 + h] = bc; ((float*)(ws + WS_GTW))[row * 4 + h] = w; ((float*)(ws + WS_GTA))[row * 4 + h] = am;
            if (lane == 63) { const int bh = b * 4 + h, c = ch & 127; ((float*)(ws + WS_BLAST))[bh * 128 + c] = bc; ((float*)(ws + WS_ALAST))[bh * 128 + c] = am; }
        }
    }
    __syncthreads();
}

struct DenseSched {
    static constexpr bool GATHER = false;
    const char* A; const char* Bt; int K, nM, nN, nwg, G, c;
    __device__ __forceinline__ void init(const void* A_, const void* Bt_, int M, int N, int K_, int G_, int c_) { A = (const char*)A_; Bt = (const char*)Bt_; K = K_; nM = M / 256; nN = N / 256; nwg = nM * nN; G = G_; c = c_; }
    __device__ __forceinline__ bool next(int i, pg8::Unit& u) const {
        const long L = (long)i * G + c; if (L >= nwg) return false;
        int wgid = (int)L; { const int q = nwg / 8, r = nwg % 8, xcd = wgid % 8, off = wgid / 8; wgid = (xcd < r ? xcd * (q + 1) : r * (q + 1) + (xcd - r) * q) + off; }
        const int nig = 8 * nN, gid = wgid / nig, fm = gid * 8, gsz = (nM - fm) < 8 ? (nM - fm) : 8;
        u.pm = fm + ((wgid % nig) % gsz); u.pn = (wgid % nig) / gsz; u.e = 0; u.mt = 0; return true;
    }
    __device__ __forceinline__ const char* a_base(const pg8::Unit& u) const { return A + (size_t)u.pm * 256 * K * 2; }
    __device__ __forceinline__ const char* b_base(const pg8::Unit& u) const { return Bt + (size_t)u.pn * 256 * K * 2; }
    __device__ __forceinline__ void a_off(const pg8::Unit&, const int (&R)[2], const int (&C)[2], int K_, unsigned (&v)[2][2]) const {
#pragma unroll
        for (int h = 0; h < 2; ++h)
#pragma unroll
            for (int i = 0; i < 2; ++i) v[h][i] = (unsigned)((128 * h + R[i]) * K_ + C[i]) * 2u;
    }
};
#define EPI_NOSTATE struct State {}; __device__ __forceinline__ void pre(State&, const pg8::Unit&, int, int) const {}
struct EpiProj {
    static constexpr bool PERM = true; EPI_NOSTATE
    bf16_t* O; int ldc;
    __device__ __forceinline__ void operator()(const f32x4 (&acc)[2][2][4][2], const pg8::Unit& u, int wr, int wc, int fr, int fq, const State& est) const {
        const int row0 = u.pm * 256 + wr * 64 + fr, col0 = u.pn * 256 + wc * 32 + 8 * fq;
#pragma unroll
        for (int ai = 0; ai < 2; ++ai)
#pragma unroll
            for (int m = 0; m < 4; ++m) { bf16_t* rowp = O + (size_t)(row0 + ai * 128 + m * 16) * ldc + col0;
#pragma unroll
                for (int bj = 0; bj < 2; ++bj) { const f32x4 v0 = acc[ai][bj][m][0], v1 = acc[ai][bj][m][1];
                    u32x4 w; w.x = cvtpk(v0[0], v0[1]); w.y = cvtpk(v0[2], v0[3]); w.z = cvtpk(v1[0], v1[1]); w.w = cvtpk(v1[2], v1[3]);
                    *(u32x4*)(rowp + bj * 128) = w; } }
    }
};
struct EpiX1 {
    static constexpr bool PERM = true; EPI_NOSTATE
    const float* x; const float* mod; bf16_t* x1b;
    __device__ __forceinline__ void operator()(const f32x4 (&acc)[2][2][4][2], const pg8::Unit& u, int wr, int wc, int fr, int fq, const State& est) const {
        const int row0 = u.pm * 256 + wr * 64 + fr, col0 = u.pn * 256 + wc * 32 + 8 * fq;
        const float* g1 = mod + (size_t)((u.pm * 256) / SEQ) * 12288 + 4096;
#pragma unroll
        for (int bj = 0; bj < 2; ++bj) { const int col = col0 + bj * 128; const f32x4 ga = *(const f32x4*)(g1 + col), gb = *(const f32x4*)(g1 + col + 4);
#pragma unroll
            for (int ai = 0; ai < 2; ++ai)
#pragma unroll
                for (int m = 0; m < 4; ++m) { const size_t off = (size_t)(row0 + ai * 128 + m * 16) * DM + col; const f32x4 xa = NT_LD((const f32x4*)(x + off)), xb = NT_LD((const f32x4*)(x + off + 4));
                    const f32x4 va = xa + ga * acc[ai][bj][m][0], vb = xb + gb * acc[ai][bj][m][1];
                    *(u32x4*)(x1b + off) = (u32x4){cvtpk(va.x, va.y), cvtpk(va.z, va.w), cvtpk(vb.x, vb.y), cvtpk(vb.z, vb.w)}; } }
    }
};
template <int NT, bool GATH>
struct MoeSched {
    static constexpr bool GATHER = GATH;
    const LAS int* tp; const int* cnt; const int* list; const char* A; const char* Bt; int K, first, stride, end;
    __device__ __forceinline__ bool next(int i, pg8::Unit& u) const {
        const int L = first + i * stride; if (L >= end) return false;
        const int tile = L / NT; u.pn = L % NT;
        const int e = __builtin_amdgcn_readfirstlane((int)((const LAS unsigned short*)(tp + 160))[tile]);
        u.e = e; u.mt = tile - tp[e]; u.pm = tile; return true;
    }
    __device__ __forceinline__ const char* a_base(const pg8::Unit& u) const { return GATH ? A : A + (size_t)u.pm * 256 * K * 2; }
    __device__ __forceinline__ const char* b_base(const pg8::Unit& u) const { return Bt + ((size_t)u.e * NT + u.pn) * 256 * K * 2; }
    __device__ __forceinline__ void a_off(const pg8::Unit& u, const int (&R)[2], const int (&C)[2], int K_, unsigned (&v)[2][2]) const {
        if (GATH) { const int n = cnt[u.e]; const int* lp = list + (size_t)u.e * T + u.mt * 256;
#pragma unroll
            for (int h = 0; h < 2; ++h)
#pragma unroll
                for (int i = 0; i < 2; ++i) { const int r = 128 * h + R[i]; const int tok = (u.mt * 256 + r < n) ? (lp[r] >> 1) : 0; v[h][i] = (unsigned)(tok * K_ + C[i]) * 2u; }
        } else {
#pragma unroll
            for (int h = 0; h < 2; ++h)
#pragma unroll
                for (int i = 0; i < 2; ++i) v[h][i] = (unsigned)((128 * h + R[i]) * K_ + C[i]) * 2u;
        }
    }
};
struct EpiGateUp {
    static constexpr bool PERM = true; EPI_NOSTATE
    bf16_t* H;
    __device__ __forceinline__ void operator()(const f32x4 (&acc)[2][2][4][2], const pg8::Unit& u, int wr, int wc, int fr, int fq, const State& est) const {
        const int row0 = u.pm * 256 + wr * 64 + fr, col0 = u.pn * 128 + wc * 32 + 8 * fq;
#pragma unroll
        for (int ai = 0; ai < 2; ++ai)
#pragma unroll
            for (int m = 0; m < 4; ++m) { bf16_t* rowp = H + (size_t)(row0 + ai * 128 + m * 16) * 512 + col0;
                const f32x4 g0 = acc[ai][0][m][0], g1 = acc[ai][0][m][1], u0 = acc[ai][1][m][0], u1 = acc[ai][1][m][1];
                u32x4 w; w.x = cvtpk(fsilu(g0[0]) * u0[0], fsilu(g0[1]) * u0[1]); w.y = cvtpk(fsilu(g0[2]) * u0[2], fsilu(g0[3]) * u0[3]);
                w.z = cvtpk(fsilu(g1[0]) * u1[0], fsilu(g1[1]) * u1[1]); w.w = cvtpk(fsilu(g1[2]) * u1[2], fsilu(g1[3]) * u1[3]);
                *(u32x4*)rowp = w; }
    }
};
struct EpiDown {
    static constexpr bool PERM = true;
    struct State { unsigned pk[2][4]; };
    bf16_t* Y; const int* cnt; const int* list; const float* listw;
    __device__ __forceinline__ void pre(State& st, const pg8::Unit& u, int wr, int fr) const {
        const int n = cnt[u.e]; const size_t base = (size_t)u.e * T + u.mt * 256;
#pragma unroll
        for (int ai = 0; ai < 2; ++ai)
#pragma unroll
            for (int m = 0; m < 4; ++m) { const int r = ai * 128 + wr * 64 + m * 16 + fr; const bool ok = u.mt * 256 + r < n;
                const unsigned d = ok ? (unsigned)list[base + r] : 0xFFFFu; const float g = ok ? listw[base + r] : 0.f; st.pk[ai][m] = (cvtpk(0.f, g) & 0xffff0000u) | d; }
    }
    __device__ __forceinline__ void operator()(const f32x4 (&acc)[2][2][4][2], const pg8::Unit& u, int wr, int wc, int fr, int fq, const State& st) const {
        const int col0 = u.pn * 256 + wc * 32 + 8 * fq;
#pragma unroll
        for (int ai = 0; ai < 2; ++ai)
#pragma unroll
            for (int m = 0; m < 4; ++m) { const unsigned pk = st.pk[ai][m]; const unsigned dst = pk & 0xffffu;
                if (dst != 0xFFFFu) { const float gw = bfhi(pk); bf16_t* rowp = Y + (size_t)dst * DM + col0;
#pragma unroll
                    for (int bj = 0; bj < 2; ++bj) { const f32x4 v0 = acc[ai][bj][m][0] * gw, v1 = acc[ai][bj][m][1] * gw;
                        u32x4 w; w.x = cvtpk(v0[0], v0[1]); w.y = cvtpk(v0[2], v0[3]); w.z = cvtpk(v1[0], v1[1]); w.w = cvtpk(v1[2], v1[3]);
                        *(u32x4*)(rowp + bj * 128) = w; } } }
    }
};

constexpr int L_KWT = 0, L_VT = 36864, L_QS = 73728, L_KS = 107520, L_PS = 141312, L_F = 150528;
constexpr int L_WEXP = L_F, L_MT = L_F + 256, L_EI = L_F + 512, L_RDN = L_F + 768, L_BT = L_F + 1024, L_WK = L_F + 1280, L_NS = L_F + 1536, L_RSS = L_F + 2560, L_MCH = L_F + 4608, L_RN = L_F + 5248, L_GW = L_F + 5504, L_GA = L_GW + 1024, L_GB = L_GA + 1024, L_AL = L_GB + 1024;
static_assert(L_AL + 16 <= L_CTL, "mixer LDS map");

#define MLSTM_LOAD_RAW(cc) do { const int c_ = (cc), r0c_ = b * SEQ + c_ * 64, dp_ = tid & 127, tg_ = tid >> 7, d0_ = 2 * dp_, s0_ = 16 * tg_, tt0_ = c_ * 64 + s0_; \
          _Pragma("unroll") for (int q = 0; q < 19; ++q) { const int ti = tt0_ - 3 + q; rawk[q] = ti >= 0 ? (FULL ? NT_LD((const unsigned*)(PROJ + (size_t)(r0c_ + s0_ - 3 + q) * NPROJ + 1024 + h * 256 + d0_)) : *(const unsigned*)(PROJ + (size_t)(r0c_ + s0_ - 3 + q) * NPROJ + 1024 + h * 256 + d0_)) : 0u; } \
          } while (0)
#define MLSTM_LOAD_RAWV(cc) do { const int c_ = (cc), r0c_ = b * SEQ + c_ * 64, dp_ = tid & 127, tg_ = tid >> 7, d0_ = 2 * dp_, s0_ = 16 * tg_; \
          _Pragma("unroll") for (int q = 0; q < 16; ++q) rawv[q] = FULL ? NT_LD((const unsigned*)(PROJ + (size_t)(r0c_ + s0_ + q) * NPROJ + 2048 + h * 256 + d0_)) : *(const unsigned*)(PROJ + (size_t)(r0c_ + s0_ + q) * NPROJ + 2048 + h * 256 + d0_); } while (0)
#define MLSTM_LOAD_RAWQ(cc) do { const int c_ = (cc), r0c_ = b * SEQ + c_ * 64, dp_ = tid & 127, tg_ = tid >> 7, d0_ = 2 * dp_, s0_ = 16 * tg_, tt0_ = c_ * 64 + s0_; \
          _Pragma("unroll") for (int q = 0; q < 19; ++q) { const int ti = tt0_ - 3 + q; rawq[q] = ti >= 0 ? NT_LD((const unsigned*)(PROJ + (size_t)(r0c_ + s0_ - 3 + q) * NPROJ + h * 256 + d0_)) : 0u; } } while (0)
template <bool FULL>
__device__ __forceinline__ void mlstm_unit(const Args& a, LAS unsigned char* lds, int bh, int j) {
    int tid_o0 = threadIdx.x; asm volatile("" : "+v"(tid_o0));
    const int tid = tid_o0, lane = tid & 63, wave = __builtin_amdgcn_readfirstlane(tid >> 6), hh = lane >> 5, l31 = lane & 31;
    const int b = bh >> 2, h = bh & 3;
    unsigned char* ws = a.ws;
    const bf16_t* PROJ = (const bf16_t*)(ws + WS_PROJ);
    const float* BLAST = (const float*)(ws + WS_BLAST); const float* ALAST = (const float*)(ws + WS_ALAST);
    LAS float* mch = (LAS float*)(lds + L_MCH); LAS float* nsv = (LAS float*)(lds + L_NS);
    LAS float* WEXP = (LAS float*)(lds + L_WEXP); LAS float* MT = (LAS float*)(lds + L_MT); LAS float* EI = (LAS float*)(lds + L_EI); LAS float* RDN = (LAS float*)(lds + L_RDN);
    LAS float* BT = (LAS float*)(lds + L_BT); LAS float* WK = (LAS float*)(lds + L_WK); LAS float* RSS = (LAS float*)(lds + L_RSS); LAS float* RN = (LAS float*)(lds + L_RN);
    const int unit = bh * 32 + j;
    __syncthreads();
    if (wave == 0) {
        const float pa = BLAST[bh * 128 + 2 * lane], qa = ALAST[bh * 128 + 2 * lane] + pa, pb = BLAST[bh * 128 + 2 * lane + 1], qb = ALAST[bh * 128 + 2 * lane + 1] + pb;
        float P = pa + pb, Q = fmaxf(qa + pb, qb);
#pragma unroll
        for (int o = 1; o < 64; o <<= 1) { const float oP = __shfl_up(P, o), oQ = __shfl_up(Q, o); if (lane >= o) { Q = fmaxf(oQ + P, Q); P = oP + P; } }
        float eP = __shfl_up(P, 1), eQ = __shfl_up(Q, 1); if (lane == 0) { eP = 0.f; eQ = -INFINITY; }
        const float m0 = fmaxf(eP, eQ), m1 = fmaxf(m0 + pa, qa);
        mch[2 * lane] = m0; mch[2 * lane + 1] = m1;
    }
    f32x16 C[8];
#pragma unroll
    for (int dt = 0; dt < 8; ++dt)
#pragma unroll
        for (int r = 0; r < 16; ++r) C[dt][r] = 0.f;
    if (FULL && j > 0) {
        const bf16_t* st = (const bf16_t*)(ws + WS_LST) + (size_t)(unit - 1) * 65536;
#pragma unroll
        for (int dt = 0; dt < 8; ++dt)
#pragma unroll
            for (int q = 0; q < 4; ++q) { const u32x2 v = NT_LD((const u32x2*)(st + ((dt * 4 + q) * 512 + tid) * 4)); C[dt][4 * q] = bflo(v.x); C[dt][4 * q + 1] = bfhi(v.x); C[dt][4 * q + 2] = bflo(v.y); C[dt][4 * q + 3] = bfhi(v.y); }
    }
    if (tid < 256) nsv[tid] = (FULL && j > 0) ? ((const float*)(ws + WS_LNS))[(size_t)(unit - 1) * 256 + tid] : 0.f;
    if (tid < 256) { const int row = b * SEQ + j * 256 + tid;
        ((LAS float*)(lds + L_GW))[tid] = ((const float*)(ws + WS_GTW))[row * 4 + h]; ((LAS float*)(lds + L_GA))[tid] = ((const float*)(ws + WS_GTA))[row * 4 + h]; ((LAS float*)(lds + L_GB))[tid] = ((const float*)(ws + WS_GTB))[row * 4 + h]; }
    if (tid < 4) ((LAS float*)(lds + L_AL))[tid] = ALAST[bh * 128 + 4 * j + tid];
    float dtot_log = 0.f;
    __syncthreads();
#pragma unroll 1
    for (int i = 0; i < 4; ++i) {
        int tid_o = threadIdx.x; asm volatile("" : "+v"(tid_o));
        const int tid = tid_o, lane = tid & 63, hh = lane >> 5, l31 = lane & 31;
        const int c = 4 * j + i; const int r0c = b * SEQ + c * 64;
        const float mc = mch[c]; const float M63 = fmaxf(mc, ((const LAS float*)(lds + L_AL))[i]); const float decay = __expf(mc - M63);
        dtot_log += mc - M63;
        unsigned rawk[19], rawv[16], rawq[19]; MLSTM_LOAD_RAW(c); MLSTM_LOAD_RAWV(c); if (FULL) MLSTM_LOAD_RAWQ(c);
        float cwk[4][2], cwq[4][2];
        { const float* cw = a.in[I_CONVQK]; const int d0 = 2 * (tid & 127);
#pragma unroll
          for (int q = 0; q < 4; ++q) { cwk[q][0] = cw[q * 2048 + 1024 + h * 256 + d0]; cwk[q][1] = cw[q * 2048 + 1024 + h * 256 + d0 + 1]; if (FULL) { cwq[q][0] = cw[q * 2048 + h * 256 + d0]; cwq[q][1] = cw[q * 2048 + h * 256 + d0 + 1]; } } }
        if (tid < 64) { const float w = ((const LAS float*)(lds + L_GW))[i * 64 + tid], am = ((const LAS float*)(lds + L_GA))[i * 64 + tid], bt = ((const LAS float*)(lds + L_GB))[i * 64 + tid];
            const float Mt = fmaxf(mc, am); WEXP[tid] = w; MT[tid] = Mt; EI[tid] = __expf(mc - Mt); BT[tid] = bt; WK[tid] = __expf(w - M63); }
        __syncthreads();
        {
            const int dp = tid & 127, tg = tid >> 7, d0 = 2 * dp, s0 = 16 * tg;
            const int tt0 = c * 64 + s0;
            const float* cw = a.in[I_CONVQK];
            {
                const float (&w)[4][2] = cwk;
                const unsigned (&raw)[19] = rawk;
                unsigned pa[8], pb[8]; float ka = 0.f, kb = 0.f;
#pragma unroll
                for (int s = 0; s < 16; ++s) { float x0 = 0.f, x1 = 0.f;
#pragma unroll
                    for (int q = 0; q < 4; ++q) { x0 += w[q][0] * bflo(raw[s + q]); x1 += w[q][1] * bfhi(raw[s + q]); }
                    x0 = fsilu(x0) * 0.0625f; x1 = fsilu(x1) * 0.0625f;
                    if (FULL) *(LAS unsigned*)(lds + L_KS + (s0 + s) * 528 + d0 * 2) = cvtpk(x0, x1);
                    const float wk = WK[s0 + s]; x0 *= wk; x1 *= wk;
                    if (s & 1) { pa[s >> 1] = cvtpk(ka, x0); pb[s >> 1] = cvtpk(kb, x1); } else { ka = x0; kb = x1; } }
                *(LAS u32x4*)(lds + L_KWT + d0 * 144 + s0 * 2) = (u32x4){pa[0], pa[1], pa[2], pa[3]}; *(LAS u32x4*)(lds + L_KWT + d0 * 144 + s0 * 2 + 16) = (u32x4){pa[4], pa[5], pa[6], pa[7]};
                *(LAS u32x4*)(lds + L_KWT + (d0 + 1) * 144 + s0 * 2) = (u32x4){pb[0], pb[1], pb[2], pb[3]}; *(LAS u32x4*)(lds + L_KWT + (d0 + 1) * 144 + s0 * 2 + 16) = (u32x4){pb[4], pb[5], pb[6], pb[7]};
            }
            __builtin_amdgcn_sched_barrier(0);
            {
                const unsigned (&raw)[16] = rawv;
                unsigned pa[8], pb[8];
#pragma unroll
                for (int q = 0; q < 8; ++q) { pa[q] = (raw[2 * q] & 0xffffu) | (raw[2 * q + 1] << 16); pb[q] = (raw[2 * q] >> 16) | (raw[2 * q + 1] & 0xffff0000u); }
                *(LAS u32x4*)(lds + L_VT + d0 * 144 + s0 * 2) = (u32x4){pa[0], pa[1], pa[2], pa[3]}; *(LAS u32x4*)(lds + L_VT + d0 * 144 + s0 * 2 + 16) = (u32x4){pa[4], pa[5], pa[6], pa[7]};
                *(LAS u32x4*)(lds + L_VT + (d0 + 1) * 144 + s0 * 2) = (u32x4){pb[0], pb[1], pb[2], pb[3]}; *(LAS u32x4*)(lds + L_VT + (d0 + 1) * 144 + s0 * 2 + 16) = (u32x4){pb[4], pb[5], pb[6], pb[7]};
            }
            __builtin_amdgcn_sched_barrier(0);
            if (FULL) {
                const float (&w)[4][2] = cwq;
                const unsigned (&raw)[19] = rawq;
#pragma unroll
                for (int s = 0; s < 16; ++s) { float x0 = 0.f, x1 = 0.f;
#pragma unroll
                    for (int q = 0; q < 4; ++q) { x0 += w[q][0] * bflo(raw[s + q]); x1 += w[q][1] * bfhi(raw[s + q]); }
                    *(LAS unsigned*)(lds + L_QS + (s0 + s) * 528 + d0 * 2) = cvtpk(fsilu(x0), fsilu(x1)); }
            }
        }
        __syncthreads();
        if (FULL) {
            {
                const int tr = wave >> 1, tc0 = 2 * (wave & 1), fr = lane & 15, fq = lane >> 4;
                f32x4 s0 = {0.f, 0.f, 0.f, 0.f}, s1 = {0.f, 0.f, 0.f, 0.f};
#pragma unroll
                for (int ks = 0; ks < 8; ++ks) {
                    const bf16x8 af = *(const LAS bf16x8*)(lds + L_QS + (16 * tr + fr) * 528 + (32 * ks + 8 * fq) * 2);
                    const bf16x8 b0 = *(const LAS bf16x8*)(lds + L_KS + (16 * tc0 + fr) * 528 + (32 * ks + 8 * fq) * 2);
                    const bf16x8 b1 = *(const LAS bf16x8*)(lds + L_KS + (16 * (tc0 + 1) + fr) * 528 + (32 * ks + 8 * fq) * 2);
                    s0 = __builtin_amdgcn_mfma_f32_16x16x32_bf16(af, b0, s0, 0, 0, 0); s1 = __builtin_amdgcn_mfma_f32_16x16x32_bf16(af, b1, s1, 0, 0, 0);
                }
                const float we0 = WEXP[16 * tc0 + fr], we1 = WEXP[16 * (tc0 + 1) + fr];
#pragma unroll
                for (int r = 0; r < 4; ++r) { const int t = 16 * tr + 4 * fq + r; const float Mt = MT[t];
                    { const int s = 16 * tc0 + fr; const float ex = __expf(fminf(we0 - Mt, 0.f)); const float p = (s <= t) ? s0[r] * ex : 0.f; *(LAS bf16_t*)(lds + L_PS + t * 144 + s * 2) = (bf16_t)cvtpk(p, 0.f); }
                    { const int s = 16 * (tc0 + 1) + fr; const float ex = __expf(fminf(we1 - Mt, 0.f)); const float p = (s <= t) ? s1[r] * ex : 0.f; *(LAS bf16_t*)(lds + L_PS + t * 144 + s * 2) = (bf16_t)cvtpk(p, 0.f); } }
            }
            __syncthreads();
            u32x4 oreg[4];
#pragma unroll
            for (int q = 0; q < 4; ++q) { const int idx = q * 512 + tid, t = idx >> 5, ch = idx & 31; oreg[q] = NT_LD((const u32x4*)(PROJ + (size_t)(r0c + t) * NPROJ + 3072 + h * 256 + ch * 8)); }
            {
                const int t = tid >> 3, p = tid & 7;
                const u32x4 pv = *(const LAS u32x4*)(lds + L_PS + t * 144 + p * 16);
                float sp = (bflo(pv.x) + bfhi(pv.x)) + (bflo(pv.y) + bfhi(pv.y)) + (bflo(pv.z) + bfhi(pv.z)) + (bflo(pv.w) + bfhi(pv.w));
                float qn = 0.f;
#pragma unroll
                for (int q = 0; q < 4; ++q) { const u32x4 qv = *(const LAS u32x4*)(lds + L_QS + t * 528 + (32 * p + 8 * q) * 2); const LAS float* np = nsv + 32 * p + 8 * q;
                    qn += bflo(qv.x) * np[0] + bfhi(qv.x) * np[1] + bflo(qv.y) * np[2] + bfhi(qv.y) * np[3] + bflo(qv.z) * np[4] + bfhi(qv.z) * np[5] + bflo(qv.w) * np[6] + bfhi(qv.w) * np[7]; }
                sp += __shfl_xor(sp, 1); sp += __shfl_xor(sp, 2); sp += __shfl_xor(sp, 4);
                qn += __shfl_xor(qn, 1); qn += __shfl_xor(qn, 2); qn += __shfl_xor(qn, 4);
                if (p == 0) { const float den = sp + EI[t] * qn; RDN[t] = frcp(fmaxf(fabsf(den), __expf(-(BT[t] + MT[t])))); }
            }
            f32x16 nacc[2];
#pragma unroll
            for (int tt = 0; tt < 2; ++tt)
#pragma unroll
                for (int r = 0; r < 16; ++r) nacc[tt][r] = 0.f;
#pragma unroll
            for (int dt = 0; dt < 8; ++dt)
#pragma unroll
                for (int sp = 0; sp < 2; ++sp) {
                    __builtin_amdgcn_sched_barrier(0);
                    bf16x8 bfr; { u32x4 t4; t4.x = cvtpk(C[dt][8 * sp + 0], C[dt][8 * sp + 1]); t4.y = cvtpk(C[dt][8 * sp + 2], C[dt][8 * sp + 3]); t4.z = cvtpk(C[dt][8 * sp + 4], C[dt][8 * sp + 5]); t4.w = cvtpk(C[dt][8 * sp + 6], C[dt][8 * sp + 7]); bfr = __builtin_bit_cast(bf16x8, t4); }
#pragma unroll
                    for (int tt = 0; tt < 2; ++tt) {
                        const u32x2 lo = *(const LAS u32x2*)(lds + L_QS + (32 * tt + l31) * 528 + (32 * dt + 16 * sp + 4 * hh) * 2);
                        const u32x2 hi = *(const LAS u32x2*)(lds + L_QS + (32 * tt + l31) * 528 + (32 * dt + 16 * sp + 8 + 4 * hh) * 2);
                        const u32x4 a4 = {lo.x, lo.y, hi.x, hi.y};
                        nacc[tt] = __builtin_amdgcn_mfma_f32_32x32x16_bf16(__builtin_bit_cast(bf16x8, a4), bfr, nacc[tt], 0, 0, 0);
                    }
                }
#pragma unroll
            for (int tt = 0; tt < 2; ++tt)
#pragma unroll
                for (int r = 0; r < 16; ++r) nacc[tt][r] *= EI[32 * tt + (r & 3) + 8 * (r >> 2) + 4 * hh];
#pragma unroll
            for (int ks = 0; ks < 4; ++ks) {
                __builtin_amdgcn_sched_barrier(0);
                const bf16x8 bfr = *(const LAS bf16x8*)(lds + L_VT + (32 * wave + l31) * 144 + (16 * ks + 8 * hh) * 2);
#pragma unroll
                for (int tt = 0; tt < 2; ++tt) { const bf16x8 afr = *(const LAS bf16x8*)(lds + L_PS + (32 * tt + l31) * 144 + (16 * ks + 8 * hh) * 2);
                    nacc[tt] = __builtin_amdgcn_mfma_f32_32x32x16_bf16(afr, bfr, nacc[tt], 0, 0, 0); }
            }
#pragma unroll
            for (int q = 0; q < 4; ++q) { const int idx = q * 512 + tid, t = idx >> 5, ch = idx & 31; *(LAS u32x4*)(lds + L_KS + t * 528 + ch * 16) = oreg[q]; }
            __syncthreads();
#pragma unroll
            for (int tt = 0; tt < 2; ++tt)
#pragma unroll
                for (int r = 0; r < 16; ++r) { const int t = 32 * tt + (r & 3) + 8 * (r >> 2) + 4 * hh; const float hv = nacc[tt][r] * RDN[t]; nacc[tt][r] = hv;
                    const float q = half_sum31(hv * hv);
                    if (l31 == 31) RSS[wave * 64 + t] = q; }
            __syncthreads();
            if (tid < 64) { float q = 0.f;
#pragma unroll
                for (int w = 0; w < 8; ++w) q += RSS[w * 64 + tid];
                RN[tid] = rsqrtf(q * (1.f / 256.f) + EPS); }
            __syncthreads();
            {
                const int e = 32 * wave + l31; const float g = a.in[I_MHG][h * 256 + e];
#pragma unroll
                for (int tt = 0; tt < 2; ++tt)
#pragma unroll
                    for (int r = 0; r < 16; ++r) { const int t = 32 * tt + (r & 3) + 8 * (r >> 2) + 4 * hh;
                        const float o = bf1(*(const LAS bf16_t*)(lds + L_KS + t * 528 + e * 2));
                        *(LAS bf16_t*)(lds + L_QS + t * 528 + e * 2) = (bf16_t)cvtpk(nacc[tt][r] * RN[t] * g * fsigmoid(o), 0.f); }
            }
            __syncthreads();
            {
                bf16_t* ymr = (bf16_t*)(ws + WS_HN);
#pragma unroll
                for (int q = 0; q < 4; ++q) { const int idx = q * 512 + tid, t = idx >> 5, ch = idx & 31;
                    *(u32x4*)(ymr + (size_t)(r0c + t) * DM + h * 256 + ch * 8) = *(const LAS u32x4*)(lds + L_QS + t * 528 + ch * 16); }
            }
        }
#pragma unroll
        for (int dt = 0; dt < 8; ++dt)
#pragma unroll
            for (int r = 0; r < 16; ++r) C[dt][r] *= decay;
#pragma unroll
        for (int ks = 0; ks < 4; ++ks) {
            __builtin_amdgcn_sched_barrier(0);
            const bf16x8 bfr = *(const LAS bf16x8*)(lds + L_VT + (32 * wave + l31) * 144 + (16 * ks + 8 * hh) * 2);
#pragma unroll
            for (int dt = 0; dt < 8; ++dt) { const bf16x8 afr = *(const LAS bf16x8*)(lds + L_KWT + (32 * dt + l31) * 144 + (16 * ks + 8 * hh) * 2);
                C[dt] = __builtin_amdgcn_mfma_f32_32x32x16_bf16(afr, bfr, C[dt], 0, 0, 0); }
        }
        if (tid < 256) { float sk = 0.f;
#pragma unroll
            for (int q = 0; q < 8; ++q) { const u32x4 kv = *(const LAS u32x4*)(lds + L_KWT + tid * 144 + q * 16); sk += (bflo(kv.x) + bfhi(kv.x)) + (bflo(kv.y) + bfhi(kv.y)) + (bflo(kv.z) + bfhi(kv.z)) + (bflo(kv.w) + bfhi(kv.w)); }
            nsv[tid] = decay * nsv[tid] + sk; }
        __syncthreads();
    }
    if (!FULL) {
        bf16_t* st = (bf16_t*)(ws + WS_LST) + (size_t)unit * 65536;
#pragma unroll
        for (int dt = 0; dt < 8; ++dt)
#pragma unroll
            for (int q = 0; q < 4; ++q) *(u32x2*)(st + ((dt * 4 + q) * 512 + tid) * 4) = (u32x2){cvtpk(C[dt][4 * q], C[dt][4 * q + 1]), cvtpk(C[dt][4 * q + 2], C[dt][4 * q + 3])};
        if (tid < 256) ((float*)(ws + WS_LNS))[(size_t)unit * 256 + tid] = nsv[tid];
        if (tid == 0) ((float*)(ws + WS_DTOT))[unit] = __expf(dtot_log);
    }
}

constexpr int L_XS = 0, L_SEG = 69632, L_WL = L_SEG + 16384;
static_assert(L_WL + 2 * 128 * 272 <= L_CTL, "lru LDS map");
__device__ __forceinline__ void lru_unit(const Args& a, LAS unsigned char* lds, int b, int j, int n, bool load_w) {
    int tid_o = threadIdx.x; asm volatile("" : "+v"(tid_o));
    const int tid = tid_o, lane = tid & 63, wave = __builtin_amdgcn_readfirstlane(tid >> 6), hh = lane >> 5, l31 = lane & 31;
    unsigned char* ws = a.ws;
    const bf16_t* PROJ = (const bf16_t*)(ws + WS_PROJ);
    const int r0 = b * SEQ + j * 256, c0 = n * 128;
    const int unit = (b * 32 + j) * 8 + n;
    LAS float* SEG = (LAS float*)(lds + L_SEG);
    __syncthreads();
    if (load_w) {
        const bf16_t* WL = (const bf16_t*)(ws + WS_WLRU) + (size_t)n * 2 * 128 * 128;
#pragma unroll
        for (int q = 0; q < 8; ++q) { const int idx = q * 512 + tid, row = idx >> 4, ch = idx & 15;
            *(LAS u32x4*)(lds + L_WL + row * 272 + ch * 16) = *(const u32x4*)(WL + (size_t)row * 128 + ch * 8); }
    }
    {
        const int cp = tid & 63, tg = tid >> 6, c = 2 * cp, s0 = 32 * tg;
        const float* cw = a.in[I_LCW]; const float* cb = a.in[I_LCB];
        float w[4][2];
#pragma unroll
        for (int q = 0; q < 4; ++q) { w[q][0] = cw[q * 1024 + c0 + c]; w[q][1] = cw[q * 1024 + c0 + c + 1]; }
        const float b0 = cb[c0 + c], b1 = cb[c0 + c + 1];
        unsigned raw[35];
#pragma unroll
        for (int q = 0; q < 35; ++q) { const int ti = j * 256 + s0 - 3 + q; raw[q] = ti >= 0 ? NT_LD((const unsigned*)(PROJ + (size_t)(r0 + s0 - 3 + q) * NPROJ + 4096 + c0 + c)) : 0u; }
#pragma unroll
        for (int s = 0; s < 32; ++s) { float x0 = b0, x1 = b1;
#pragma unroll
            for (int q = 0; q < 4; ++q) { x0 += w[q][0] * bflo(raw[s + q]); x1 += w[q][1] * bfhi(raw[s + q]); }
            *(LAS unsigned*)(lds + L_XS + (s0 + s) * 272 + c * 2) = cvtpk(x0, x1); }
    }
    __syncthreads();
    float gba[4], gbx[4], glam[4];
#pragma unroll
    for (int nt = 0; nt < 4; ++nt) { const int c = c0 + 32 * nt + l31; gba[nt] = a.in[I_BLA][c]; gbx[nt] = a.in[I_BLX][c]; glam[nt] = a.in[I_LAM][c]; }
    f32x16 ar[4], ai[4];
#pragma unroll
    for (int nt = 0; nt < 4; ++nt)
#pragma unroll
        for (int r = 0; r < 16; ++r) { ar[nt][r] = 0.f; ai[nt][r] = 0.f; }
    {
        const int tau = 16 * ((l31 >> 2) & 1) + 4 * (l31 >> 3) + (l31 & 3);
#pragma unroll
        for (int ks = 0; ks < 8; ++ks) {
            const bf16x8 afr = *(const LAS bf16x8*)(lds + L_XS + (32 * wave + tau) * 272 + (16 * ks + 8 * hh) * 2);
#pragma unroll
            for (int nt = 0; nt < 4; ++nt) {
                const bf16x8 br = *(const LAS bf16x8*)(lds + L_WL + (32 * nt + l31) * 272 + (16 * ks + 8 * hh) * 2);
                const bf16x8 bi = *(const LAS bf16x8*)(lds + L_WL + (128 + 32 * nt + l31) * 272 + (16 * ks + 8 * hh) * 2);
                ar[nt] = __builtin_amdgcn_mfma_f32_32x32x16_bf16(afr, br, ar[nt], 0, 0, 0); ai[nt] = __builtin_amdgcn_mfma_f32_32x32x16_bf16(afr, bi, ai[nt], 0, 0, 0);
            }
        }
    }
#pragma unroll
    for (int nt = 0; nt < 4; ++nt) {
        __builtin_amdgcn_sched_barrier(0);
        const int d = 32 * nt + l31;
        const float ba = gba[nt], bx = gbx[nt], lsl = flogsigmoid(glam[nt]);
        float A = 1.f, H = 0.f;
#pragma unroll
        for (int r = 0; r < 16; ++r) {
            const int t = 32 * wave + 16 * hh + r;
            const float rg = fsigmoid(ar[nt][r] + ba), ig = fsigmoid(ai[nt][r] + bx);
            const float la = 8.f * rg * lsl; const float av = __expf(la);
            const float xr = bf1(*(const LAS bf16_t*)(lds + L_XS + t * 272 + d * 2));
            const float x2 = 2.f * la; const float om = (x2 > -0.02f) ? -x2 * (1.f + x2 * (0.5f + x2 * (1.f / 6.f))) : 1.f - __expf(x2);
            const float u = __builtin_amdgcn_sqrtf(om) * (ig * xr);
            ar[nt][r] = av; ai[nt][r] = u;
            A *= av; H = av * H + u;
        }
        SEG[((2 * wave + hh) * 128 + d) * 2] = A; SEG[((2 * wave + hh) * 128 + d) * 2 + 1] = H;
    }
    __syncthreads();
    if (tid < 128) {
        float hc = 0.f, At = 1.f;
#pragma unroll
        for (int sg = 0; sg < 16; ++sg) { const float A = SEG[(sg * 128 + tid) * 2], H = SEG[(sg * 128 + tid) * 2 + 1]; SEG[(sg * 128 + tid) * 2] = hc; SEG[(sg * 128 + tid) * 2 + 1] = At; hc = A * hc + H; At *= A; }
        ((float*)(ws + WS_LRUA))[(size_t)unit * 128 + tid] = At; ((float*)(ws + WS_LRUH))[(size_t)unit * 128 + tid] = hc;
    }
    __syncthreads();
#pragma unroll 1
    for (int round = 0; round < 2; ++round) {
#pragma unroll
        for (int nt = 0; nt < 4; ++nt) { const int d = 32 * nt + l31;
            float v = SEG[((2 * wave + hh) * 128 + d) * 2 + round];
#pragma unroll
            for (int r = 0; r < 16; ++r) { const int t = 32 * wave + 16 * hh + r;
                v = round ? v * ar[nt][r] : ar[nt][r] * v + ai[nt][r];
                *(LAS bf16_t*)(lds + L_XS + t * 272 + d * 2) = (bf16_t)cvtpk(v, 0.f); } }
        __syncthreads();
        bf16_t* dstb = (bf16_t*)(ws + (round ? WS_ACUM : WS_HLOC));
#pragma unroll
        for (int q = 0; q < 8; ++q) { const int idx = q * 512 + tid, t = idx >> 4, ch = idx & 15;
            *(u32x4*)(dstb + (size_t)(r0 + t) * 1024 + c0 + ch * 8) = *(const LAS u32x4*)(lds + L_XS + t * 272 + ch * 16); }
        __syncthreads();
    }
}
__device__ __forceinline__ void lru_out_unit(const Args& a, int b, int j, int n) {
    int tid_o = threadIdx.x; asm volatile("" : "+v"(tid_o));
    const int tid = tid_o, d8 = tid & 15;
    unsigned char* ws = a.ws;
    const bf16_t* PROJ = (const bf16_t*)(ws + WS_PROJ); const bf16_t* HL = (const bf16_t*)(ws + WS_HLOC); const bf16_t* AC = (const bf16_t*)(ws + WS_ACUM);
    const int r0 = b * SEQ + j * 256, c0 = n * 128 + 8 * d8;
    const float* cp = (const float*)(ws + WS_LRUC) + (size_t)(b * 32 + j) * 1024 + c0; const float* gp = a.in[I_LNG] + c0;
    const f32x4 ca = *(const f32x4*)cp, cb = *(const f32x4*)(cp + 4), ga = *(const f32x4*)gp, gb = *(const f32x4*)(gp + 4);
    u32x4 hl[8], ac[8], gr[8];
#pragma unroll
    for (int q = 0; q < 8; ++q) { const size_t t = (size_t)(r0 + (tid >> 4) + 32 * q);
        hl[q] = NT_LD((const u32x4*)(HL + t * 1024 + c0)); ac[q] = NT_LD((const u32x4*)(AC + t * 1024 + c0)); gr[q] = NT_LD((const u32x4*)(PROJ + t * NPROJ + 5120 + c0)); }
    bf16_t* ymr = (bf16_t*)(ws + WS_HN);
#pragma unroll
    for (int q = 0; q < 8; ++q) { const size_t t = (size_t)(r0 + (tid >> 4) + 32 * q);
        f32x4 ya = (f32x4){bflo(hl[q].x), bfhi(hl[q].x), bflo(hl[q].y), bfhi(hl[q].y)} + (f32x4){bflo(ac[q].x), bfhi(ac[q].x), bflo(ac[q].y), bfhi(ac[q].y)} * ca;
        f32x4 yb = (f32x4){bflo(hl[q].z), bfhi(hl[q].z), bflo(hl[q].w), bfhi(hl[q].w)} + (f32x4){bflo(ac[q].z), bfhi(ac[q].z), bflo(ac[q].w), bfhi(ac[q].w)} * cb;
        ya = ya * (f32x4){fgelu_tanh(bflo(gr[q].x)), fgelu_tanh(bfhi(gr[q].x)), fgelu_tanh(bflo(gr[q].y)), fgelu_tanh(bfhi(gr[q].y))};
        yb = yb * (f32x4){fgelu_tanh(bflo(gr[q].z)), fgelu_tanh(bfhi(gr[q].z)), fgelu_tanh(bflo(gr[q].w)), fgelu_tanh(bfhi(gr[q].w))};
        float ss = (ya.x * ya.x + ya.y * ya.y) + (ya.z * ya.z + ya.w * ya.w) + (yb.x * yb.x + yb.y * yb.y) + (yb.z * yb.z + yb.w * yb.w);
        ss += __shfl_xor(ss, 1); ss += __shfl_xor(ss, 2); ss += __shfl_xor(ss, 4); ss += __shfl_xor(ss, 8);
        const float rn = rsqrtf(ss * (1.f / 128.f) + EPS);
        ya = ya * rn * ga; yb = yb * rn * gb;
        *(u32x4*)(ymr + t * DM + 1024 + c0) = (u32x4){cvtpk(ya.x, ya.y), cvtpk(ya.z, ya.w), cvtpk(yb.x, yb.y), cvtpk(yb.z, yb.w)}; }
}

__device__ __forceinline__ void mixer_scan(const Args& a, int vcu, int G) {
    unsigned char* ws = a.ws; int tid_o = threadIdx.x; asm volatile("" : "+v"(tid_o)); const int tid = tid_o;
    const float* DT = (const float*)(ws + WS_DTOT);
    if (tid < 256) for (int g = vcu * 256 + tid; g < 65536; g += G * 256) {
        const int bh = g >> 13, i8 = g & 8191; bf16_t* base = (bf16_t*)(ws + WS_LST) + (size_t)bh * 32 * 65536 + (size_t)i8 * 8;
        f32x4 Sa = {0.f, 0.f, 0.f, 0.f}, Sb = {0.f, 0.f, 0.f, 0.f}; u32x4 Lr[31];
#pragma unroll
        for (int j = 0; j < 31; ++j) Lr[j] = NT_LD((const u32x4*)(base + (size_t)j * 65536));
#pragma unroll
        for (int j = 0; j < 31; ++j) { const float d = DT[bh * 32 + j]; const u32x4 L = Lr[j];
            Sa = d * Sa + (f32x4){bflo(L.x), bfhi(L.x), bflo(L.y), bfhi(L.y)}; Sb = d * Sb + (f32x4){bflo(L.z), bfhi(L.z), bflo(L.w), bfhi(L.w)};
            *(u32x4*)(base + (size_t)j * 65536) = (u32x4){cvtpk(Sa.x, Sa.y), cvtpk(Sa.z, Sa.w), cvtpk(Sb.x, Sb.y), cvtpk(Sb.z, Sb.w)}; }
    }
    if (tid >= 264 && tid < 266) for (int g = vcu * 2 + (tid - 264); g < 8 * 64; g += G * 2) {
        const int bh = g >> 6, i4 = g & 63; float* base = (float*)(ws + WS_LNS) + (size_t)bh * 32 * 256 + (size_t)i4 * 4;
        f32x4 S = {0.f, 0.f, 0.f, 0.f};
#pragma unroll 8
        for (int j = 0; j < 31; ++j) { const f32x4 L = *(const f32x4*)(base + (size_t)j * 256); S = DT[bh * 32 + j] * S + L; *(f32x4*)(base + (size_t)j * 256) = S; }
    }
    if (tid >= 256 && tid < 264) for (int g = vcu * 8 + (tid - 256); g < 2048; g += G * 8) {
        const int b = g >> 10, ch = g & 1023, n = ch >> 7, d = ch & 127; float hc = 0.f;
        const float* LA = (const float*)(ws + WS_LRUA); const float* LH = (const float*)(ws + WS_LRUH); float* LC = (float*)(ws + WS_LRUC);
#pragma unroll 8
        for (int j = 0; j < 32; ++j) { const size_t u = (size_t)((b * 32 + j) * 8 + n) * 128 + d; LC[(size_t)(b * 32 + j) * 1024 + ch] = hc; hc = LA[u] * hc + LH[u]; }
    }
}

__device__ __forceinline__ void p5_hn2_route(const Args& a, LAS unsigned char* lds, int vcu, int G) {
    int tid_o = threadIdx.x; asm volatile("" : "+v"(tid_o));
    const int tid = tid_o, lane = tid & 63, wave = __builtin_amdgcn_readfirstlane(tid >> 6), fr = lane & 15, kq = lane >> 4;
    unsigned char* ws = a.ws;
    LAS float* part = (LAS float*)lds;
    LAS float* rstds = (LAS float*)(lds + 49152);
    LAS float* lgs = (LAS float*)(lds + 49152 + 128);
    const float* mod = (const float*)(ws + WS_MOD); const float* cvec = (const float*)(ws + WS_CVEC);
    const bf16_t* WRH = (const bf16_t*)(ws + WS_WRH); const bf16_t* WRL = (const bf16_t*)(ws + WS_WRL);
    int* cnt = (int*)(ws + WS_CTL); int* list = (int*)(ws + WS_LIST); float* route = (float*)(ws + WS_ROUTE);
    for (int task = vcu; task < T / 32; task += G) {
        int lane_o = tid_o & 63; asm volatile("" : "+v"(lane_o));
        const int lane = lane_o, fr = lane & 15, kq = lane >> 4;
        const int row0 = task * 32, b = row0 / SEQ;
        const float* sh2 = mod + (size_t)b * 12288 + 6144; const float* sc2 = mod + (size_t)b * 12288 + 8192;
        __syncthreads();
        const bf16_t* X1 = (const bf16_t*)(ws + WS_X1B);
        f32x4 acc[2][3];
#pragma unroll
        for (int rt = 0; rt < 2; ++rt)
#pragma unroll
            for (int nt = 0; nt < 3; ++nt) acc[rt][nt] = (f32x4){0.f, 0.f, 0.f, 0.f};
        {
            u32x4 xb[8][2];
#pragma unroll
            for (int st = 0; st < 8; ++st)
#pragma unroll
                for (int rt = 0; rt < 2; ++rt) xb[st][rt] = *(const u32x4*)(X1 + (size_t)(row0 + 16 * rt + fr) * DM + 256 * wave + 32 * st + 8 * kq);
            bf16x8 Bhs[2][3], Bls[2][3]; f32x4 s0s[2], s1s[2];
#define RT_LOADB(set, stp) do { const int c0_ = 256 * wave + 32 * (stp) + 8 * kq; s0s[set] = *(const f32x4*)(sc2 + c0_); s1s[set] = *(const f32x4*)(sc2 + c0_ + 4); \
                _Pragma("unroll") for (int nt = 0; nt < 3; ++nt) { Bhs[set][nt] = *(const bf16x8*)(WRH + (size_t)(16 * nt + fr) * 2048 + c0_); Bls[set][nt] = *(const bf16x8*)(WRL + (size_t)(16 * nt + fr) * 2048 + c0_); } } while (0)
            RT_LOADB(0, 0);
#pragma unroll
            for (int st = 0; st < 8; ++st) {
                __builtin_amdgcn_sched_barrier(0);
                if (st < 7) RT_LOADB((st + 1) & 1, st + 1);
                const f32x4 s0 = s0s[st & 1] + 1.f, s1 = s1s[st & 1] + 1.f;
                bf16x8 Ah[2], Al[2];
#pragma unroll
                for (int rt = 0; rt < 2; ++rt) {
                    const u32x4 r4 = xb[st][rt];
                    const f32x4 x0 = (f32x4){bflo(r4.x), bfhi(r4.x), bflo(r4.y), bfhi(r4.y)} * s0, x1 = (f32x4){bflo(r4.z), bfhi(r4.z), bflo(r4.w), bfhi(r4.w)} * s1;
                    u32x4 h; h.x = cvtpk(x0.x, x0.y); h.y = cvtpk(x0.z, x0.w); h.z = cvtpk(x1.x, x1.y); h.w = cvtpk(x1.z, x1.w);
                    u32x4 l; l.x = cvtpk(x0.x - bflo(h.x), x0.y - bfhi(h.x)); l.y = cvtpk(x0.z - bflo(h.y), x0.w - bfhi(h.y)); l.z = cvtpk(x1.x - bflo(h.z), x1.y - bfhi(h.z)); l.w = cvtpk(x1.z - bflo(h.w), x1.w - bfhi(h.w));
                    Ah[rt] = __builtin_bit_cast(bf16x8, h); Al[rt] = __builtin_bit_cast(bf16x8, l);
                }
#pragma unroll
                for (int nt = 0; nt < 3; ++nt) {
                    const bf16x8 Bh = Bhs[st & 1][nt], Bl = Bls[st & 1][nt];
#pragma unroll
                    for (int rt = 0; rt < 2; ++rt) {
                        acc[rt][nt] = __builtin_amdgcn_mfma_f32_16x16x32_bf16(Ah[rt], Bh, acc[rt][nt], 0, 0, 0);
                        acc[rt][nt] = __builtin_amdgcn_mfma_f32_16x16x32_bf16(Al[rt], Bh, acc[rt][nt], 0, 0, 0);
                        acc[rt][nt] = __builtin_amdgcn_mfma_f32_16x16x32_bf16(Ah[rt], Bl, acc[rt][nt], 0, 0, 0);
                    }
                }
            }
        }
#undef RT_LOADB
        __builtin_amdgcn_sched_barrier(0);
        {
            u32x4 v[4][4]; float rs[4];
#pragma unroll
            for (int r = 0; r < 4; ++r)
#pragma unroll
                for (int jj = 0; jj < 4; ++jj) v[r][jj] = NT_LD((const u32x4*)(X1 + (size_t)(row0 + wave * 4 + r) * DM + 8 * lane + 512 * jj));
#pragma unroll
            for (int r = 0; r < 4; ++r) { float ssum = 0.f;
#pragma unroll
                for (int jj = 0; jj < 4; ++jj) { const u32x4 q = v[r][jj]; const float a0 = bflo(q.x), a1 = bfhi(q.x), a2 = bflo(q.y), a3 = bfhi(q.y), a4 = bflo(q.z), a5 = bfhi(q.z), a6 = bflo(q.w), a7 = bfhi(q.w);
                    ssum += ((a0 * a0 + a1 * a1) + (a2 * a2 + a3 * a3)) + ((a4 * a4 + a5 * a5) + (a6 * a6 + a7 * a7)); }
                rs[r] = rsqrtf(wave_sum(ssum) * (1.f / DM) + EPS); if (lane == 0) rstds[wave * 4 + r] = rs[r]; }
#pragma unroll
            for (int jj = 0; jj < 4; ++jj) { __builtin_amdgcn_sched_barrier(0);
                const f32x4 sha = *(const f32x4*)(sh2 + 8 * lane + 512 * jj), shb = *(const f32x4*)(sh2 + 8 * lane + 512 * jj + 4);
                const f32x4 sca = *(const f32x4*)(sc2 + 8 * lane + 512 * jj) + 1.f, scb = *(const f32x4*)(sc2 + 8 * lane + 512 * jj + 4) + 1.f;
#pragma unroll
                for (int r = 0; r < 4; ++r) { const u32x4 q = v[r][jj];
                    const f32x4 ha = (f32x4){bflo(q.x), bfhi(q.x), bflo(q.y), bfhi(q.y)} * rs[r] * sca + sha, hb = (f32x4){bflo(q.z), bfhi(q.z), bflo(q.w), bfhi(q.w)} * rs[r] * scb + shb;
                    *(u32x4*)((bf16_t*)(ws + WS_HN) + (size_t)(row0 + wave * 4 + r) * DM + 8 * lane + 512 * jj) = (u32x4){cvtpk(ha.x, ha.y), cvtpk(ha.z, ha.w), cvtpk(hb.x, hb.y), cvtpk(hb.z, hb.w)}; } }
        }
#pragma unroll
        for (int rt = 0; rt < 2; ++rt)
#pragma unroll
            for (int nt = 0; nt < 3; ++nt)
#pragma unroll
                for (int r = 0; r < 4; ++r) part[(wave * 32 + 16 * rt + 4 * kq + r) * 48 + 16 * nt + fr] = acc[rt][nt][r];
        __syncthreads();
        for (int idx = tid; idx < 32 * 36; idx += 512) { const int r = idx / 36, n = idx % 36; float q = 0.f;
#pragma unroll
            for (int w = 0; w < 8; ++w) q += part[(w * 32 + r) * 48 + n];
            lgs[r * 40 + n] = rstds[r] * q + cvec[b * 48 + n]; }
        __syncthreads();
        if (tid < 32) {
            const int t = row0 + tid; const LAS float* lg = lgs + tid * 40;
            int g = 0; float mx = lg[0];
#pragma unroll
            for (int i = 1; i < 4; ++i) { const float x = lg[i]; if (x > mx) { mx = x; g = i; } }
            float sg = 0.f;
#pragma unroll
            for (int i = 0; i < 4; ++i) sg += __expf(lg[i] - mx);
            const float pg = 1.f / sg;
            int e0 = 0; float m0 = lg[4 + g * 8];
            for (int i = 1; i < 8; ++i) { const float x = lg[4 + g * 8 + i]; if (x > m0) { m0 = x; e0 = i; } }
            int e1 = -1; float m1 = -INFINITY;
            for (int i = 0; i < 8; ++i) { const float x = lg[4 + g * 8 + i]; if (i != e0 && x > m1) { m1 = x; e1 = i; } }
            const float x1 = __expf(m1 - m0); const float w0 = pg / (1.f + x1), w1 = pg * x1 / (1.f + x1);
            const int E0 = g * 8 + e0, E1 = g * 8 + e1;
            *(f32x4*)(route + (size_t)t * 4) = (f32x4){w0, w1, (float)E0, (float)E1};
            LAS int* lcnt = (LAS int*)(lds + 49152 + 128 + 5120); LAS int* lbase = lcnt + 32;
            lcnt[tid] = 0;
            LDS_WAIT(); asm volatile("" ::: "memory");
            const int rk0 = __hip_atomic_fetch_add(lcnt + E0, 1, __ATOMIC_RELAXED, __HIP_MEMORY_SCOPE_WORKGROUP);
            const int rk1 = __hip_atomic_fetch_add(lcnt + E1, 1, __ATOMIC_RELAXED, __HIP_MEMORY_SCOPE_WORKGROUP);
            LDS_WAIT(); asm volatile("" ::: "memory");
            const int lc = lcnt[tid];
            lbase[tid] = lc ? atomicAdd(&cnt[tid], lc) : 0;
            LDS_WAIT(); asm volatile("" ::: "memory");
            float* listw = (float*)(ws + WS_LISTW);
            { const size_t p0 = (size_t)E0 * T + lbase[E0] + rk0, p1 = (size_t)E1 * T + lbase[E1] + rk1;
              list[p0] = t * 2; listw[p0] = w0; list[p1] = t * 2 + 1; listw[p1] = w1; }
        }
    }
}

__device__ __forceinline__ void p9_final(const Args& a, int vcu, int G, float* dstbase) {
    int tid_o = threadIdx.x; asm volatile("" : "+v"(tid_o));
    const int tid = tid_o, lane = tid & 63, wave = __builtin_amdgcn_readfirstlane(tid >> 6);
    unsigned char* ws = a.ws; const float* mod = (const float*)(ws + WS_MOD); const bf16_t* YS = (const bf16_t*)(ws + WS_YS);
    const bf16_t* X1 = (const bf16_t*)(ws + WS_X1B);
    for (int rp = vcu * 8 + wave; rp < T / 2; rp += G * 8) {
        const int b = (2 * rp) / SEQ; const float* g2 = mod + (size_t)b * 12288 + 10240;
        u32x4 xr[2][4], y0[2][4], y1[2][4];
#pragma unroll
        for (int q = 0; q < 2; ++q)
#pragma unroll
            for (int jj = 0; jj < 4; ++jj) { const int row = 2 * rp + q; xr[q][jj] = NT_LD((const u32x4*)(X1 + (size_t)row * DM + 8 * lane + 512 * jj)); y0[q][jj] = NT_LD((const u32x4*)(YS + (size_t)(2 * row) * DM + 8 * lane + 512 * jj)); y1[q][jj] = NT_LD((const u32x4*)(YS + (size_t)(2 * row + 1) * DM + 8 * lane + 512 * jj)); }
#pragma unroll
        for (int q = 0; q < 2; ++q) {
            const int row = 2 * rp + q; f32x4 v[4][2]; float s = 0.f;
#pragma unroll
            for (int jj = 0; jj < 4; ++jj) { const f32x4 ga = *(const f32x4*)(g2 + 8 * lane + 512 * jj), gb = *(const f32x4*)(g2 + 8 * lane + 512 * jj + 4);
                const u32x4 x = xr[q][jj], p0 = y0[q][jj], p1 = y1[q][jj];
                v[jj][0] = (f32x4){bflo(x.x), bfhi(x.x), bflo(x.y), bfhi(x.y)} + ga * (f32x4){bflo(p0.x) + bflo(p1.x), bfhi(p0.x) + bfhi(p1.x), bflo(p0.y) + bflo(p1.y), bfhi(p0.y) + bfhi(p1.y)};
                v[jj][1] = (f32x4){bflo(x.z), bfhi(x.z), bflo(x.w), bfhi(x.w)} + gb * (f32x4){bflo(p0.z) + bflo(p1.z), bfhi(p0.z) + bfhi(p1.z), bflo(p0.w) + bflo(p1.w), bfhi(p0.w) + bfhi(p1.w)};
#pragma unroll
                for (int z = 0; z < 2; ++z) s += (v[jj][z].x * v[jj][z].x + v[jj][z].y * v[jj][z].y) + (v[jj][z].z * v[jj][z].z + v[jj][z].w * v[jj][z].w); }
            const float rstd = rsqrtf(wave_sum(s) * (1.f / DM) + EPS);
#pragma unroll
            for (int jj = 0; jj < 4; ++jj) { const f32x4 fa = *(const f32x4*)(a.in[I_FG] + 8 * lane + 512 * jj), fb = *(const f32x4*)(a.in[I_FG] + 8 * lane + 512 * jj + 4);
                float* dr = dstbase + (size_t)row * DM + 8 * lane + 512 * jj; NT_ST(v[jj][0] * rstd * fa, (f32x4*)dr); NT_ST(v[jj][1] * rstd * fb, (f32x4*)(dr + 4)); }
        }
    }
}
}
namespace fk {
#define XB_TMO      128
#define XB_XCNT(j)  (256  + 64 * (j))
#define XB_XSUB(j)  (1280 + 64 * (j))
#define XB_XGEN(j)  (2304 + 64 * (j))
#define XB_TOP      3328
#define XB_TOPGEN   3392
#define XCD_BAR_WORDS 3456
#define XB_SPIN_CAP (1u << 18)

__device__ __forceinline__ unsigned xb_ld(unsigned* p)              { return __hip_atomic_load(p, __ATOMIC_RELAXED, __HIP_MEMORY_SCOPE_AGENT); }
__device__ __forceinline__ unsigned xb_add(unsigned* p, unsigned v) { return __hip_atomic_fetch_add(p, v, __ATOMIC_RELAXED, __HIP_MEMORY_SCOPE_AGENT); }
__device__ __forceinline__ unsigned xb_xcc_id() { return (unsigned)__builtin_amdgcn_s_getreg((3 << 11) | 20) & 0xFu; }
#define XB_SPIN(cond, bar) do { unsigned _sp = 0; while (cond) { __builtin_amdgcn_s_sleep(1); \
    if ((++_sp & 255u) == 0u) { if (xb_ld(&(bar)[XB_TMO])) break; if (_sp > XB_SPIN_CAP) { atomicAdd(&(bar)[XB_TMO], 1u); break; } } } } while (0)

struct XcdBarrier {
    unsigned* bar; unsigned x;
    volatile LAS unsigned* st;
};

__device__ __forceinline__ XcdBarrier xcd_barrier_post(unsigned* bar, volatile LAS unsigned* st) {
    XcdBarrier b; b.bar = bar; b.x = xb_xcc_id(); b.st = st;
    if (threadIdx.x == 0) (void)xb_add(&bar[XB_XCNT(b.x)], 1u);
    return b;
}
__device__ __forceinline__ void xcd_barrier_complete(unsigned* bar, unsigned x, unsigned& nloc, unsigned& nx) {
    const unsigned G = gridDim.x * gridDim.y * gridDim.z;
    unsigned sum, cnt, mine, sp = 0u;
    for (;;) {
        sum = 0u; cnt = 0u; mine = 0u;
#pragma unroll
        for (unsigned j = 0; j < 16; ++j) { const unsigned c = xb_ld(&bar[XB_XCNT(j)]); sum += c; cnt += (c > 0u) ? 1u : 0u; mine = (j == x) ? c : mine; }
        if (sum == G) break;
        __builtin_amdgcn_s_sleep(1);
        if ((++sp & 255u) == 0u) { if (xb_ld(&bar[XB_TMO])) break; if (sp > XB_SPIN_CAP) { atomicAdd(&bar[XB_TMO], 1u); break; } }
    }
    nloc = mine > 0u ? mine : 1u; nx = cnt > 0u ? cnt : 1u;
}

__device__ __forceinline__ void xcd_barrier(const XcdBarrier& b) {
    asm volatile("s_waitcnt vmcnt(0)" ::: "memory");
    __syncthreads();
    if (threadIdx.x == 0) {
        unsigned* bar = b.bar;
        __builtin_amdgcn_s_waitcnt(0);
        unsigned nloc = b.st[0], nx = b.st[1];
        if (nloc == 0u) { xcd_barrier_complete(bar, b.x, nloc, nx); b.st[0] = nloc; b.st[1] = nx; }
        const unsigned old = xb_add(&bar[XB_XSUB(b.x)], 1u);
        const unsigned gen = old / nloc;
        if (old + 1u == (gen + 1u) * nloc) {
            __builtin_amdgcn_fence(__ATOMIC_RELEASE, "agent");
            asm volatile("s_waitcnt vmcnt(0)" ::: "memory");
            const unsigned og = xb_add(&bar[XB_TOP], 1u);
            const unsigned tg = og / nx;
            if (og + 1u == (tg + 1u) * nx) xb_add(&bar[XB_TOPGEN], 1u);
            else XB_SPIN(xb_ld(&bar[XB_TOPGEN]) == tg, bar);
            __builtin_amdgcn_fence(__ATOMIC_ACQUIRE, "agent");
            xb_add(&bar[XB_XGEN(b.x)], 1u);
            asm volatile("s_waitcnt vmcnt(0)" ::: "memory");
        } else {
            XB_SPIN(xb_ld(&bar[XB_XGEN(b.x)]) == gen, bar);
            __builtin_amdgcn_fence(__ATOMIC_ACQUIRE, "agent");
            asm volatile("s_waitcnt vmcnt(0)" ::: "memory");
        }
    }
    __syncthreads();
}
}
namespace fk {
constexpr int NPHASE = 11;
#ifndef NCONV
#define NCONV 36
#endif
__global__ void __launch_bounds__(512, 2) fwd(Args a) {
    extern __shared__ __attribute__((aligned(16))) unsigned char lds_raw[];
    LAS unsigned char* lds = (LAS unsigned char*)lds_raw;
    const int G = gridDim.x, bx = blockIdx.x, tid = threadIdx.x;
    const int vcu = (G % 8 == 0) ? (bx % 8) * (G / 8) + bx / 8 : bx;
    const int lo = a.ph_lo, hi = a.ph_hi;
    unsigned char* ws = a.ws;
    volatile LAS unsigned* bst = (volatile LAS unsigned*)(lds + L_CTL + 512);
    if (tid < 2) bst[tid] = 0u;
    __syncthreads();
    XcdBarrier bar; bar.bar = (unsigned*)(ws + WS_BAR); bar.x = 0; bar.st = bst;
    if (hi - lo > 1) bar = xcd_barrier_post((unsigned*)(ws + WS_BAR), bst);
#ifndef PH_ONLY
#define PH_ONLY -1
#endif
#define IN(k) ((PH_ONLY < 0 || PH_ONLY == (k)) && lo <= (k) && (k) < hi)
#define GSYNC() xcd_barrier(bar)
#define SYNC(k) do { if (IN(k) && IN((k) + 1)) GSYNC(); } while (0)
#ifndef REP_PHASE
#define REP_PHASE -1
#endif
#ifndef REP_SKIPL
#define REP_SKIPL 0
#endif
#define REP(k) _Pragma("unroll 1") for (int rep_ = 0; rep_ < ((REP_PHASE == (k)) ? 2 : 1); ++rep_)
#define RSYNC() do { if (rep_) GSYNC(); } while (0)
    const int nconv = (G == 256 && IN(0) && IN(2)) ? NCONV : 0;
    REP(0) { RSYNC(); if (IN(0)) { p0_prologue(a, lds, vcu, G, nconv); } } SYNC(0);
    REP(1) { RSYNC(); if (IN(1)) { p1_hn_gates(a, lds, vcu, G); } } SYNC(1);
    REP(2) { RSYNC(); if (IN(2)) {
        if (bx < G - nconv) { DenseSched S; S.init(ws + WS_HN, ws + WS_WIN, T, NPROJ, DM, G - nconv, bx); EpiProj E{(bf16_t*)(ws + WS_PROJ), NPROJ}; pg8::gemm_phase<EpiProj, DenseSched>(lds, DM, S, E); }
        else if (!rep_) p2_convert(a, lds, (bx - (G - nconv)) + nconv * (tid >> 6), nconv * 8);
    } } SYNC(2);
    REP(34) { RSYNC(); REP(3) { RSYNC(); if (IN(3)) {
#ifndef NO_MLSTM
                 for (int u = vcu; u < 256; u += G) mlstm_unit<false>(a, lds, u >> 5, u & 31);
#endif
#ifndef NO_LRU
                 if (!(REP_SKIPL && rep_)) for (int u = vcu, pn_ = -1; u < 512; u += G) { lru_unit(a, lds, u >> 8, (u >> 3) & 31, u & 7, (u & 7) != pn_); pn_ = u & 7; }
#endif
    } } SYNC(3);
    if (IN(4)) { mixer_scan(a, vcu, G); } } SYNC(4);
    REP(5) { RSYNC(); if (IN(5)) {
                 if (vcu & 1) { for (int u = vcu; u < 512; u += G) lru_out_unit(a, u >> 8, (u >> 3) & 31, u & 7); }
                 for (int u = vcu; u < 256; u += G) mlstm_unit<true>(a, lds, u >> 5, u & 31);
                 if (!(vcu & 1)) { for (int u = vcu; u < 512; u += G) lru_out_unit(a, u >> 8, (u >> 3) & 31, u & 7); }
    } } SYNC(5);
    REP(6) { RSYNC(); if (IN(6)) { __syncthreads(); DenseSched S; S.init(ws + WS_HN, ws + WS_WOUT, T, DM, DM, G, bx); EpiX1 E{a.in[I_X], (const float*)(ws + WS_MOD), (bf16_t*)(ws + WS_X1B)}; pg8::gemm_phase<EpiX1, DenseSched>(lds, DM, S, E); } } SYNC(6);
    REP(7) { if (rep_) { GSYNC(); if (bx == 0 && tid < 32) ((int*)(ws + WS_CTL))[tid] = 0; GSYNC(); }
        if (IN(7)) { p5_hn2_route(a, lds, vcu, G); } } SYNC(7);
    if (IN(8) || IN(9)) {
        LAS int* tp = (LAS int*)(lds + L_CTL); const int* cnt = (const int*)(ws + WS_CTL);
        __syncthreads();
        if (tid == 0) { int s = 0; for (int e = 0; e < 32; ++e) { tp[e] = s; s += (cnt[e] + 255) >> 8; } tp[32] = s; }
        __syncthreads();
        if (tid < 192) { int e = 0; for (int q = 1; q < 32; ++q) e += (tp[q] <= tid) ? 1 : 0; ((LAS unsigned short*)(tp + 160))[tid] = (unsigned short)e; }
        __syncthreads();
    }
    if (IN(8)) { const LAS int* tp = (const LAS int*)(lds + L_CTL); const int nGU = tp[32] * 4, R = nGU / G, rem = nGU - R * G, Ne = G - rem;
        { MoeSched<4, true> S{tp, (const int*)(ws + WS_CTL), (const int*)(ws + WS_LIST), (const char*)(ws + WS_HN), (const char*)(ws + WS_WGU), DM, vcu, G, R * G};
          EpiGateUp E{(bf16_t*)(ws + WS_HEXP)}; pg8::gemm_phase<EpiGateUp, MoeSched<4, true>>(lds, DM, S, E); }
        if (rem > 0) {
            GSYNC();
            if (vcu < rem) { MoeSched<4, true> S{tp, (const int*)(ws + WS_CTL), (const int*)(ws + WS_LIST), (const char*)(ws + WS_HN), (const char*)(ws + WS_WGU), DM, R * G + vcu, G, nGU};
                EpiGateUp E{(bf16_t*)(ws + WS_HEXP)}; pg8::gemm_phase<EpiGateUp, MoeSched<4, true>>(lds, DM, S, E); }
            else if (R >= 1) { MoeSched<8, false> S{tp, (const int*)(ws + WS_CTL), (const int*)(ws + WS_LIST), (const char*)(ws + WS_HEXP), (const char*)(ws + WS_WDN), 512, vcu - rem, Ne, 2 * Ne};
                EpiDown E{(bf16_t*)(ws + WS_YS), (const int*)(ws + WS_CTL), (const int*)(ws + WS_LIST), (const float*)(ws + WS_LISTW)}; pg8::gemm_phase<EpiDown, MoeSched<8, false>>(lds, 512, S, E); }
        }
    } SYNC(8);
    if (IN(9)) { const LAS int* tp = (const LAS int*)(lds + L_CTL); const int nGU = tp[32] * 4, R = nGU / G, rem = nGU - R * G, Ne = G - rem;
        MoeSched<8, false> S{tp, (const int*)(ws + WS_CTL), (const int*)(ws + WS_LIST), (const char*)(ws + WS_HEXP), (const char*)(ws + WS_WDN), 512, ((rem > 0 && R >= 1) ? 2 * Ne : 0) + vcu, G, tp[32] * 8};
        EpiDown E{(bf16_t*)(ws + WS_YS), (const int*)(ws + WS_CTL), (const int*)(ws + WS_LIST), (const float*)(ws + WS_LISTW)}; pg8::gemm_phase<EpiDown, MoeSched<8, false>>(lds, 512, S, E); } SYNC(9);
#if REP_PHASE == 10
    if (IN(10)) { p9_final(a, vcu, G, (float*)(ws + WS_WGU)); GSYNC(); }
#endif
#if REP_PHASE == 99
    for (int q = 0; q < 20; ++q) GSYNC();
#endif
    if (IN(10)) { p9_final(a, vcu, G, a.out); }
#undef IN
#undef SYNC
}

static int g_grid = 0;
static bool setup() {
    if (g_grid) return g_grid > 0;
    int dev = 0, cus = 0, per_cu = 0;
    if (hipGetDevice(&dev) != hipSuccess || hipDeviceGetAttribute(&cus, hipDeviceAttributeMultiprocessorCount, dev) != hipSuccess) { g_grid = -1; return false; }
    if (hipFuncSetAttribute((const void*)fwd, hipFuncAttributeMaxDynamicSharedMemorySize, LDS_BYTES) != hipSuccess) { fprintf(stderr, "hipFuncSetAttribute failed\n"); g_grid = -1; return false; }
    if (hipOccupancyMaxActiveBlocksPerMultiprocessor(&per_cu, (const void*)fwd, 512, LDS_BYTES) != hipSuccess || per_cu < 1) { fprintf(stderr, "occupancy query: %d\n", per_cu); (void)hipGetLastError(); g_grid = -1; return false; }
    g_grid = cus;
    return true;
}
static void run(void* const* d_in, float* out, unsigned char* ws, hipStream_t st, int lo, int hi, bool coop) {
    if (!setup()) return;
    (void)hipMemsetAsync(ws + WS_CTL, 0, CTL_ZERO_BYTES, st);
    Args a{};
    for (int i = 0; i < 25; ++i) a.in[i] = (const float*)d_in[i];
    a.out = out; a.ws = ws;
    if (coop) { a.ph_lo = lo; a.ph_hi = hi;
        hipLaunchKernelGGL(fwd, dim3(g_grid), dim3(512), LDS_BYTES, st, a);
    } else {
        for (int p = lo; p < hi; ++p) { a.ph_lo = p; a.ph_hi = p + 1; hipLaunchKernelGGL(fwd, dim3(g_grid), dim3(512), LDS_BYTES, st, a); }
    }
}
}
#ifndef DBG_STAGE
#define DBG_STAGE 0
#endif
#ifndef N_LAUNCHES
#define N_LAUNCHES 1
#endif
#if DBG_STAGE
namespace dbg {
template <typename TIn> __global__ void k_sample(const TIn* src, int ld, int col0, int ncols, int stride, float* dst) {
    const int i = blockIdx.x; const size_t row = (size_t)i * stride;
    for (int c = threadIdx.x; c < ncols; c += blockDim.x) { float v; if (sizeof(TIn) == 2) v = __builtin_bit_cast(float, (unsigned)(*(const unsigned short*)&src[row * ld + col0 + c]) << 16); else v = (float)(*(const float*)&src[row * ld + col0 + c]); dst[(size_t)i * ncols + c] = v; }
}
__global__ void k_cmp(const float* smp, int sld, int scol0, int n, int stride, const float* ref, int ldr, int rcol0, const float* rowscale, float* acc) {
    __shared__ float r0[256], r1[256];
    const int i = blockIdx.x; const size_t row = (size_t)i * stride; const float sc = rowscale ? rowscale[row] : 1.f;
    float d2 = 0.f, f2 = 0.f;
    for (int c = threadIdx.x; c < n; c += blockDim.x) { const float r = ref[row * ldr + rcol0 + c] * sc, s = smp[(size_t)i * sld + scol0 + c]; const float d = s - r; d2 += d * d; f2 += r * r; }
    r0[threadIdx.x] = d2; r1[threadIdx.x] = f2; __syncthreads();
    for (int o = 128; o > 0; o >>= 1) { if (threadIdx.x < o) { r0[threadIdx.x] += r0[threadIdx.x + o]; r1[threadIdx.x] += r1[threadIdx.x + o]; } __syncthreads(); }
    if (threadIdx.x == 0) { atomicAdd(&acc[0], r0[0]); atomicAdd(&acc[1], r1[0]); }
}
__global__ void k_scale(float* out, const float* acc, int nchk, int raw, float tol) {
    float delta = 0.f;
    if (raw >= 0) { const float e = sqrtf(acc[2 * raw] / fmaxf(acc[2 * raw + 1], 1e-30f)); delta = 4.f * fminf(e, 2.f); if (!(e == e)) delta = 9.f; }
    else for (int i = 0; i < nchk; ++i) { const float e = sqrtf(acc[2 * i] / fmaxf(acc[2 * i + 1], 1e-30f)); if (!(e <= tol)) { delta = 0.1f * (i + 1) + 0.05f * ((e == e) ? fminf(e, 1.f) : 1.f); break; } }
    const size_t idx = (size_t)blockIdx.x * blockDim.x + threadIdx.x;
    out[idx] *= (1.f + delta);
}
struct Ctx { unsigned char* ws; float* out; float* smp; float* acc; };
#ifndef DBG_RAW
#define DBG_RAW -1
#endif
#ifndef DBG_TOL
#define DBG_TOL 0.02f
#endif
constexpr size_t SM0 = 0, SM1 = 2 * 1024 * 1024 + 65536;
static void hook(int stage, void* vctx, hipStream_t st) {
    Ctx& c = *(Ctx*)vctx; unsigned char* ws = c.ws;
    const float* bufA = (const float*)(ws + nv::W_A); const float* proj = (const float*)(ws + nv::W_B); const float* ymr = (const float*)(ws + nv::W_C);
#if DBG_STAGE == 3
    if (stage == 2) k_cmp<<<964, 256, 0, st>>>(c.smp + SM0, 2048, 0, 2048, 17, bufA, 2048, 0, nullptr, c.acc + 0);
    if (stage == 3) { k_cmp<<<529, 256, 0, st>>>(c.smp + SM1, 6144, 0, 4096, 31, proj, nv::INW, 0, nullptr, c.acc + 2);
                      k_cmp<<<529, 256, 0, st>>>(c.smp + SM1, 6144, 4096, 2048, 31, proj, nv::INW, 4104, nullptr, c.acc + 4); }
#elif DBG_STAGE == 6
    if (stage == 6) { k_cmp<<<964, 256, 0, st>>>(c.smp + SM0, 2048, 0, 1024, 17, ymr, 2048, 0, nullptr, c.acc + 0);
                      k_cmp<<<964, 256, 0, st>>>(c.smp + SM0, 2048, 1024, 1024, 17, ymr, 2048, 1024, nullptr, c.acc + 2); }
#elif DBG_STAGE == 7
    if (stage == 7) k_cmp<<<964, 256, 0, st>>>(c.smp + SM0, 2048, 0, 2048, 17, c.out, 2048, 0, nullptr, c.acc + 0);
#elif DBG_STAGE == 8
    if (stage == 8) k_cmp<<<964, 256, 0, st>>>(c.smp + SM0, 2048, 0, 2048, 17, bufA, 2048, 0, nullptr, c.acc + 0);
    if (stage == 9) { k_cmp<<<964, 256, 0, st>>>(c.smp + SM1, 4, 0, 2, 17, (const float*)(ws + nv::W_R4), 4, 0, nullptr, c.acc + 2);
                      k_cmp<<<964, 256, 0, st>>>(c.smp + SM1, 4, 2, 2, 17, (const float*)(ws + nv::W_R4), 4, 2, nullptr, c.acc + 4); }
#elif DBG_STAGE == 10
    if (stage == 10) k_cmp<<<1928, 256, 0, st>>>(c.smp + SM0, 2048, 0, 2048, 17, proj + (size_t)4 * nv::T_ * 512, 2048, 0, (const float*)(ws + nv::W_GW), c.acc + 0);
#endif
}
}
#endif

extern "C" void kernel_launch(void* const* d_in, const int* in_sizes, int n_in, void* d_out, int out_size, void* d_ws, size_t ws_size, hipStream_t stream) {
    if (n_in != 25 || ws_size < fk::WS_END) { fprintf(stderr, "kernel_launch: unexpected n_in %d / ws_size %zu\n", n_in, ws_size); return; }
    unsigned char* ws = (unsigned char*)d_ws; float* out = (float*)d_out;
#if DBG_STAGE == 0
    fk::run(d_in, out, ws, stream, 0, fk::NPHASE, N_LAUNCHES == 1);
#else
    if (ws_size < nv::W_END + 24 * nv::MiB_) { fprintf(stderr, "debug build: ws too small\n"); return; }
    float* smp = (float*)(ws + ws_size - 24 * nv::MiB_); float* acc = smp + 6 * 1024 * 1024 - 64;
    (void)hipMemsetAsync(acc, 0, 256, stream);
#if DBG_STAGE == 3
    fk::run(d_in, out, ws, stream, 0, 3, N_LAUNCHES == 1);
    dbg::k_sample<unsigned short><<<964, 256, 0, stream>>>((const unsigned short*)(ws + fk::WS_HN), 2048, 0, 2048, 17, smp + dbg::SM0);
    dbg::k_sample<unsigned short><<<529, 256, 0, stream>>>((const unsigned short*)(ws + fk::WS_PROJ), 6144, 0, 6144, 31, smp + dbg::SM1);
    const int nchk = 3;
#elif DBG_STAGE == 6
    fk::run(d_in, out, ws, stream, 0, 6, N_LAUNCHES == 1);
    dbg::k_sample<unsigned short><<<964, 256, 0, stream>>>((const unsigned short*)(ws + fk::WS_HN), 2048, 0, 2048, 17, smp + dbg::SM0);
    const int nchk = 2;
#elif DBG_STAGE == 7
    fk::run(d_in, out, ws, stream, 0, 7, N_LAUNCHES == 1);
    dbg::k_sample<float><<<964, 256, 0, stream>>>(out, 2048, 0, 2048, 17, smp + dbg::SM0);
    const int nchk = 1;
#elif DBG_STAGE == 8
    fk::run(d_in, out, ws, stream, 0, 8, N_LAUNCHES == 1);
    dbg::k_sample<unsigned short><<<964, 256, 0, stream>>>((const unsigned short*)(ws + fk::WS_HN), 2048, 0, 2048, 17, smp + dbg::SM0);
    dbg::k_sample<float><<<964, 256, 0, stream>>>((const float*)(ws + fk::WS_ROUTE), 4, 0, 4, 17, smp + dbg::SM1);
    const int nchk = 3;
#elif DBG_STAGE == 10
    fk::run(d_in, out, ws, stream, 0, 10, N_LAUNCHES == 1);
    dbg::k_sample<unsigned short><<<1928, 256, 0, stream>>>((const unsigned short*)(ws + fk::WS_YS), 2048, 0, 2048, 17, smp + dbg::SM0);
    const int nchk = 1;
#endif
    nv::In I; { const float** p = (const float**)&I; for (int i = 0; i < 25; ++i) p[i] = (const float*)d_in[i]; }
    dbg::Ctx ctx{ws, out, smp, acc};
    nv::run(I, out, ws, stream, dbg::hook, &ctx);
    dbg::k_scale<<<(fk::T * fk::DM) / 256, 256, 0, stream>>>(out, acc, nchk, DBG_RAW, DBG_TOL);
#endif
}
```

```cpp
#define DBG_STAGE 0
#define N_LAUNCHES 1
#define DBG_RAW -1
#include <hip/hip_runtime.h>
#include <hip/hip_cooperative_groups.h>
#include <cstdio>
#include <cstdint>
#include <cmath>
#define LAS __attribute__((address_space(3)))
#define GAS __attribute__((address_space(1)))
typedef unsigned short bf16_t;
typedef short bf16x8 __attribute__((ext_vector_type(8)));
typedef float f32x4 __attribute__((ext_vector_type(4)));
typedef float f32x2 __attribute__((ext_vector_type(2)));
typedef float f32x16 __attribute__((ext_vector_type(16)));
typedef unsigned u32x4 __attribute__((ext_vector_type(4)));
typedef unsigned u32x2 __attribute__((ext_vector_type(2)));

__device__ __forceinline__ unsigned f2bf(float f) { unsigned u = __builtin_bit_cast(unsigned, f); return (u + 0x7fffu + ((u >> 16) & 1u)) >> 16; }
__device__ __forceinline__ unsigned pk2(float lo, float hi) { return f2bf(lo) | (f2bf(hi) << 16); }
__device__ __forceinline__ float bflo(unsigned u) { return __builtin_bit_cast(float, u << 16); }
__device__ __forceinline__ float bfhi(unsigned u) { return __builtin_bit_cast(float, u & 0xffff0000u); }
__device__ __forceinline__ float bf1(bf16_t b) { return __builtin_bit_cast(float, (unsigned)b << 16); }
__device__ __forceinline__ float wave_sum(float v) {
#pragma unroll
    for (int o = 1; o < 64; o <<= 1) v += __shfl_xor(v, o);
    return v;
}
__device__ __forceinline__ float frcp(float x) { return __builtin_amdgcn_rcpf(x); }
__device__ __forceinline__ float fsigmoid(float x) { return frcp(1.f + __expf(-x)); }
__device__ __forceinline__ float fsilu(float x) { return x * frcp(1.f + __expf(-x)); }
__device__ __forceinline__ float flogsigmoid(float x) { return fminf(x, 0.f) - log1pf(expf(-fabsf(x))); }
__device__ __forceinline__ float fgelu_tanh(float x) { const float u = 0.7978845608028654f * (x + 0.044715f * x * x * x); const float e = __expf(2.f * u); const float th = 1.f - 2.f * frcp(e + 1.f); return 0.5f * x * (1.f + th); }
template <int CTRL, int ROW_MASK> __device__ __forceinline__ float dpp_add(float x) { const int v = __builtin_amdgcn_update_dpp(0, __builtin_bit_cast(int, x), CTRL, ROW_MASK, 0xf, true); return x + __builtin_bit_cast(float, v); }
__device__ __forceinline__ float half_sum31(float x) {
    x = dpp_add<0x111, 0xf>(x);
    x = dpp_add<0x112, 0xf>(x);
    x = dpp_add<0x114, 0xf>(x);
    x = dpp_add<0x118, 0xf>(x);
    x = dpp_add<0x142, 0xa>(x);
    return x;
}

namespace pg8 {
constexpr int BM = 256, BK = 64, HALF = 128, HTB = HALF * BK * 2  , STAGE_BYTES = 8 * HTB, NXCD = 8, WGM = 8;
__host__ __device__ __forceinline__ int lds_byte(int r, int c) { const int st = (r >> 4) * 2 + (c >> 5), rr = r & 15, cc = c & 31, ob = rr * 64 + cc * 2; return st * 1024 + (ob ^ (((ob >> 9) & 1) << 5)); }
__host__ __device__ __forceinline__ void stage_rc(int b, int& R, int& C) { const int st = b / 1024, sb = b % 1024, swz = sb ^ (((sb >> 9) & 1) << 5); R = (st >> 1) * 16 + swz / 64; C = (st & 1) * 32 + (swz % 64) / 2; }
__host__ __device__ __forceinline__ int perm32(int rho) { const int n = rho >> 4, i = rho & 15; return 8 * (i >> 2) + 4 * n + (i & 3); }

struct Unit { int pm, pn, e, mt; };

template <class Epi, class Sched>
__device__ __forceinline__ void gemm_phase(LAS unsigned char* lds, const int K, const Sched& S, const Epi& E) {
    int tid_o = threadIdx.x; asm volatile("" : "+v"(tid_o));
    const int tid = tid_o, wid = __builtin_amdgcn_readfirstlane(tid >> 6), lane = tid & 63, wr = wid >> 2, wc = wid & 3, fr = lane & 15, fq = lane >> 4;
    const int nt = K / BK;
    int Rr[2], Cc[2]; unsigned voffB[2];
#pragma unroll
    for (int i = 0; i < 2; ++i) { stage_rc(tid * 16 + i * 8192, Rr[i], Cc[i]); const int Rb = Epi::PERM ? ((Rr[i] & ~31) + perm32(Rr[i] & 31)) : Rr[i]; voffB[i] = (unsigned)(Rb * K + Cc[i]) * 2u; }
    const size_t kstep = (size_t)(BK * 2);
    const size_t hstep = (size_t)HALF * K * 2;
    const unsigned ldsw = (unsigned)wid * 1024u;
    const int aoff = lds_byte(wr * 64 + fr, fq * 8), boff = lds_byte(wc * 32 + fr, fq * 8);
#define PG8_SA(b, h) (((b) * 2 + (h)) * HTB)
#define PG8_SB(b, h) ((4 + (b) * 2 + (h)) * HTB)
#define PG8_STAGE(bufoff, gbase, voff) do { const char* _gb = (const char*)(gbase); asm volatile("" : "+s"(_gb));     \
        _Pragma("unroll") for (int _i = 0; _i < 2; ++_i) \
        __builtin_amdgcn_global_load_lds((const unsigned*)(_gb + (voff)[_i]), (LAS unsigned*)(lds + (bufoff) + ldsw + _i * 8192), 16, 0, 0); } while (0)
#define PG8_LDA(dst, b, h) do { _Pragma("unroll") for (int m = 0; m < 4; ++m) _Pragma("unroll") for (int k = 0; k < 2; ++k) dst[m][k] = *(const LAS bf16x8*)(lds + PG8_SA(b, h) + aoff + m * 2048 + k * 1024); } while (0)
#define PG8_LDB(dst, b, h) do { _Pragma("unroll") for (int n = 0; n < 2; ++n) _Pragma("unroll") for (int k = 0; k < 2; ++k) dst[n][k] = *(const LAS bf16x8*)(lds + PG8_SB(b, h) + boff + n * 2048 + k * 1024); } while (0)
#define PG8_MMA(ai, bj, At, Bt) do { __builtin_amdgcn_s_setprio(1); _Pragma("unroll") for (int m = 0; m < 4; ++m) _Pragma("unroll") for (int n = 0; n < 2; ++n) _Pragma("unroll") for (int k = 0; k < 2; ++k) \
        acc[ai][bj][m][n] = __builtin_amdgcn_mfma_f32_16x16x32_bf16(Bt[n][k], At[m][k], acc[ai][bj][m][n], 0, 0, 0); __builtin_amdgcn_s_setprio(0); } while (0)
#define PG8_WAIT_V(n) asm volatile("s_waitcnt vmcnt(" #n ")" ::: "memory")
#define PG8_WAIT_L(n) asm volatile("s_waitcnt lgkmcnt(" #n ")" ::: "memory")
#define PG8_BAR __builtin_amdgcn_s_barrier()
#define PG8_SCHED __builtin_amdgcn_sched_barrier(0)
    Unit cur, nxt; int ui = 0;
    if (!S.next(0, cur)) return;
    f32x4 acc[2][2][4][2];
#pragma unroll
    for (int a = 0; a < 2; ++a)
#pragma unroll
        for (int b = 0; b < 2; ++b)
#pragma unroll
            for (int m = 0; m < 4; ++m)
#pragma unroll
                for (int n = 0; n < 2; ++n) acc[a][b][m][n] = (f32x4){0.f, 0.f, 0.f, 0.f};
    bf16x8 At[4][2], B0[2][2], B1[2][2];
    unsigned vA[2][2], nvA[2][2];
    typename Epi::State est; E.pre(est, cur, wr, fr);
    S.a_off(cur, Rr, Cc, K, vA);
    const char* cA = S.a_base(cur); const char* cB = S.b_base(cur);
    PG8_STAGE(PG8_SB(0, 0), cB, voffB); PG8_STAGE(PG8_SB(0, 1), cB + hstep, voffB); PG8_STAGE(PG8_SA(0, 0), cA, vA[0]); PG8_STAGE(PG8_SA(0, 1), cA, vA[1]);
    if (wr == 1) PG8_BAR;
    PG8_WAIT_V(2); PG8_BAR;
    PG8_STAGE(PG8_SB(1, 0), cB + kstep, voffB); PG8_STAGE(PG8_SA(1, 0), cA + kstep, vA[0]); PG8_STAGE(PG8_SB(1, 1), cB + hstep + kstep, voffB);
    PG8_WAIT_V(6); PG8_BAR;
    for (;;) {
        const bool has_next = S.next(ui + 1, nxt);
        if (!has_next) nxt = cur;
        const char* nA = S.a_base(nxt); const char* nB = S.b_base(nxt);
        S.a_off(nxt, Rr, Cc, K, nvA);
        for (int t = 0; t < nt; t += 2) {
            const bool last = (t == nt - 2);
            const char* a1 = cA + (size_t)(t + 1) * kstep;
            const char* a2 = last ? nA : cA + (size_t)(t + 2) * kstep; const char* b2 = last ? nB : cB + (size_t)(t + 2) * kstep;
            const char* a3 = a2 + kstep; const char* b3 = b2 + kstep;
            unsigned w0[2], w1[2];
#pragma unroll
            for (int i = 0; i < 2; ++i) { w0[i] = last ? nvA[0][i] : vA[0][i]; w1[i] = last ? nvA[1][i] : vA[1][i]; }
            PG8_LDB(B0, 0, 0); PG8_LDB(B1, 0, 1); PG8_SCHED; PG8_LDA(At, 0, 0); PG8_STAGE(PG8_SA(1, 1), a1, vA[1]);
            PG8_WAIT_V(8); PG8_WAIT_L(0); PG8_BAR; PG8_MMA(0, 0, At, B0); PG8_MMA(0, 1, At, B1); PG8_BAR; PG8_SCHED;
            PG8_LDA(At, 0, 1); PG8_STAGE(PG8_SB(0, 0), b2, voffB); PG8_STAGE(PG8_SB(0, 1), b2 + hstep, voffB); PG8_STAGE(PG8_SA(0, 0), a2, w0);
            PG8_WAIT_V(8); PG8_WAIT_L(0); PG8_BAR; PG8_MMA(1, 0, At, B0); PG8_MMA(1, 1, At, B1); PG8_BAR; PG8_SCHED;
            PG8_LDB(B0, 1, 0); PG8_LDB(B1, 1, 1); PG8_SCHED; PG8_LDA(At, 1, 0); PG8_STAGE(PG8_SA(0, 1), a2, w1);
            PG8_WAIT_V(8); PG8_WAIT_L(0); PG8_BAR; PG8_MMA(0, 0, At, B0); PG8_MMA(0, 1, At, B1); PG8_BAR; PG8_SCHED;
            PG8_LDA(At, 1, 1); PG8_STAGE(PG8_SB(1, 0), b3, voffB); PG8_STAGE(PG8_SB(1, 1), b3 + hstep, voffB); PG8_STAGE(PG8_SA(1, 0), a3, w0);
            PG8_WAIT_V(8); PG8_WAIT_L(0); PG8_BAR; PG8_MMA(1, 0, At, B0); PG8_MMA(1, 1, At, B1); PG8_BAR; PG8_SCHED;
        }
        if (wr == 0) PG8_BAR;
        E(acc, cur, wr, wc, fr, fq, est);
        if (!has_next) break;
#pragma unroll
        for (int a = 0; a < 2; ++a)
#pragma unroll
            for (int b = 0; b < 2; ++b)
#pragma unroll
                for (int m = 0; m < 4; ++m)
#pragma unroll
                    for (int n = 0; n < 2; ++n) acc[a][b][m][n] = (f32x4){0.f, 0.f, 0.f, 0.f};
        cur = nxt; cA = nA; cB = nB; ++ui; E.pre(est, cur, wr, fr);
#pragma unroll
        for (int h = 0; h < 2; ++h)
#pragma unroll
            for (int i = 0; i < 2; ++i) vA[h][i] = nvA[h][i];
        if (wr == 1) PG8_BAR;
    }
    PG8_WAIT_V(0);
    PG8_BAR;
#undef PG8_SA
#undef PG8_SB
#undef PG8_STAGE
#undef PG8_LDA
#undef PG8_LDB
#undef PG8_MMA
#undef PG8_WAIT_V
#undef PG8_WAIT_L
#undef PG8_BAR
#undef PG8_SCHED
}
}
namespace fk {
constexpr int T = 16384, SEQ = 8192, DM = 2048, NPROJ = 6144, INW = 6152;
constexpr float EPS = 1e-6f;
constexpr size_t MiB = 1u << 20, KiB = 1u << 10;
constexpr size_t WS_CTL = 0, WS_DONE = 1024, WS_BAR = 4096, CTL_ZERO_BYTES = 32768;
constexpr size_t WS_MODP = 1 * MiB;
constexpr size_t WS_MOD = 2 * MiB;
constexpr size_t WS_WG8 = 2 * MiB + 256 * KiB;
constexpr size_t WS_WRH = 2 * MiB + 512 * KiB, WS_WRL = WS_WRH + 192 * KiB;
constexpr size_t WS_GTB = 3 * MiB, WS_GTW = 3 * MiB + 256 * KiB, WS_GTA = 3 * MiB + 512 * KiB;
constexpr size_t WS_BLAST = 3 * MiB + 768 * KiB, WS_ALAST = WS_BLAST + 4 * KiB, WS_DTOT = WS_BLAST + 8 * KiB, WS_CVEC = WS_BLAST + 9 * KiB;
constexpr size_t WS_LNS = 4 * MiB;
constexpr size_t WS_LRUA = 4 * MiB + 256 * KiB, WS_LRUH = 4 * MiB + 512 * KiB, WS_LRUC = 4 * MiB + 768 * KiB;
constexpr size_t WS_ROUTE = 5 * MiB;
constexpr size_t WS_LIST = 6 * MiB;
constexpr size_t WS_LW = 2 * MiB + 896 * KiB;
constexpr size_t WS_LISTW = 553 * MiB;
constexpr size_t WS_WLRU = 8 * MiB;
constexpr size_t WS_WIN = 9 * MiB;
constexpr size_t WS_WOUT = 33 * MiB;
constexpr size_t WS_WGU = 41 * MiB;
constexpr size_t WS_WDN = 169 * MiB;
constexpr size_t WS_HN = 233 * MiB;
constexpr size_t WS_PROJ = 297 * MiB;
constexpr size_t WS_HEXP = WS_PROJ, WS_YS = WS_PROJ + 40 * MiB;
constexpr size_t WS_LST = 489 * MiB;
constexpr size_t WS_X1B = WS_LST;
constexpr size_t WS_HLOC = 555 * MiB, WS_ACUM = 587 * MiB;
constexpr size_t WS_END = 619 * MiB;
constexpr int LDS_BYTES = 163840;
constexpr int L_CTL = 160 * 1024 - 1024;

struct Args { const float* in[25]; float* out; unsigned char* ws; int ph_lo, ph_hi; };
enum { I_X = 0, I_C, I_WADA, I_BADA, I_WIN, I_BGATES, I_CONVQK, I_MHG, I_LCW, I_LCB, I_WLA, I_BLA, I_WLX, I_BLX, I_LAM, I_LNG, I_WOUT, I_WGRP, I_BGRP, I_WRT, I_BRT, I_WEG, I_WEU, I_WED, I_FG };

#define LDS_WAIT() asm volatile("s_waitcnt lgkmcnt(0)" ::: "memory")
#define NT_LD(p) __builtin_nontemporal_load(p)
#define NT_ST(v, p) __builtin_nontemporal_store(v, p)
typedef __bf16 bf16x2_t __attribute__((ext_vector_type(2)));
__device__ __forceinline__ unsigned cvtpk(float lo, float hi) { f32x2 v = {lo, hi}; bf16x2_t b = __builtin_convertvector(v, bf16x2_t); return __builtin_bit_cast(unsigned, b); }

struct TrItem { const float* W; bf16_t* WT; int ldw, ldt; };
__device__ __forceinline__ void tr_load(const TrItem& t, f32x4 (&v)[16], int lane) {
#pragma unroll
    for (int i = 0; i < 16; ++i) v[i] = NT_LD((const f32x4*)(t.W + (size_t)(4 * i + (lane >> 4)) * t.ldw + (lane & 15) * 4));
}
__device__ __forceinline__ void tr_store(const TrItem& t, const f32x4 (&v)[16], LAS float* scr, int lane) {
#pragma unroll
    for (int i = 0; i < 16; ++i) { LAS float* sp = scr + (4 * i + (lane >> 4)) * 65 + (lane & 15) * 4; sp[0] = v[i].x; sp[1] = v[i].y; sp[2] = v[i].z; sp[3] = v[i].w; }
    LDS_WAIT(); asm volatile("" ::: "memory");
#pragma unroll
    for (int j = 0; j < 8; ++j) { const int pair = lane + 64 * j, c = pair & 7, n = pair >> 3; const LAS float* s = scr + (8 * c) * 65 + n;
        u32x4 o; o.x = cvtpk(s[0 * 65], s[1 * 65]); o.y = cvtpk(s[2 * 65], s[3 * 65]); o.z = cvtpk(s[4 * 65], s[5 * 65]); o.w = cvtpk(s[6 * 65], s[7 * 65]);
        NT_ST(o, (u32x4*)(t.WT + (size_t)n * t.ldt + 8 * c)); }
    LDS_WAIT(); asm volatile("" ::: "memory");
}
constexpr int TR_IN = 32 * 96, TR_OUT = 32 * 32, TR_L = 64, TR_G = 32 * 256, TR_U = TR_G, TR_D = 32 * 256;
#ifndef TR_KEEP
#define TR_KEEP 5632
#endif
constexpr int TR_EARLY = TR_IN + TR_OUT + TR_L + TR_KEEP, TR_ALL = TR_IN + TR_OUT + TR_L + TR_G + TR_U + TR_D;
__device__ __forceinline__ TrItem tr_mk(const float* W, int ldw, int k0, int n0src, bf16_t* WT, int ldt, int rowdst0) { TrItem t; t.W = W + (size_t)k0 * ldw + n0src; t.WT = WT + (size_t)rowdst0 * ldt + k0; t.ldw = ldw; t.ldt = ldt; return t; }
__device__ __forceinline__ TrItem tr_decode(const Args& a, int it) {
    unsigned char* ws = a.ws; int r = it;
    if (r < TR_IN) { const int kb = r / 96, nb = r % 96, n0 = 64 * nb; return tr_mk(a.in[I_WIN], INW, 64 * kb, n0 + (n0 >= 4096 ? 8 : 0), (bf16_t*)(ws + WS_WIN), 2048, n0); } r -= TR_IN;
    if (r < TR_OUT) { const int kb = r / 32, nb = r % 32; return tr_mk(a.in[I_WOUT], 2048, 64 * kb, 64 * nb, (bf16_t*)(ws + WS_WOUT), 2048, 64 * nb); } r -= TR_OUT;
    if (r < TR_L) { const int mi = r / 4, q = r % 4, kb = q / 2, nb = q % 2, n = mi >> 1, g = mi & 1;
        return tr_mk((g ? a.in[I_WLX] : a.in[I_WLA]) + (size_t)n * 16384, 128, 64 * kb, 64 * nb, (bf16_t*)(ws + WS_WLRU), 128, (n * 2 + g) * 128 + 64 * nb); } r -= TR_L;
    if (r < TR_G) { const int e = r / 256, q = r % 256, kb = q / 8, nb = q % 8, n0 = 64 * nb;
        return tr_mk(a.in[I_WEG] + (size_t)e * 2048 * 512, 512, 64 * kb, n0, (bf16_t*)(ws + WS_WGU), 2048, e * 1024 + (n0 / 128) * 256 + (n0 % 128)); } r -= TR_G;
    if (r < TR_U) { const int e = r / 256, q = r % 256, kb = q / 8, nb = q % 8, n0 = 64 * nb;
        return tr_mk(a.in[I_WEU] + (size_t)e * 2048 * 512, 512, 64 * kb, n0, (bf16_t*)(ws + WS_WGU), 2048, e * 1024 + (n0 / 128) * 256 + 128 + (n0 % 128)); } r -= TR_U;
    { const int e = r / 256, q = r % 256, kb = q / 32, nb = q % 32;
        return tr_mk(a.in[I_WED] + (size_t)e * 512 * 2048, 2048, 64 * kb, 64 * nb, (bf16_t*)(ws + WS_WDN), 512, e * 2048 + 64 * nb); }
}
__device__ __forceinline__ void p2_convert(const Args& a, LAS unsigned char* lds, int cw, int ncw) {
    int tid_o = threadIdx.x; asm volatile("" : "+v"(tid_o));
    const int lane = tid_o & 63, wave = __builtin_amdgcn_readfirstlane(tid_o >> 6);
    LAS float* scr = (LAS float*)(lds + wave * 16896);
    int it = TR_EARLY + cw; if (it >= TR_ALL) return;
#ifdef CONV3
    f32x4 va[16], vb[16], vc[16]; TrItem ta = tr_decode(a, it), tb = ta, tc = ta; tr_load(ta, va, lane);
    it += ncw; bool hb = it < TR_ALL; if (hb) { tb = tr_decode(a, it); tr_load(tb, vb, lane); }
#pragma unroll 1
    for (;;) {
        it += ncw; const bool hc = it < TR_ALL; if (hc) { tc = tr_decode(a, it); tr_load(tc, vc, lane); }
        tr_store(ta, va, scr, lane); if (!hb) break;
        it += ncw; const bool ha = it < TR_ALL; if (ha) { ta = tr_decode(a, it); tr_load(ta, va, lane); }
        tr_store(tb, vb, scr, lane); if (!hc) break;
        it += ncw; hb = it < TR_ALL; if (hb) { tb = tr_decode(a, it); tr_load(tb, vb, lane); }
        tr_store(tc, vc, scr, lane); if (!ha) break;
    }
#else
    f32x4 va[16], vb[16]; TrItem ta = tr_decode(a, it), tb = ta; tr_load(ta, va, lane);
#pragma unroll 1
    for (;;) {
        it += ncw; const bool hb = it < TR_ALL; if (hb) { tb = tr_decode(a, it); tr_load(tb, vb, lane); }
        tr_store(ta, va, scr, lane); if (!hb) break;
        it += ncw; const bool ha = it < TR_ALL; if (ha) { ta = tr_decode(a, it); tr_load(ta, va, lane); }
        tr_store(tb, vb, scr, lane); if (!ha) break;
    }
#endif
}
__device__ __forceinline__ void p0_prologue(const Args& a, LAS unsigned char* lds, int vcu, int G, int nconv) {
    int tid_o = threadIdx.x; asm volatile("" : "+v"(tid_o));
    const int tid = tid_o, lane = tid & 63, wave = __builtin_amdgcn_readfirstlane(tid >> 6);
    LAS float* scr = (LAS float*)(lds + wave * 16896);
    const int gw = vcu * 8 + wave, NGW = G * 8;
    unsigned char* ws = a.ws;
    const int nGw = (2 * G < 384) ? 2 * G : 384;
    const bool isG = wave < 2 && (vcu * 2 + wave) < 384;
    if (wave < 2) for (int task = vcu * 2 + wave; task < 384; task += 2 * G) {
        const int cg = task % 48, ks = task / 48, n = cg * 256 + lane * 4;
        const float* c = a.in[I_C]; const float* wada = a.in[I_WADA];
        f32x4 a0 = {0.f, 0.f, 0.f, 0.f}, a1 = {0.f, 0.f, 0.f, 0.f};
#pragma unroll 1
        for (int k0 = ks * 256; k0 < ks * 256 + 256; k0 += 16) { f32x4 w[16];
#pragma unroll
            for (int q = 0; q < 16; ++q) w[q] = NT_LD((const f32x4*)(wada + (size_t)(k0 + q) * 12288 + n));
#pragma unroll
            for (int q = 0; q < 16; ++q) { const float s0 = fsilu(c[k0 + q]), s1 = fsilu(c[2048 + k0 + q]); a0 += s0 * w[q]; a1 += s1 * w[q]; } }
        float* modp = (float*)(ws + WS_MODP);
        *(f32x4*)(modp + (size_t)(ks * 2 + 0) * 12288 + n) = a0; *(f32x4*)(modp + (size_t)(ks * 2 + 1) * 12288 + n) = a1;
    }
    const int NITEMS = nconv ? TR_EARLY : TR_ALL;
    const int N1 = nconv ? 0 : ((G == 256) ? 5 * NGW : NITEMS);
    const int before = (2 * vcu + (wave < 2 ? wave : 2)) < nGw ? (2 * vcu + (wave < 2 ? wave : 2)) : nGw;
    const int it2_0 = N1 + (gw - before), it2_s = NGW - nGw;
    for (int pass = 0; pass < 2; ++pass)
    for (int it = pass ? it2_0 : gw; it < (pass ? NITEMS : N1); it += (pass ? it2_s : NGW)) {
        if (pass && isG) break;
        TrItem t = tr_decode(a, it); f32x4 v[16]; tr_load(t, v, lane); tr_store(t, v, scr, lane);
    }
    const int gt = vcu * 512 + tid, NGT = G * 512;
    float* wg8 = (float*)(ws + WS_WG8); bf16_t* wrh = (bf16_t*)(ws + WS_WRH); bf16_t* wrl = (bf16_t*)(ws + WS_WRL);
    for (int i = gt; i < 8 * 2048; i += NGT) { const int g = i >> 11, k = i & 2047; wg8[i] = a.in[I_WIN][(size_t)k * INW + 4096 + g]; }
    for (int i = gt; i < 48 * 2048; i += NGT) { const int c = i >> 11, k = i & 2047; const float w = c < 4 ? a.in[I_WGRP][k * 4 + c] : (c < 36 ? a.in[I_WRT][k * 32 + (c - 4)] : 0.f);
        const unsigned hi = f2bf(w); wrh[i] = (bf16_t)hi; wrl[i] = (bf16_t)f2bf(w - bf1((bf16_t)hi)); }
}

__device__ __forceinline__ void p1_hn_gates(const Args& a, LAS unsigned char* lds, int vcu, int G) {
    int tid_o = threadIdx.x; asm volatile("" : "+v"(tid_o));
    const int tid = tid_o, lane = tid & 63, wave = __builtin_amdgcn_readfirstlane(tid >> 6);
    unsigned char* ws = a.ws;
    LAS float* modv = (LAS float*)lds;
    LAS float* wgs = (LAS float*)(lds + 16384);
    LAS float* gts = (LAS float*)(lds + 16384 + 65536);
    const float* modp = (const float*)(ws + WS_MODP); const float* bada = a.in[I_BADA];
    for (int i = tid; i < 8 * 2048; i += 512) wgs[i] = ((const float*)(ws + WS_WG8))[i];
    for (int ch = vcu; ch < 256; ch += G) {
        const int b = ch >> 7;
        __syncthreads();
        for (int i = tid; i < 4096; i += 512) { float v = bada[i]; for (int ks = 0; ks < 8; ++ks) v += modp[(size_t)(ks * 2 + b) * 12288 + i]; modv[i] = v; }
        if (ch < 72) {
            const int bb = ch / 36, n = ch % 36; float p = 0.f;
            for (int k = tid; k < 2048; k += 512) { float sh = bada[6144 + k]; for (int ks = 0; ks < 8; ++ks) sh += modp[(size_t)(ks * 2 + bb) * 12288 + 6144 + k];
                p += sh * (n < 4 ? a.in[I_WGRP][k * 4 + n] : a.in[I_WRT][k * 32 + (n - 4)]); }
            p = wave_sum(p); LAS float* red = gts + 512;
            if (lane == 0) red[wave] = p;
            __syncthreads();
            if (tid == 0) { float q = 0.f; for (int w = 0; w < 8; ++w) q += red[w]; ((float*)(ws + WS_CVEC))[bb * 48 + n] = q + (n < 4 ? a.in[I_BGRP][n] : a.in[I_BRT][n - 4]); }
        }
        if (tid < 96) { const int o = ch * 96 + tid, bb = o / 12288, col = o % 12288; float v = bada[col]; for (int ks = 0; ks < 8; ++ks) v += modp[(size_t)(ks * 2 + bb) * 12288 + col]; ((float*)(ws + WS_MOD))[o] = v; }
        __syncthreads();
#pragma unroll 1
        for (int i4 = 0; i4 < 2; ++i4) {
            const int rowb = ch * 64 + wave * 8 + i4 * 4;
            f32x4 v[4][8]; float rs[4];
#pragma unroll
            for (int r = 0; r < 4; ++r) { const f32x4* xr = (const f32x4*)(a.in[I_X] + (size_t)(rowb + r) * DM) + lane;
#pragma unroll
                for (int j = 0; j < 8; ++j) v[r][j] = NT_LD(xr + 64 * j); }
#pragma unroll
            for (int r = 0; r < 4; ++r) { float s = 0.f;
#pragma unroll
                for (int j = 0; j < 8; ++j) s += (v[r][j].x * v[r][j].x + v[r][j].y * v[r][j].y) + (v[r][j].z * v[r][j].z + v[r][j].w * v[r][j].w);
                rs[r] = rsqrtf(wave_sum(s) * (1.f / DM) + EPS); }
#pragma unroll
            for (int j = 0; j < 8; ++j) { const f32x4 sh = *(const LAS f32x4*)(modv + 4 * lane + 256 * j), sc = *(const LAS f32x4*)(modv + 2048 + 4 * lane + 256 * j) + 1.f;
#pragma unroll
                for (int r = 0; r < 4; ++r) { v[r][j] = v[r][j] * rs[r] * sc + sh;
                    u32x2* o8 = (u32x2*)((bf16_t*)(ws + WS_HN) + (size_t)(rowb + r) * DM) + lane; o8[64 * j] = (u32x2){cvtpk(v[r][j].x, v[r][j].y), cvtpk(v[r][j].z, v[r][j].w)}; } }
            float gv[4] = {0.f, 0.f, 0.f, 0.f};
#pragma unroll
            for (int g = 0; g < 8; ++g) { float p[4] = {0.f, 0.f, 0.f, 0.f};
#pragma unroll
                for (int j = 0; j < 8; ++j) { const f32x4 w = *(const LAS f32x4*)(wgs + g * 2048 + 4 * lane + 256 * j);
#pragma unroll
                    for (int r = 0; r < 4; ++r) p[r] += (v[r][j].x * w.x + v[r][j].y * w.y) + (v[r][j].z * w.z + v[r][j].w * w.w); }
#pragma unroll
                for (int r = 0; r < 4; ++r) { const float q = wave_sum(p[r]); if (lane == g) gv[r] = q; } }
#pragma unroll
            for (int r = 0; r < 4; ++r) if (lane < 8) gts[(wave * 8 + i4 * 4 + r) * 8 + lane] = gv[r];
        }
        __syncthreads();
        if (wave < 4) {
            const int h = wave, row = ch * 64 + lane; const float* bg = a.in[I_BGATES];
            const float ig = gts[lane * 8 + h] + bg[h]; const float lf = flogsigmoid(gts[lane * 8 + 4 + h] + bg[4 + h]);
            float bc = lf;
#pragma unroll
            for (int o = 1; o < 64; o <<= 1) { const float t = __shfl_up(bc, o); if (lane >= o) bc += t; }
            const float w = ig - bc; float am = w;
#pragma unroll
            for (int o = 1; o < 64; o <<= 1) { const float t = __shfl_up(am, o); if (lane >= o) am = fmaxf(am, t); }
            ((float*)(ws + WS_GTB))[row * 4 + h] = bc; ((float*)(ws + WS_GTW))[row * 4 + h] = w; ((float*)(ws + WS_GTA))[row * 4 + h] = am;
            if (lane == 63) { const int bh = b * 4 + h, c = ch & 127; ((float*)(ws + WS_BLAST))[bh * 128 + c] = bc; ((float*)(ws + WS_ALAST))[bh * 128 + c] = am; }
        }
    }
    __syncthreads();
}

struct DenseSched {
    static constexpr bool GATHER = false;
    const char* A; const char* Bt; int K, nM, nN, nwg, G, c;
    __device__ __forceinline__ void init(const void* A_, const void* Bt_, int M, int N, int K_, int G_, int c_) { A = (const char*)A_; Bt = (const char*)Bt_; K = K_; nM = M / 256; nN = N / 256; nwg = nM * nN; G = G_; c = c_; }
    __device__ __forceinline__ bool next(int i, pg8::Unit& u) const {
#ifdef P2_DUP
        if (K == 2048 && nN == 24) { const int cnt = (nwg - c + G - 1) / G; if (i >= 2 * cnt) return false; if (i >= cnt) i -= cnt; }
#endif
        const long L = (long)i * G + c; if (L >= nwg) return false;
        int wgid = (int)L; { const int q = nwg / 8, r = nwg % 8, xcd = wgid % 8, off = wgid / 8; wgid = (xcd < r ? xcd * (q + 1) : r * (q + 1) + (xcd - r) * q) + off; }
        const int nig = 8 * nN, gid = wgid / nig, fm = gid * 8, gsz = (nM - fm) < 8 ? (nM - fm) : 8;
        u.pm = fm + ((wgid % nig) % gsz); u.pn = (wgid % nig) / gsz; u.e = 0; u.mt = 0; return true;
    }
    __device__ __forceinline__ const char* a_base(const pg8::Unit& u) const { return A + (size_t)u.pm * 256 * K * 2; }
    __device__ __forceinline__ const char* b_base(const pg8::Unit& u) const { return Bt + (size_t)u.pn * 256 * K * 2; }
    __device__ __forceinline__ void a_off(const pg8::Unit&, const int (&R)[2], const int (&C)[2], int K_, unsigned (&v)[2][2]) const {
#pragma unroll
        for (int h = 0; h < 2; ++h)
#pragma unroll
            for (int i = 0; i < 2; ++i) v[h][i] = (unsigned)((128 * h + R[i]) * K_ + C[i]) * 2u;
    }
};
#define EPI_NOSTATE struct State {}; __device__ __forceinline__ void pre(State&, const pg8::Unit&, int, int) const {}
struct EpiProj {
    static constexpr bool PERM = true; EPI_NOSTATE
    bf16_t* O; int ldc;
    __device__ __forceinline__ void operator()(const f32x4 (&acc)[2][2][4][2], const pg8::Unit& u, int wr, int wc, int fr, int fq, const State& est) const {
        const int row0 = u.pm * 256 + wr * 64 + fr, col0 = u.pn * 256 + wc * 32 + 8 * fq;
#pragma unroll
        for (int ai = 0; ai < 2; ++ai)
#pragma unroll
            for (int m = 0; m < 4; ++m) { bf16_t* rowp = O + (size_t)(row0 + ai * 128 + m * 16) * ldc + col0;
#pragma unroll
                for (int bj = 0; bj < 2; ++bj) { const f32x4 v0 = acc[ai][bj][m][0], v1 = acc[ai][bj][m][1];
                    u32x4 w; w.x = cvtpk(v0[0], v0[1]); w.y = cvtpk(v0[2], v0[3]); w.z = cvtpk(v1[0], v1[1]); w.w = cvtpk(v1[2], v1[3]);
                    *(u32x4*)(rowp + bj * 128) = w; } }
    }
};
struct EpiX1 {
    static constexpr bool PERM = true; EPI_NOSTATE
    const float* x; const float* mod; bf16_t* x1b;
    __device__ __forceinline__ void operator()(const f32x4 (&acc)[2][2][4][2], const pg8::Unit& u, int wr, int wc, int fr, int fq, const State& est) const {
        const int row0 = u.pm * 256 + wr * 64 + fr, col0 = u.pn * 256 + wc * 32 + 8 * fq;
        const float* g1 = mod + (size_t)((u.pm * 256) / SEQ) * 12288 + 4096;
#pragma unroll
        for (int bj = 0; bj < 2; ++bj) { const int col = col0 + bj * 128; const f32x4 ga = *(const f32x4*)(g1 + col), gb = *(const f32x4*)(g1 + col + 4);
#pragma unroll
            for (int ai = 0; ai < 2; ++ai)
#pragma unroll
                for (int m = 0; m < 4; ++m) { const size_t off = (size_t)(row0 + ai * 128 + m * 16) * DM + col; const f32x4 xa = NT_LD((const f32x4*)(x + off)), xb = NT_LD((const f32x4*)(x + off + 4));
                    const f32x4 va = xa + ga * acc[ai][bj][m][0], vb = xb + gb * acc[ai][bj][m][1];
                    *(u32x4*)(x1b + off) = (u32x4){cvtpk(va.x, va.y), cvtpk(va.z, va.w), cvtpk(vb.x, vb.y), cvtpk(vb.z, vb.w)}; } }
    }
};
template <int NT, bool GATH>
struct MoeSched {
    static constexpr bool GATHER = GATH;
    const LAS int* tp; const int* cnt; const int* list; const char* A; const char* Bt; int K, first, stride, end;
    __device__ __forceinline__ bool next(int i, pg8::Unit& u) const {
        const int L = first + i * stride; if (L >= end) return false;
        const int tile = L / NT; u.pn = L % NT;
        const int e = __builtin_amdgcn_readfirstlane((int)((const LAS unsigned short*)(tp + 160))[tile]);
        u.e = e; u.mt = tile - tp[e]; u.pm = tile; return true;
    }
    __device__ __forceinline__ const char* a_base(const pg8::Unit& u) const { return GATH ? A : A + (size_t)u.pm * 256 * K * 2; }
    __device__ __forceinline__ const char* b_base(const pg8::Unit& u) const { return Bt + ((size_t)u.e * NT + u.pn) * 256 * K * 2; }
    __device__ __forceinline__ void a_off(const pg8::Unit& u, const int (&R)[2], const int (&C)[2], int K_, unsigned (&v)[2][2]) const {
        if (GATH) { const int n = cnt[u.e]; const int* lp = list + (size_t)u.e * T + u.mt * 256;
#pragma unroll
            for (int h = 0; h < 2; ++h)
#pragma unroll
                for (int i = 0; i < 2; ++i) { const int r = 128 * h + R[i]; const int tok = (u.mt * 256 + r < n) ? (lp[r] >> 1) : 0; v[h][i] = (unsigned)(tok * K_ + C[i]) * 2u; }
        } else {
#pragma unroll
            for (int h = 0; h < 2; ++h)
#pragma unroll
                for (int i = 0; i < 2; ++i) v[h][i] = (unsigned)((128 * h + R[i]) * K_ + C[i]) * 2u;
        }
    }
};
struct EpiGateUp {
    static constexpr bool PERM = true; EPI_NOSTATE
    bf16_t* H;
    __device__ __forceinline__ void operator()(const f32x4 (&acc)[2][2][4][2], const pg8::Unit& u, int wr, int wc, int fr, int fq, const State& est) const {
        const int row0 = u.pm * 256 + wr * 64 + fr, col0 = u.pn * 128 + wc * 32 + 8 * fq;
#pragma unroll
        for (int ai = 0; ai < 2; ++ai)
#pragma unroll
            for (int m = 0; m < 4; ++m) { bf16_t* rowp = H + (size_t)(row0 + ai * 128 + m * 16) * 512 + col0;
                const f32x4 g0 = acc[ai][0][m][0], g1 = acc[ai][0][m][1], u0 = acc[ai][1][m][0], u1 = acc[ai][1][m][1];
                u32x4 w; w.x = cvtpk(fsilu(g0[0]) * u0[0], fsilu(g0[1]) * u0[1]); w.y = cvtpk(fsilu(g0[2]) * u0[2], fsilu(g0[3]) * u0[3]);
                w.z = cvtpk(fsilu(g1[0]) * u1[0], fsilu(g1[1]) * u1[1]); w.w = cvtpk(fsilu(g1[2]) * u1[2], fsilu(g1[3]) * u1[3]);
                *(u32x4*)rowp = w; }
    }
};
struct EpiDown {
    static constexpr bool PERM = true;
    struct State { unsigned pk[2][4]; };
    bf16_t* Y; const int* cnt; const int* list; const float* listw;
    __device__ __forceinline__ void pre(State& st, const pg8::Unit& u, int wr, int fr) const {
        const int n = cnt[u.e]; const size_t base = (size_t)u.e * T + u.mt * 256;
#pragma unroll
        for (int ai = 0; ai < 2; ++ai)
#pragma unroll
            for (int m = 0; m < 4; ++m) { const int r = ai * 128 + wr * 64 + m * 16 + fr; const bool ok = u.mt * 256 + r < n;
                const unsigned d = ok ? (unsigned)list[base + r] : 0xFFFFu; const float g = ok ? listw[base + r] : 0.f; st.pk[ai][m] = (cvtpk(0.f, g) & 0xffff0000u) | d; }
    }
    __device__ __forceinline__ void operator()(const f32x4 (&acc)[2][2][4][2], const pg8::Unit& u, int wr, int wc, int fr, int fq, const State& st) const {
        const int col0 = u.pn * 256 + wc * 32 + 8 * fq;
#pragma unroll
        for (int ai = 0; ai < 2; ++ai)
#pragma unroll
            for (int m = 0; m < 4; ++m) { const unsigned pk = st.pk[ai][m]; const unsigned dst = pk & 0xffffu;
                if (dst != 0xFFFFu) { const float gw = bfhi(pk); bf16_t* rowp = Y + (size_t)dst * DM + col0;
#pragma unroll
                    for (int bj = 0; bj < 2; ++bj) { const f32x4 v0 = acc[ai][bj][m][0] * gw, v1 = acc[ai][bj][m][1] * gw;
                        u32x4 w; w.x = cvtpk(v0[0], v0[1]); w.y = cvtpk(v0[2], v0[3]); w.z = cvtpk(v1[0], v1[1]); w.w = cvtpk(v1[2], v1[3]);
                        *(u32x4*)(rowp + bj * 128) = w; } } }
    }
};

constexpr int L_KWT = 0, L_VT = 36864, L_QS = 73728, L_KS = 107520, L_PS = 141312, L_F = 150528;
constexpr int L_WEXP = L_F, L_MT = L_F + 256, L_EI = L_F + 512, L_RDN = L_F + 768, L_BT = L_F + 1024, L_WK = L_F + 1280, L_NS = L_F + 1536, L_RSS = L_F + 2560, L_MCH = L_F + 4608, L_RN = L_F + 5248, L_GW = L_F + 5504, L_GA = L_GW + 1024, L_GB = L_GA + 1024, L_AL = L_GB + 1024;
static_assert(L_AL + 16 <= L_CTL, "mixer LDS map");

#define MLSTM_LOAD_RAW(cc) do { const int c_ = (cc), r0c_ = b * SEQ + c_ * 64, dp_ = tid & 127, tg_ = tid >> 7, d0_ = 2 * dp_, s0_ = 16 * tg_, tt0_ = c_ * 64 + s0_; \
          _Pragma("unroll") for (int q = 0; q < 19; ++q) { const int ti = tt0_ - 3 + q; rawk[q] = ti >= 0 ? (FULL ? NT_LD((const unsigned*)(PROJ + (size_t)(r0c_ + s0_ - 3 + q) * NPROJ + 1024 + h * 256 + d0_)) : *(const unsigned*)(PROJ + (size_t)(r0c_ + s0_ - 3 + q) * NPROJ + 1024 + h * 256 + d0_)) : 0u; } \
          } while (0)
#define MLSTM_LOAD_RAWV(cc) do { const int c_ = (cc), r0c_ = b * SEQ + c_ * 64, dp_ = tid & 127, tg_ = tid >> 7, d0_ = 2 * dp_, s0_ = 16 * tg_; \
          _Pragma("unroll") for (int q = 0; q < 16; ++q) rawv[q] = FULL ? NT_LD((const unsigned*)(PROJ + (size_t)(r0c_ + s0_ + q) * NPROJ + 2048 + h * 256 + d0_)) : *(const unsigned*)(PROJ + (size_t)(r0c_ + s0_ + q) * NPROJ + 2048 + h * 256 + d0_); } while (0)
#define MLSTM_LOAD_RAWQ(cc) do { const int c_ = (cc), r0c_ = b * SEQ + c_ * 64, dp_ = tid & 127, tg_ = tid >> 7, d0_ = 2 * dp_, s0_ = 16 * tg_, tt0_ = c_ * 64 + s0_; \
          _Pragma("unroll") for (int q = 0; q < 19; ++q) { const int ti = tt0_ - 3 + q; rawq[q] = ti >= 0 ? NT_LD((const unsigned*)(PROJ + (size_t)(r0c_ + s0_ - 3 + q) * NPROJ + h * 256 + d0_)) : 0u; } } while (0)
template <bool FULL>
__device__ __forceinline__ void mlstm_unit(const Args& a, LAS unsigned char* lds, int bh, int j) {
    int tid_o0 = threadIdx.x; asm volatile("" : "+v"(tid_o0));
    const int tid = tid_o0, lane = tid & 63, wave = __builtin_amdgcn_readfirstlane(tid >> 6), hh = lane >> 5, l31 = lane & 31;
    const int b = bh >> 2, h = bh & 3;
    unsigned char* ws = a.ws;
    const bf16_t* PROJ = (const bf16_t*)(ws + WS_PROJ);
    const float* BLAST = (const float*)(ws + WS_BLAST); const float* ALAST = (const float*)(ws + WS_ALAST);
    LAS float* mch = (LAS float*)(lds + L_MCH); LAS float* nsv = (LAS float*)(lds + L_NS);
    LAS float* WEXP = (LAS float*)(lds + L_WEXP); LAS float* MT = (LAS float*)(lds + L_MT); LAS float* EI = (LAS float*)(lds + L_EI); LAS float* RDN = (LAS float*)(lds + L_RDN);
    LAS float* BT = (LAS float*)(lds + L_BT); LAS float* WK = (LAS float*)(lds + L_WK); LAS float* RSS = (LAS float*)(lds + L_RSS); LAS float* RN = (LAS float*)(lds + L_RN);
    const int unit = bh * 32 + j;
    __syncthreads();
    if (wave == 0) {
        const float pa = BLAST[bh * 128 + 2 * lane], qa = ALAST[bh * 128 + 2 * lane] + pa, pb = BLAST[bh * 128 + 2 * lane + 1], qb = ALAST[bh * 128 + 2 * lane + 1] + pb;
        float P = pa + pb, Q = fmaxf(qa + pb, qb);
#pragma unroll
        for (int o = 1; o < 64; o <<= 1) { const float oP = __shfl_up(P, o), oQ = __shfl_up(Q, o); if (lane >= o) { Q = fmaxf(oQ + P, Q); P = oP + P; } }
        float eP = __shfl_up(P, 1), eQ = __shfl_up(Q, 1); if (lane == 0) { eP = 0.f; eQ = -INFINITY; }
        const float m0 = fmaxf(eP, eQ), m1 = fmaxf(m0 + pa, qa);
        mch[2 * lane] = m0; mch[2 * lane + 1] = m1;
    }
    f32x16 C[8];
#pragma unroll
    for (int dt = 0; dt < 8; ++dt)
#pragma unroll
        for (int r = 0; r < 16; ++r) C[dt][r] = 0.f;
    if (FULL && j > 0) {
        const bf16_t* st = (const bf16_t*)(ws + WS_LST) + (size_t)(unit - 1) * 65536;
#pragma unroll
        for (int dt = 0; dt < 8; ++dt)
#pragma unroll
            for (int q = 0; q < 4; ++q) { const u32x2 v = NT_LD((const u32x2*)(st + ((dt * 4 + q) * 512 + tid) * 4)); C[dt][4 * q] = bflo(v.x); C[dt][4 * q + 1] = bfhi(v.x); C[dt][4 * q + 2] = bflo(v.y); C[dt][4 * q + 3] = bfhi(v.y); }
    }
    if (tid < 256) nsv[tid] = (FULL && j > 0) ? ((const float*)(ws + WS_LNS))[(size_t)(unit - 1) * 256 + tid] : 0.f;
    if (tid < 256) { const int row = b * SEQ + j * 256 + tid;
        ((LAS float*)(lds + L_GW))[tid] = ((const float*)(ws + WS_GTW))[row * 4 + h]; ((LAS float*)(lds + L_GA))[tid] = ((const float*)(ws + WS_GTA))[row * 4 + h]; ((LAS float*)(lds + L_GB))[tid] = ((const float*)(ws + WS_GTB))[row * 4 + h]; }
    if (tid < 4) ((LAS float*)(lds + L_AL))[tid] = ALAST[bh * 128 + 4 * j + tid];
    float dtot_log = 0.f;
    __syncthreads();
#pragma unroll 1
    for (int i = 0; i < 4; ++i) {
        int tid_o = threadIdx.x; asm volatile("" : "+v"(tid_o));
        const int tid = tid_o, lane = tid & 63, hh = lane >> 5, l31 = lane & 31;
        const int c = 4 * j + i; const int r0c = b * SEQ + c * 64;
        const float mc = mch[c]; const float M63 = fmaxf(mc, ((const LAS float*)(lds + L_AL))[i]); const float decay = __expf(mc - M63);
        dtot_log += mc - M63;
        unsigned rawk[19], rawv[16], rawq[19]; MLSTM_LOAD_RAW(c); MLSTM_LOAD_RAWV(c); if (FULL) MLSTM_LOAD_RAWQ(c);
        float cwk[4][2], cwq[4][2];
        { const float* cw = a.in[I_CONVQK]; const int d0 = 2 * (tid & 127);
#pragma unroll
          for (int q = 0; q < 4; ++q) { cwk[q][0] = cw[q * 2048 + 1024 + h * 256 + d0]; cwk[q][1] = cw[q * 2048 + 1024 + h * 256 + d0 + 1]; if (FULL) { cwq[q][0] = cw[q * 2048 + h * 256 + d0]; cwq[q][1] = cw[q * 2048 + h * 256 + d0 + 1]; } } }
        if (tid < 64) { const float w = ((const LAS float*)(lds + L_GW))[i * 64 + tid], am = ((const LAS float*)(lds + L_GA))[i * 64 + tid], bt = ((const LAS float*)(lds + L_GB))[i * 64 + tid];
            const float Mt = fmaxf(mc, am); WEXP[tid] = w; MT[tid] = Mt; EI[tid] = __expf(mc - Mt); BT[tid] = bt; WK[tid] = __expf(w - M63); }
        __syncthreads();
        {
            const int dp = tid & 127, tg = tid >> 7, d0 = 2 * dp, s0 = 16 * tg;
            const int tt0 = c * 64 + s0;
            const float* cw = a.in[I_CONVQK];
            {
                const float (&w)[4][2] = cwk;
                const unsigned (&raw)[19] = rawk;
                unsigned pa[8], pb[8]; float ka = 0.f, kb = 0.f;
#pragma unroll
                for (int s = 0; s < 16; ++s) { float x0 = 0.f, x1 = 0.f;
#pragma unroll
                    for (int q = 0; q < 4; ++q) { x0 += w[q][0] * bflo(raw[s + q]); x1 += w[q][1] * bfhi(raw[s + q]); }
                    x0 = fsilu(x0) * 0.0625f; x1 = fsilu(x1) * 0.0625f;
                    if (FULL) *(LAS unsigned*)(lds + L_KS + (s0 + s) * 528 + d0 * 2) = cvtpk(x0, x1);
                    const float wk = WK[s0 + s]; x0 *= wk; x1 *= wk;
                    if (s & 1) { pa[s >> 1] = cvtpk(ka, x0); pb[s >> 1] = cvtpk(kb, x1); } else { ka = x0; kb = x1; } }
                *(LAS u32x4*)(lds + L_KWT + d0 * 144 + s0 * 2) = (u32x4){pa[0], pa[1], pa[2], pa[3]}; *(LAS u32x4*)(lds + L_KWT + d0 * 144 + s0 * 2 + 16) = (u32x4){pa[4], pa[5], pa[6], pa[7]};
                *(LAS u32x4*)(lds + L_KWT + (d0 + 1) * 144 + s0 * 2) = (u32x4){pb[0], pb[1], pb[2], pb[3]}; *(LAS u32x4*)(lds + L_KWT + (d0 + 1) * 144 + s0 * 2 + 16) = (u32x4){pb[4], pb[5], pb[6], pb[7]};
            }
            __builtin_amdgcn_sched_barrier(0);
            {
                const unsigned (&raw)[16] = rawv;
                unsigned pa[8], pb[8];
#pragma unroll
                for (int q = 0; q < 8; ++q) { pa[q] = (raw[2 * q] & 0xffffu) | (raw[2 * q + 1] << 16); pb[q] = (raw[2 * q] >> 16) | (raw[2 * q + 1] & 0xffff0000u); }
                *(LAS u32x4*)(lds + L_VT + d0 * 144 + s0 * 2) = (u32x4){pa[0], pa[1], pa[2], pa[3]}; *(LAS u32x4*)(lds + L_VT + d0 * 144 + s0 * 2 + 16) = (u32x4){pa[4], pa[5], pa[6], pa[7]};
                *(LAS u32x4*)(lds + L_VT + (d0 + 1) * 144 + s0 * 2) = (u32x4){pb[0], pb[1], pb[2], pb[3]}; *(LAS u32x4*)(lds + L_VT + (d0 + 1) * 144 + s0 * 2 + 16) = (u32x4){pb[4], pb[5], pb[6], pb[7]};
            }
            __builtin_amdgcn_sched_barrier(0);
            if (FULL) {
                const float (&w)[4][2] = cwq;
                const unsigned (&raw)[19] = rawq;
#pragma unroll
                for (int s = 0; s < 16; ++s) { float x0 = 0.f, x1 = 0.f;
#pragma unroll
                    for (int q = 0; q < 4; ++q) { x0 += w[q][0] * bflo(raw[s + q]); x1 += w[q][1] * bfhi(raw[s + q]); }
                    *(LAS unsigned*)(lds + L_QS + (s0 + s) * 528 + d0 * 2) = cvtpk(fsilu(x0), fsilu(x1)); }
            }
        }
        __syncthreads();
        if (FULL) {
            {
                const int tr = wave >> 1, tc0 = 2 * (wave & 1), fr = lane & 15, fq = lane >> 4;
                f32x4 s0 = {0.f, 0.f, 0.f, 0.f}, s1 = {0.f, 0.f, 0.f, 0.f};
#pragma unroll
                for (int ks = 0; ks < 8; ++ks) {
                    const bf16x8 af = *(const LAS bf16x8*)(lds + L_QS + (16 * tr + fr) * 528 + (32 * ks + 8 * fq) * 2);
                    const bf16x8 b0 = *(const LAS bf16x8*)(lds + L_KS + (16 * tc0 + fr) * 528 + (32 * ks + 8 * fq) * 2);
                    const bf16x8 b1 = *(const LAS bf16x8*)(lds + L_KS + (16 * (tc0 + 1) + fr) * 528 + (32 * ks + 8 * fq) * 2);
                    s0 = __builtin_amdgcn_mfma_f32_16x16x32_bf16(af, b0, s0, 0, 0, 0); s1 = __builtin_amdgcn_mfma_f32_16x16x32_bf16(af, b1, s1, 0, 0, 0);
                }
                const float we0 = WEXP[16 * tc0 + fr], we1 = WEXP[16 * (tc0 + 1) + fr];
#pragma unroll
                for (int r = 0; r < 4; ++r) { const int t = 16 * tr + 4 * fq + r; const float Mt = MT[t];
                    { const int s = 16 * tc0 + fr; const float ex = __expf(fminf(we0 - Mt, 0.f)); const float p = (s <= t) ? s0[r] * ex : 0.f; *(LAS bf16_t*)(lds + L_PS + t * 144 + s * 2) = (bf16_t)cvtpk(p, 0.f); }
                    { const int s = 16 * (tc0 + 1) + fr; const float ex = __expf(fminf(we1 - Mt, 0.f)); const float p = (s <= t) ? s1[r] * ex : 0.f; *(LAS bf16_t*)(lds + L_PS + t * 144 + s * 2) = (bf16_t)cvtpk(p, 0.f); } }
            }
            __syncthreads();
            u32x4 oreg[4];
#pragma unroll
            for (int q = 0; q < 4; ++q) { const int idx = q * 512 + tid, t = idx >> 5, ch = idx & 31; oreg[q] = NT_LD((const u32x4*)(PROJ + (size_t)(r0c + t) * NPROJ + 3072 + h * 256 + ch * 8)); }
            {
                const int t = tid >> 3, p = tid & 7;
                const u32x4 pv = *(const LAS u32x4*)(lds + L_PS + t * 144 + p * 16);
                float sp = (bflo(pv.x) + bfhi(pv.x)) + (bflo(pv.y) + bfhi(pv.y)) + (bflo(pv.z) + bfhi(pv.z)) + (bflo(pv.w) + bfhi(pv.w));
                float qn = 0.f;
#pragma unroll
                for (int q = 0; q < 4; ++q) { const u32x4 qv = *(const LAS u32x4*)(lds + L_QS + t * 528 + (32 * p + 8 * q) * 2); const LAS float* np = nsv + 32 * p + 8 * q;
                    qn += bflo(qv.x) * np[0] + bfhi(qv.x) * np[1] + bflo(qv.y) * np[2] + bfhi(qv.y) * np[3] + bflo(qv.z) * np[4] + bfhi(qv.z) * np[5] + bflo(qv.w) * np[6] + bfhi(qv.w) * np[7]; }
                sp += __shfl_xor(sp, 1); sp += __shfl_xor(sp, 2); sp += __shfl_xor(sp, 4);
                qn += __shfl_xor(qn, 1); qn += __shfl_xor(qn, 2); qn += __shfl_xor(qn, 4);
                if (p == 0) { const float den = sp + EI[t] * qn; RDN[t] = frcp(fmaxf(fabsf(den), __expf(-(BT[t] + MT[t])))); }
            }
            f32x16 nacc[2];
#pragma unroll
            for (int tt = 0; tt < 2; ++tt)
#pragma unroll
                for (int r = 0; r < 16; ++r) nacc[tt][r] = 0.f;
#pragma unroll
            for (int dt = 0; dt < 8; ++dt)
#pragma unroll
                for (int sp = 0; sp < 2; ++sp) {
                    __builtin_amdgcn_sched_barrier(0);
                    bf16x8 bfr; { u32x4 t4; t4.x = cvtpk(C[dt][8 * sp + 0], C[dt][8 * sp + 1]); t4.y = cvtpk(C[dt][8 * sp + 2], C[dt][8 * sp + 3]); t4.z = cvtpk(C[dt][8 * sp + 4], C[dt][8 * sp + 5]); t4.w = cvtpk(C[dt][8 * sp + 6], C[dt][8 * sp + 7]); bfr = __builtin_bit_cast(bf16x8, t4); }
#pragma unroll
                    for (int tt = 0; tt < 2; ++tt) {
                        const u32x2 lo = *(const LAS u32x2*)(lds + L_QS + (32 * tt + l31) * 528 + (32 * dt + 16 * sp + 4 * hh) * 2);
                        const u32x2 hi = *(const LAS u32x2*)(lds + L_QS + (32 * tt + l31) * 528 + (32 * dt + 16 * sp + 8 + 4 * hh) * 2);
                        const u32x4 a4 = {lo.x, lo.y, hi.x, hi.y};
                        nacc[tt] = __builtin_amdgcn_mfma_f32_32x32x16_bf16(__builtin_bit_cast(bf16x8, a4), bfr, nacc[tt], 0, 0, 0);
                    }
                }
#pragma unroll
            for (int tt = 0; tt < 2; ++tt)
#pragma unroll
                for (int r = 0; r < 16; ++r) nacc[tt][r] *= EI[32 * tt + (r & 3) + 8 * (r >> 2) + 4 * hh];
#pragma unroll
            for (int ks = 0; ks < 4; ++ks) {
                __builtin_amdgcn_sched_barrier(0);
                const bf16x8 bfr = *(const LAS bf16x8*)(lds + L_VT + (32 * wave + l31) * 144 + (16 * ks + 8 * hh) * 2);
#pragma unroll
                for (int tt = 0; tt < 2; ++tt) { const bf16x8 afr = *(const LAS bf16x8*)(lds + L_PS + (32 * tt + l31) * 144 + (16 * ks + 8 * hh) * 2);
                    nacc[tt] = __builtin_amdgcn_mfma_f32_32x32x16_bf16(afr, bfr, nacc[tt], 0, 0, 0); }
            }
#pragma unroll
            for (int q = 0; q < 4; ++q) { const int idx = q * 512 + tid, t = idx >> 5, ch = idx & 31; *(LAS u32x4*)(lds + L_KS + t * 528 + ch * 16) = oreg[q]; }
            __syncthreads();
#pragma unroll
            for (int tt = 0; tt < 2; ++tt)
#pragma unroll
                for (int r = 0; r < 16; ++r) { const int t = 32 * tt + (r & 3) + 8 * (r >> 2) + 4 * hh; const float hv = nacc[tt][r] * RDN[t]; nacc[tt][r] = hv;
                    const float q = half_sum31(hv * hv);
                    if (l31 == 31) RSS[wave * 64 + t] = q; }
            __syncthreads();
            if (tid < 64) { float q = 0.f;
#pragma unroll
                for (int w = 0; w < 8; ++w) q += RSS[w * 64 + tid];
                RN[tid] = rsqrtf(q * (1.f / 256.f) + EPS); }
            __syncthreads();
            {
                const int e = 32 * wave + l31; const float g = a.in[I_MHG][h * 256 + e];
#pragma unroll
                for (int tt = 0; tt < 2; ++tt)
#pragma unroll
                    for (int r = 0; r < 16; ++r) { const int t = 32 * tt + (r & 3) + 8 * (r >> 2) + 4 * hh;
                        const float o = bf1(*(const LAS bf16_t*)(lds + L_KS + t * 528 + e * 2));
                        *(LAS bf16_t*)(lds + L_QS + t * 528 + e * 2) = (bf16_t)cvtpk(nacc[tt][r] * RN[t] * g * fsigmoid(o), 0.f); }
            }
            __syncthreads();
            {
                bf16_t* ymr = (bf16_t*)(ws + WS_HN);
#pragma unroll
                for (int q = 0; q < 4; ++q) { const int idx = q * 512 + tid, t = idx >> 5, ch = idx & 31;
                    *(u32x4*)(ymr + (size_t)(r0c + t) * DM + h * 256 + ch * 8) = *(const LAS u32x4*)(lds + L_QS + t * 528 + ch * 16); }
            }
        }
#pragma unroll
        for (int dt = 0; dt < 8; ++dt)
#pragma unroll
            for (int r = 0; r < 16; ++r) C[dt][r] *= decay;
#pragma unroll
        for (int ks = 0; ks < 4; ++ks) {
            __builtin_amdgcn_sched_barrier(0);
            const bf16x8 bfr = *(const LAS bf16x8*)(lds + L_VT + (32 * wave + l31) * 144 + (16 * ks + 8 * hh) * 2);
#pragma unroll
            for (int dt = 0; dt < 8; ++dt) { const bf16x8 afr = *(const LAS bf16x8*)(lds + L_KWT + (32 * dt + l31) * 144 + (16 * ks + 8 * hh) * 2);
                C[dt] = __builtin_amdgcn_mfma_f32_32x32x16_bf16(afr, bfr, C[dt], 0, 0, 0); }
        }
        if (tid < 256) { float sk = 0.f;
#pragma unroll
            for (int q = 0; q < 8; ++q) { const u32x4 kv = *(const LAS u32x4*)(lds + L_KWT + tid * 144 + q * 16); sk += (bflo(kv.x) + bfhi(kv.x)) + (bflo(kv.y) + bfhi(kv.y)) + (bflo(kv.z) + bfhi(kv.z)) + (bflo(kv.w) + bfhi(kv.w)); }
            nsv[tid] = decay * nsv[tid] + sk; }
        __syncthreads();
    }
    if (!FULL) {
        bf16_t* st = (bf16_t*)(ws + WS_LST) + (size_t)unit * 65536;
#pragma unroll
        for (int dt = 0; dt < 8; ++dt)
#pragma unroll
            for (int q = 0; q < 4; ++q) *(u32x2*)(st + ((dt * 4 + q) * 512 + tid) * 4) = (u32x2){cvtpk(C[dt][4 * q], C[dt][4 * q + 1]), cvtpk(C[dt][4 * q + 2], C[dt][4 * q + 3])};
        if (tid < 256) ((float*)(ws + WS_LNS))[(size_t)unit * 256 + tid] = nsv[tid];
        if (tid == 0) ((float*)(ws + WS_DTOT))[unit] = __expf(dtot_log);
    }
}

constexpr int L_XS = 0, L_SEG = 69632, L_WL = L_SEG + 16384;
static_assert(L_WL + 2 * 128 * 272 <= L_CTL, "lru LDS map");
__device__ __forceinline__ void lru_unit(const Args& a, LAS unsigned char* lds, int b, int j, int n, bool load_w) {
    int tid_o = threadIdx.x; asm volatile("" : "+v"(tid_o));
    const int tid = tid_o, lane = tid & 63, wave = __builtin_amdgcn_readfirstlane(tid >> 6), hh = lane >> 5, l31 = lane & 31;
    unsigned char* ws = a.ws;
    const bf16_t* PROJ = (const bf16_t*)(ws + WS_PROJ);
    const int r0 = b * SEQ + j * 256, c0 = n * 128;
    const int unit = (b * 32 + j) * 8 + n;
    LAS float* SEG = (LAS float*)(lds + L_SEG);
    __syncthreads();
    if (load_w) {
        const bf16_t* WL = (const bf16_t*)(ws + WS_WLRU) + (size_t)n * 2 * 128 * 128;
#pragma unroll
        for (int q = 0; q < 8; ++q) { const int idx = q * 512 + tid, row = idx >> 4, ch = idx & 15;
            *(LAS u32x4*)(lds + L_WL + row * 272 + ch * 16) = *(const u32x4*)(WL + (size_t)row * 128 + ch * 8); }
    }
    {
        const int cp = tid & 63, tg = tid >> 6, c = 2 * cp, s0 = 32 * tg;
        const float* cw = a.in[I_LCW]; const float* cb = a.in[I_LCB];
        float w[4][2];
#pragma unroll
        for (int q = 0; q < 4; ++q) { w[q][0] = cw[q * 1024 + c0 + c]; w[q][1] = cw[q * 1024 + c0 + c + 1]; }
        const float b0 = cb[c0 + c], b1 = cb[c0 + c + 1];
        unsigned raw[35];
#pragma unroll
        for (int q = 0; q < 35; ++q) { const int ti = j * 256 + s0 - 3 + q; raw[q] = ti >= 0 ? NT_LD((const unsigned*)(PROJ + (size_t)(r0 + s0 - 3 + q) * NPROJ + 4096 + c0 + c)) : 0u; }
#pragma unroll
        for (int s = 0; s < 32; ++s) { float x0 = b0, x1 = b1;
#pragma unroll
            for (int q = 0; q < 4; ++q) { x0 += w[q][0] * bflo(raw[s + q]); x1 += w[q][1] * bfhi(raw[s + q]); }
            *(LAS unsigned*)(lds + L_XS + (s0 + s) * 272 + c * 2) = cvtpk(x0, x1); }
    }
    __syncthreads();
    float gba[4], gbx[4], glam[4];
#pragma unroll
    for (int nt = 0; nt < 4; ++nt) { const int c = c0 + 32 * nt + l31; gba[nt] = a.in[I_BLA][c]; gbx[nt] = a.in[I_BLX][c]; glam[nt] = a.in[I_LAM][c]; }
    f32x16 ar[4], ai[4];
#pragma unroll
    for (int nt = 0; nt < 4; ++nt)
#pragma unroll
        for (int r = 0; r < 16; ++r) { ar[nt][r] = 0.f; ai[nt][r] = 0.f; }
    {
        const int tau = 16 * ((l31 >> 2) & 1) + 4 * (l31 >> 3) + (l31 & 3);
#pragma unroll
        for (int ks = 0; ks < 8; ++ks) {
            const bf16x8 afr = *(const LAS bf16x8*)(lds + L_XS + (32 * wave + tau) * 272 + (16 * ks + 8 * hh) * 2);
#pragma unroll
            for (int nt = 0; nt < 4; ++nt) {
                const bf16x8 br = *(const LAS bf16x8*)(lds + L_WL + (32 * nt + l31) * 272 + (16 * ks + 8 * hh) * 2);
                const bf16x8 bi = *(const LAS bf16x8*)(lds + L_WL + (128 + 32 * nt + l31) * 272 + (16 * ks + 8 * hh) * 2);
                ar[nt] = __builtin_amdgcn_mfma_f32_32x32x16_bf16(afr, br, ar[nt], 0, 0, 0); ai[nt] = __builtin_amdgcn_mfma_f32_32x32x16_bf16(afr, bi, ai[nt], 0, 0, 0);
            }
        }
    }
#pragma unroll
    for (int nt = 0; nt < 4; ++nt) {
        __builtin_amdgcn_sched_barrier(0);
        const int d = 32 * nt + l31;
        const float ba = gba[nt], bx = gbx[nt], lsl = flogsigmoid(glam[nt]);
        float A = 1.f, H = 0.f;
#pragma unroll
        for (int r = 0; r < 16; ++r) {
            const int t = 32 * wave + 16 * hh + r;
            const float rg = fsigmoid(ar[nt][r] + ba), ig = fsigmoid(ai[nt][r] + bx);
            const float la = 8.f * rg * lsl; const float av = __expf(la);
            const float xr = bf1(*(const LAS bf16_t*)(lds + L_XS + t * 272 + d * 2));
            const float x2 = 2.f * la; const float om = (x2 > -0.02f) ? -x2 * (1.f + x2 * (0.5f + x2 * (1.f / 6.f))) : 1.f - __expf(x2);
            const float u = __builtin_amdgcn_sqrtf(om) * (ig * xr);
            ar[nt][r] = av; ai[nt][r] = u;
            A *= av; H = av * H + u;
        }
        SEG[((2 * wave + hh) * 128 + d) * 2] = A; SEG[((2 * wave + hh) * 128 + d) * 2 + 1] = H;
    }
    __syncthreads();
    if (tid < 128) {
        float hc = 0.f, At = 1.f;
#pragma unroll
        for (int sg = 0; sg < 16; ++sg) { const float A = SEG[(sg * 128 + tid) * 2], H = SEG[(sg * 128 + tid) * 2 + 1]; SEG[(sg * 128 + tid) * 2] = hc; SEG[(sg * 128 + tid) * 2 + 1] = At; hc = A * hc + H; At *= A; }
        ((float*)(ws + WS_LRUA))[(size_t)unit * 128 + tid] = At; ((float*)(ws + WS_LRUH))[(size_t)unit * 128 + tid] = hc;
    }
    __syncthreads();
#pragma unroll 1
    for (int round = 0; round < 2; ++round) {
#pragma unroll
        for (int nt = 0; nt < 4; ++nt) { const int d = 32 * nt + l31;
            float v = SEG[((2 * wave + hh) * 128 + d) * 2 + round];
#pragma unroll
            for (int r = 0; r < 16; ++r) { const int t = 32 * wave + 16 * hh + r;
                v = round ? v * ar[nt][r] : ar[nt][r] * v + ai[nt][r];
                *(LAS bf16_t*)(lds + L_XS + t * 272 + d * 2) = (bf16_t)cvtpk(v, 0.f); } }
        __syncthreads();
        bf16_t* dstb = (bf16_t*)(ws + (round ? WS_ACUM : WS_HLOC));
#pragma unroll
        for (int q = 0; q < 8; ++q) { const int idx = q * 512 + tid, t = idx >> 4, ch = idx & 15;
            *(u32x4*)(dstb + (size_t)(r0 + t) * 1024 + c0 + ch * 8) = *(const LAS u32x4*)(lds + L_XS + t * 272 + ch * 16); }
        __syncthreads();
    }
}
__device__ __forceinline__ void lru_out_unit(const Args& a, int b, int j, int n) {
    int tid_o = threadIdx.x; asm volatile("" : "+v"(tid_o));
    const int tid = tid_o, d8 = tid & 15;
    unsigned char* ws = a.ws;
    const bf16_t* PROJ = (const bf16_t*)(ws + WS_PROJ); const bf16_t* HL = (const bf16_t*)(ws + WS_HLOC); const bf16_t* AC = (const bf16_t*)(ws + WS_ACUM);
    const int r0 = b * SEQ + j * 256, c0 = n * 128 + 8 * d8;
    const float* cp = (const float*)(ws + WS_LRUC) + (size_t)(b * 32 + j) * 1024 + c0; const float* gp = a.in[I_LNG] + c0;
    const f32x4 ca = *(const f32x4*)cp, cb = *(const f32x4*)(cp + 4), ga = *(const f32x4*)gp, gb = *(const f32x4*)(gp + 4);
    u32x4 hl[8], ac[8], gr[8];
#pragma unroll
    for (int q = 0; q < 8; ++q) { const size_t t = (size_t)(r0 + (tid >> 4) + 32 * q);
        hl[q] = NT_LD((const u32x4*)(HL + t * 1024 + c0)); ac[q] = NT_LD((const u32x4*)(AC + t * 1024 + c0)); gr[q] = NT_LD((const u32x4*)(PROJ + t * NPROJ + 5120 + c0)); }
    bf16_t* ymr = (bf16_t*)(ws + WS_HN);
#pragma unroll
    for (int q = 0; q < 8; ++q) { const size_t t = (size_t)(r0 + (tid >> 4) + 32 * q);
        f32x4 ya = (f32x4){bflo(hl[q].x), bfhi(hl[q].x), bflo(hl[q].y), bfhi(hl[q].y)} + (f32x4){bflo(ac[q].x), bfhi(ac[q].x), bflo(ac[q].y), bfhi(ac[q].y)} * ca;
        f32x4 yb = (f32x4){bflo(hl[q].z), bfhi(hl[q].z), bflo(hl[q].w), bfhi(hl[q].w)} + (f32x4){bflo(ac[q].z), bfhi(ac[q].z), bflo(ac[q].w), bfhi(ac[q].w)} * cb;
        ya = ya * (f32x4){fgelu_tanh(bflo(gr[q].x)), fgelu_tanh(bfhi(gr[q].x)), fgelu_tanh(bflo(gr[q].y)), fgelu_tanh(bfhi(gr[q].y))};
        yb = yb * (f32x4){fgelu_tanh(bflo(gr[q].z)), fgelu_tanh(bfhi(gr[q].z)), fgelu_tanh(bflo(gr[q].w)), fgelu_tanh(bfhi(gr[q].w))};
        float ss = (ya.x * ya.x + ya.y * ya.y) + (ya.z * ya.z + ya.w * ya.w) + (yb.x * yb.x + yb.y * yb.y) + (yb.z * yb.z + yb.w * yb.w);
        ss += __shfl_xor(ss, 1); ss += __shfl_xor(ss, 2); ss += __shfl_xor(ss, 4); ss += __shfl_xor(ss, 8);
        const float rn = rsqrtf(ss * (1.f / 128.f) + EPS);
        ya = ya * rn * ga; yb = yb * rn * gb;
        *(u32x4*)(ymr + t * DM + 1024 + c0) = (u32x4){cvtpk(ya.x, ya.y), cvtpk(ya.z, ya.w), cvtpk(yb.x, yb.y), cvtpk(yb.z, yb.w)}; }
}

__device__ __forceinline__ void mixer_scan(const Args& a, int vcu, int G) {
    unsigned char* ws = a.ws; int tid_o = threadIdx.x; asm volatile("" : "+v"(tid_o)); const int tid = tid_o;
    const float* DT = (const float*)(ws + WS_DTOT);
    if (tid < 256) for (int g = vcu * 256 + tid; g < 65536; g += G * 256) {
        const int bh = g >> 13, i8 = g & 8191; bf16_t* base = (bf16_t*)(ws + WS_LST) + (size_t)bh * 32 * 65536 + (size_t)i8 * 8;
        f32x4 Sa = {0.f, 0.f, 0.f, 0.f}, Sb = {0.f, 0.f, 0.f, 0.f}; u32x4 Lr[31];
#pragma unroll
        for (int j = 0; j < 31; ++j) Lr[j] = NT_LD((const u32x4*)(base + (size_t)j * 65536));
#pragma unroll
        for (int j = 0; j < 31; ++j) { const float d = DT[bh * 32 + j]; const u32x4 L = Lr[j];
            Sa = d * Sa + (f32x4){bflo(L.x), bfhi(L.x), bflo(L.y), bfhi(L.y)}; Sb = d * Sb + (f32x4){bflo(L.z), bfhi(L.z), bflo(L.w), bfhi(L.w)};
            *(u32x4*)(base + (size_t)j * 65536) = (u32x4){cvtpk(Sa.x, Sa.y), cvtpk(Sa.z, Sa.w), cvtpk(Sb.x, Sb.y), cvtpk(Sb.z, Sb.w)}; }
    }
    if (tid >= 264 && tid < 266) for (int g = vcu * 2 + (tid - 264); g < 8 * 64; g += G * 2) {
        const int bh = g >> 6, i4 = g & 63; float* base = (float*)(ws + WS_LNS) + (size_t)bh * 32 * 256 + (size_t)i4 * 4;
        f32x4 S = {0.f, 0.f, 0.f, 0.f};
#pragma unroll 8
        for (int j = 0; j < 31; ++j) { const f32x4 L = *(const f32x4*)(base + (size_t)j * 256); S = DT[bh * 32 + j] * S + L; *(f32x4*)(base + (size_t)j * 256) = S; }
    }
    if (tid >= 256 && tid < 264) for (int g = vcu * 8 + (tid - 256); g < 2048; g += G * 8) {
        const int b = g >> 10, ch = g & 1023, n = ch >> 7, d = ch & 127; float hc = 0.f;
        const float* LA = (const float*)(ws + WS_LRUA); const float* LH = (const float*)(ws + WS_LRUH); float* LC = (float*)(ws + WS_LRUC);
#pragma unroll 8
        for (int j = 0; j < 32; ++j) { const size_t u = (size_t)((b * 32 + j) * 8 + n) * 128 + d; LC[(size_t)(b * 32 + j) * 1024 + ch] = hc; hc = LA[u] * hc + LH[u]; }
    }
}

__device__ __forceinline__ void p5_hn2_route(const Args& a, LAS unsigned char* lds, int vcu, int G) {
    int tid_o = threadIdx.x; asm volatile("" : "+v"(tid_o));
    const int tid = tid_o, lane = tid & 63, wave = __builtin_amdgcn_readfirstlane(tid >> 6), fr = lane & 15, kq = lane >> 4;
    unsigned char* ws = a.ws;
    LAS float* part = (LAS float*)lds;
    LAS float* rstds = (LAS float*)(lds + 49152);
    LAS float* lgs = (LAS float*)(lds + 49152 + 128);
    const float* mod = (const float*)(ws + WS_MOD); const float* cvec = (const float*)(ws + WS_CVEC);
    const bf16_t* WRH = (const bf16_t*)(ws + WS_WRH); const bf16_t* WRL = (const bf16_t*)(ws + WS_WRL);
    int* cnt = (int*)(ws + WS_CTL); int* list = (int*)(ws + WS_LIST); float* route = (float*)(ws + WS_ROUTE);
    for (int task = vcu; task < T / 32; task += G) {
        int lane_o = tid_o & 63; asm volatile("" : "+v"(lane_o));
        const int lane = lane_o, fr = lane & 15, kq = lane >> 4;
        const int row0 = task * 32, b = row0 / SEQ;
        const float* sh2 = mod + (size_t)b * 12288 + 6144; const float* sc2 = mod + (size_t)b * 12288 + 8192;
        __syncthreads();
        const bf16_t* X1 = (const bf16_t*)(ws + WS_X1B);
        f32x4 acc[2][3];
#pragma unroll
        for (int rt = 0; rt < 2; ++rt)
#pragma unroll
            for (int nt = 0; nt < 3; ++nt) acc[rt][nt] = (f32x4){0.f, 0.f, 0.f, 0.f};
        {
            u32x4 xb[8][2];
#pragma unroll
            for (int st = 0; st < 8; ++st)
#pragma unroll
                for (int rt = 0; rt < 2; ++rt) xb[st][rt] = *(const u32x4*)(X1 + (size_t)(row0 + 16 * rt + fr) * DM + 256 * wave + 32 * st + 8 * kq);
            bf16x8 Bhs[2][3], Bls[2][3]; f32x4 s0s[2], s1s[2];
#define RT_LOADB(set, stp) do { const int c0_ = 256 * wave + 32 * (stp) + 8 * kq; s0s[set] = *(const f32x4*)(sc2 + c0_); s1s[set] = *(const f32x4*)(sc2 + c0_ + 4); \
                _Pragma("unroll") for (int nt = 0; nt < 3; ++nt) { Bhs[set][nt] = *(const bf16x8*)(WRH + (size_t)(16 * nt + fr) * 2048 + c0_); Bls[set][nt] = *(const bf16x8*)(WRL + (size_t)(16 * nt + fr) * 2048 + c0_); } } while (0)
            RT_LOADB(0, 0);
#pragma unroll
            for (int st = 0; st < 8; ++st) {
                __builtin_amdgcn_sched_barrier(0);
                if (st < 7) RT_LOADB((st + 1) & 1, st + 1);
                const f32x4 s0 = s0s[st & 1] + 1.f, s1 = s1s[st & 1] + 1.f;
                bf16x8 Ah[2], Al[2];
#pragma unroll
                for (int rt = 0; rt < 2; ++rt) {
                    const u32x4 r4 = xb[st][rt];
                    const f32x4 x0 = (f32x4){bflo(r4.x), bfhi(r4.x), bflo(r4.y), bfhi(r4.y)} * s0, x1 = (f32x4){bflo(r4.z), bfhi(r4.z), bflo(r4.w), bfhi(r4.w)} * s1;
                    u32x4 h; h.x = cvtpk(x0.x, x0.y); h.y = cvtpk(x0.z, x0.w); h.z = cvtpk(x1.x, x1.y); h.w = cvtpk(x1.z, x1.w);
                    u32x4 l; l.x = cvtpk(x0.x - bflo(h.x), x0.y - bfhi(h.x)); l.y = cvtpk(x0.z - bflo(h.y), x0.w - bfhi(h.y)); l.z = cvtpk(x1.x - bflo(h.z), x1.y - bfhi(h.z)); l.w = cvtpk(x1.z - bflo(h.w), x1.w - bfhi(h.w));
                    Ah[rt] = __builtin_bit_cast(bf16x8, h); Al[rt] = __builtin_bit_cast(bf16x8, l);
                }
#pragma unroll
                for (int nt = 0; nt < 3; ++nt) {
                    const bf16x8 Bh = Bhs[st & 1][nt], Bl = Bls[st & 1][nt];
#pragma unroll
                    for (int rt = 0; rt < 2; ++rt) {
                        acc[rt][nt] = __builtin_amdgcn_mfma_f32_16x16x32_bf16(Ah[rt], Bh, acc[rt][nt], 0, 0, 0);
                        acc[rt][nt] = __builtin_amdgcn_mfma_f32_16x16x32_bf16(Al[rt], Bh, acc[rt][nt], 0, 0, 0);
                        acc[rt][nt] = __builtin_amdgcn_mfma_f32_16x16x32_bf16(Ah[rt], Bl, acc[rt][nt], 0, 0, 0);
                    }
                }
            }
        }
#undef RT_LOADB
        __builtin_amdgcn_sched_barrier(0);
        {
            u32x4 v[4][4]; float rs[4];
#pragma unroll
            for (int r = 0; r < 4; ++r)
#pragma unroll
                for (int jj = 0; jj < 4; ++jj) v[r][jj] = NT_LD((const u32x4*)(X1 + (size_t)(row0 + wave * 4 + r) * DM + 8 * lane + 512 * jj));
#pragma unroll
            for (int r = 0; r < 4; ++r) { float ssum = 0.f;
#pragma unroll
                for (int jj = 0; jj < 4; ++jj) { const u32x4 q = v[r][jj]; const float a0 = bflo(q.x), a1 = bfhi(q.x), a2 = bflo(q.y), a3 = bfhi(q.y), a4 = bflo(q.z), a5 = bfhi(q.z), a6 = bflo(q.w), a7 = bfhi(q.w);
                    ssum += ((a0 * a0 + a1 * a1) + (a2 * a2 + a3 * a3)) + ((a4 * a4 + a5 * a5) + (a6 * a6 + a7 * a7)); }
                rs[r] = rsqrtf(wave_sum(ssum) * (1.f / DM) + EPS); if (lane == 0) rstds[wave * 4 + r] = rs[r]; }
#pragma unroll
            for (int jj = 0; jj < 4; ++jj) { __builtin_amdgcn_sched_barrier(0);
                const f32x4 sha = *(const f32x4*)(sh2 + 8 * lane + 512 * jj), shb = *(const f32x4*)(sh2 + 8 * lane + 512 * jj + 4);
                const f32x4 sca = *(const f32x4*)(sc2 + 8 * lane + 512 * jj) + 1.f, scb = *(const f32x4*)(sc2 + 8 * lane + 512 * jj + 4) + 1.f;
#pragma unroll
                for (int r = 0; r < 4; ++r) { const u32x4 q = v[r][jj];
                    const f32x4 ha = (f32x4){bflo(q.x), bfhi(q.x), bflo(q.y), bfhi(q.y)} * rs[r] * sca + sha, hb = (f32x4){bflo(q.z), bfhi(q.z), bflo(q.w), bfhi(q.w)} * rs[r] * scb + shb;
                    *(u32x4*)((bf16_t*)(ws + WS_HN) + (size_t)(row0 + wave * 4 + r) * DM + 8 * lane + 512 * jj) = (u32x4){cvtpk(ha.x, ha.y), cvtpk(ha.z, ha.w), cvtpk(hb.x, hb.y), cvtpk(hb.z, hb.w)}; } }
        }
#pragma unroll
        for (int rt = 0; rt < 2; ++rt)
#pragma unroll
            for (int nt = 0; nt < 3; ++nt)
#pragma unroll
                for (int r = 0; r < 4; ++r) part[(wave * 32 + 16 * rt + 4 * kq + r) * 48 + 16 * nt + fr] = acc[rt][nt][r];
        __syncthreads();
        for (int idx = tid; idx < 32 * 36; idx += 512) { const int r = idx / 36, n = idx % 36; float q = 0.f;
#pragma unroll
            for (int w = 0; w < 8; ++w) q += part[(w * 32 + r) * 48 + n];
            lgs[r * 40 + n] = rstds[r] * q + cvec[b * 48 + n]; }
        __syncthreads();
        if (tid < 32) {
            const int t = row0 + tid; const LAS float* lg = lgs + tid * 40;
            int g = 0; float mx = lg[0];
#pragma unroll
            for (int i = 1; i < 4; ++i) { const float x = lg[i]; if (x > mx) { mx = x; g = i; } }
            float sg = 0.f;
#pragma unroll
            for (int i = 0; i < 4; ++i) sg += __expf(lg[i] - mx);
            const float pg = 1.f / sg;
            int e0 = 0; float m0 = lg[4 + g * 8];
            for (int i = 1; i < 8; ++i) { const float x = lg[4 + g * 8 + i]; if (x > m0) { m0 = x; e0 = i; } }
            int e1 = -1; float m1 = -INFINITY;
            for (int i = 0; i < 8; ++i) { const float x = lg[4 + g * 8 + i]; if (i != e0 && x > m1) { m1 = x; e1 = i; } }
            const float x1 = __expf(m1 - m0); const float w0 = pg / (1.f + x1), w1 = pg * x1 / (1.f + x1);
            const int E0 = g * 8 + e0, E1 = g * 8 + e1;
            *(f32x4*)(route + (size_t)t * 4) = (f32x4){w0, w1, (float)E0, (float)E1};
            LAS int* lcnt = (LAS int*)(lds + 49152 + 128 + 5120); LAS int* lbase = lcnt + 32;
            lcnt[tid] = 0;
            LDS_WAIT(); asm volatile("" ::: "memory");
            const int rk0 = __hip_atomic_fetch_add(lcnt + E0, 1, __ATOMIC_RELAXED, __HIP_MEMORY_SCOPE_WORKGROUP);
            const int rk1 = __hip_atomic_fetch_add(lcnt + E1, 1, __ATOMIC_RELAXED, __HIP_MEMORY_SCOPE_WORKGROUP);
            LDS_WAIT(); asm volatile("" ::: "memory");
            const int lc = lcnt[tid];
            lbase[tid] = lc ? atomicAdd(&cnt[tid], lc) : 0;
            LDS_WAIT(); asm volatile("" ::: "memory");
            float* listw = (float*)(ws + WS_LISTW);
            { const size_t p0 = (size_t)E0 * T + lbase[E0] + rk0, p1 = (size_t)E1 * T + lbase[E1] + rk1;
              list[p0] = t * 2; listw[p0] = w0; list[p1] = t * 2 + 1; listw[p1] = w1; }
        }
    }
}

__device__ __forceinline__ void p9_final(const Args& a, int vcu, int G, float* dstbase) {
    int tid_o = threadIdx.x; asm volatile("" : "+v"(tid_o));
    const int tid = tid_o, lane = tid & 63, wave = __builtin_amdgcn_readfirstlane(tid >> 6);
    unsigned char* ws = a.ws; const float* mod = (const float*)(ws + WS_MOD); const bf16_t* YS = (const bf16_t*)(ws + WS_YS);
    const bf16_t* X1 = (const bf16_t*)(ws + WS_X1B);
    for (int rp = vcu * 8 + wave; rp < T / 2; rp += G * 8) {
        const int b = (2 * rp) / SEQ; const float* g2 = mod + (size_t)b * 12288 + 10240;
        u32x4 xr[2][4], y0[2][4], y1[2][4];
#pragma unroll
        for (int q = 0; q < 2; ++q)
#pragma unroll
            for (int jj = 0; jj < 4; ++jj) { const int row = 2 * rp + q; xr[q][jj] = NT_LD((const u32x4*)(X1 + (size_t)row * DM + 8 * lane + 512 * jj)); y0[q][jj] = NT_LD((const u32x4*)(YS + (size_t)(2 * row) * DM + 8 * lane + 512 * jj)); y1[q][jj] = NT_LD((const u32x4*)(YS + (size_t)(2 * row + 1) * DM + 8 * lane + 512 * jj)); }
#pragma unroll
        for (int q = 0; q < 2; ++q) {
            const int row = 2 * rp + q; f32x4 v[4][2]; float s = 0.f;
#pragma unroll
            for (int jj = 0; jj < 4; ++jj) { const f32x4 ga = *(const f32x4*)(g2 + 8 * lane + 512 * jj), gb = *(const f32x4*)(g2 + 8 * lane + 512 * jj + 4);
                const u32x4 x = xr[q][jj], p0 = y0[q][jj], p1 = y1[q][jj];
                v[jj][0] = (f32x4){bflo(x.x), bfhi(x.x), bflo(x.y), bfhi(x.y)} + ga * (f32x4){bflo(p0.x) + bflo(p1.x), bfhi(p0.x) + bfhi(p1.x), bflo(p0.y) + bflo(p1.y), bfhi(p0.y) + bfhi(p1.y)};
                v[jj][1] = (f32x4){bflo(x.z), bfhi(x.z), bflo(x.w), bfhi(x.w)} + gb * (f32x4){bflo(p0.z) + bflo(p1.z), bfhi(p0.z) + bfhi(p1.z), bflo(p0.w) + bflo(p1.w), bfhi(p0.w) + bfhi(p1.w)};
#pragma unroll
                for (int z = 0; z < 2; ++z) s += (v[jj][z].x * v[jj][z].x + v[jj][z].y * v[jj][z].y) + (v[jj][z].z * v[jj][z].z + v[jj][z].w * v[jj][z].w); }
            const float rstd = rsqrtf(wave_sum(s) * (1.f / DM) + EPS);
#pragma unroll
            for (int jj = 0; jj < 4; ++jj) { const f32x4 fa = *(const f32x4*)(a.in[I_FG] + 8 * lane + 512 * jj), fb = *(const f32x4*)(a.in[I_FG] + 8 * lane + 512 * jj + 4);
                float* dr = dstbase + (size_t)row * DM + 8 * lane + 512 * jj; NT_ST(v[jj][0] * rstd * fa, (f32x4*)dr); NT_ST(v[jj][1] * rstd * fb, (f32x4*)(dr + 4)); }
        }
    }
}
}
namespace fk {
#define XB_TMO      128
#define XB_XCNT(j)  (256  + 64 * (j))
#define XB_XSUB(j)  (1280 + 64 * (j))
#define XB_XGEN(j)  (2304 + 64 * (j))
#define XB_TOP      3328
#define XB_TOPGEN   3392
#define XCD_BAR_WORDS 3456
#define XB_SPIN_CAP (1u << 18)

__device__ __forceinline__ unsigned xb_ld(unsigned* p)              { return __hip_atomic_load(p, __ATOMIC_RELAXED, __HIP_MEMORY_SCOPE_AGENT); }
__device__ __forceinline__ unsigned xb_add(unsigned* p, unsigned v) { return __hip_atomic_fetch_add(p, v, __ATOMIC_RELAXED, __HIP_MEMORY_SCOPE_AGENT); }
__device__ __forceinline__ unsigned xb_xcc_id() { return (unsigned)__builtin_amdgcn_s_getreg((3 << 11) | 20) & 0xFu; }
#define XB_SPIN(cond, bar) do { unsigned _sp = 0; while (cond) { __builtin_amdgcn_s_sleep(1); \
    if ((++_sp & 255u) == 0u) { if (xb_ld(&(bar)[XB_TMO])) break; if (_sp > XB_SPIN_CAP) { atomicAdd(&(bar)[XB_TMO], 1u); break; } } } } while (0)

struct XcdBarrier {
    unsigned* bar; unsigned x;
    volatile LAS unsigned* st;
};

__device__ __forceinline__ XcdBarrier xcd_barrier_post(unsigned* bar, volatile LAS unsigned* st) {
    XcdBarrier b; b.bar = bar; b.x = xb_xcc_id(); b.st = st;
    if (threadIdx.x == 0) (void)xb_add(&bar[XB_XCNT(b.x)], 1u);
    return b;
}
__device__ __forceinline__ void xcd_barrier_complete(unsigned* bar, unsigned x, unsigned& nloc, unsigned& nx) {
    const unsigned G = gridDim.x * gridDim.y * gridDim.z;
    unsigned sum, cnt, mine, sp = 0u;
    for (;;) {
        sum = 0u; cnt = 0u; mine = 0u;
#pragma unroll
        for (unsigned j = 0; j < 16; ++j) { const unsigned c = xb_ld(&bar[XB_XCNT(j)]); sum += c; cnt += (c > 0u) ? 1u : 0u; mine = (j == x) ? c : mine; }
        if (sum == G) break;
        __builtin_amdgcn_s_sleep(1);
        if ((++sp & 255u) == 0u) { if (xb_ld(&bar[XB_TMO])) break; if (sp > XB_SPIN_CAP) { atomicAdd(&bar[XB_TMO], 1u); break; } }
    }
    nloc = mine > 0u ? mine : 1u; nx = cnt > 0u ? cnt : 1u;
}

__device__ __forceinline__ void xcd_barrier(const XcdBarrier& b) {
    asm volatile("s_waitcnt vmcnt(0)" ::: "memory");
    __syncthreads();
    if (threadIdx.x == 0) {
        unsigned* bar = b.bar;
        __builtin_amdgcn_s_waitcnt(0);
        unsigned nloc = b.st[0], nx = b.st[1];
        if (nloc == 0u) { xcd_barrier_complete(bar, b.x, nloc, nx); b.st[0] = nloc; b.st[1] = nx; }
        const unsigned old = xb_add(&bar[XB_XSUB(b.x)], 1u);
        const unsigned gen = old / nloc;
        if (old + 1u == (gen + 1u) * nloc) {
            __builtin_amdgcn_fence(__ATOMIC_RELEASE, "agent");
            asm volatile("s_waitcnt vmcnt(0)" ::: "memory");
            const unsigned og = xb_add(&bar[XB_TOP], 1u);
            const unsigned tg = og / nx;
            if (og + 1u == (tg + 1u) * nx) xb_add(&bar[XB_TOPGEN], 1u);
            else XB_SPIN(xb_ld(&bar[XB_TOPGEN]) == tg, bar);
            __builtin_amdgcn_fence(__ATOMIC_ACQUIRE, "agent");
            xb_add(&bar[XB_XGEN(b.x)], 1u);
            asm volatile("s_waitcnt vmcnt(0)" ::: "memory");
        } else {
            XB_SPIN(xb_ld(&bar[XB_XGEN(b.x)]) == gen, bar);
            __builtin_amdgcn_fence(__ATOMIC_ACQUIRE, "agent");
            asm volatile("s_waitcnt vmcnt(0)" ::: "memory");
        }
    }
    __syncthreads();
}
}
namespace fk {
constexpr int NPHASE = 11;
#ifndef NCONV
#define NCONV 36
#endif
__global__ void __launch_bounds__(512, 2) fwd(Args a) {
    extern __shared__ __attribute__((aligned(16))) unsigned char lds_raw[];
    LAS unsigned char* lds = (LAS unsigned char*)lds_raw;
    const int G = gridDim.x, bx = blockIdx.x, tid = threadIdx.x;
    const int vcu = (G % 8 == 0) ? (bx % 8) * (G / 8) + bx / 8 : bx;
    const int lo = a.ph_lo, hi = a.ph_hi;
    unsigned char* ws = a.ws;
    volatile LAS unsigned* bst = (volatile LAS unsigned*)(lds + L_CTL + 512);
    if (tid < 2) bst[tid] = 0u;
    __syncthreads();
    XcdBarrier bar; bar.bar = (unsigned*)(ws + WS_BAR); bar.x = 0; bar.st = bst;
    if (hi - lo > 1) bar = xcd_barrier_post((unsigned*)(ws + WS_BAR), bst);
#ifndef PH_ONLY
#define PH_ONLY -1
#endif
#define IN(k) ((PH_ONLY < 0 || PH_ONLY == (k)) && lo <= (k) && (k) < hi)
#define GSYNC() xcd_barrier(bar)
#define SYNC(k) do { if (IN(k) && IN((k) + 1)) GSYNC(); } while (0)
#ifndef REP_PHASE
#define REP_PHASE -1
#endif
#ifndef REP_SKIPL
#define REP_SKIPL 0
#endif
#define REP(k) _Pragma("unroll 1") for (int rep_ = 0; rep_ < ((REP_PHASE == (k)) ? 2 : 1); ++rep_)
#define RSYNC() do { if (rep_) GSYNC(); } while (0)
    const int nconv = (G == 256 && IN(0) && IN(2)) ? NCONV : 0;
    REP(0) { RSYNC(); if (IN(0)) { p0_prologue(a, lds, vcu, G, nconv); } } SYNC(0);
    REP(1) { RSYNC(); if (IN(1)) { p1_hn_gates(a, lds, vcu, G); } } SYNC(1);
    REP(2) { RSYNC(); if (IN(2)) {
        if (bx < G - nconv) { DenseSched S; S.init(ws + WS_HN, ws + WS_WIN, T, NPROJ, DM, G - nconv, bx); EpiProj E{(bf16_t*)(ws + WS_PROJ), NPROJ}; pg8::gemm_phase<EpiProj, DenseSched>(lds, DM, S, E); }
        else if (!rep_) { p2_convert(a, lds, (bx - (G - nconv)) * 8 + (tid >> 6), nconv * 8);
#ifdef CONV_DUP
            p2_convert(a, lds, (bx - (G - nconv)) * 8 + (tid >> 6), nconv * 8);
#endif
        }
    } } SYNC(2);
    REP(34) { RSYNC(); REP(3) { RSYNC(); if (IN(3)) {
#ifndef NO_MLSTM
                 for (int u = vcu; u < 256; u += G) mlstm_unit<false>(a, lds, u >> 5, u & 31);
#endif
#ifndef NO_LRU
                 if (!(REP_SKIPL && rep_)) for (int u = vcu, pn_ = -1; u < 512; u += G) { lru_unit(a, lds, u >> 8, (u >> 3) & 31, u & 7, (u & 7) != pn_); pn_ = u & 7; }
#endif
    } } SYNC(3);
    if (IN(4)) { mixer_scan(a, vcu, G); } } SYNC(4);
    REP(5) { RSYNC(); if (IN(5)) {
                 if (vcu & 1) { for (int u = vcu; u < 512; u += G) lru_out_unit(a, u >> 8, (u >> 3) & 31, u & 7); }
                 for (int u = vcu; u < 256; u += G) mlstm_unit<true>(a, lds, u >> 5, u & 31);
                 if (!(vcu & 1)) { for (int u = vcu; u < 512; u += G) lru_out_unit(a, u >> 8, (u >> 3) & 31, u & 7); }
    } } SYNC(5);
    REP(6) { RSYNC(); if (IN(6)) { __syncthreads(); DenseSched S; S.init(ws + WS_HN, ws + WS_WOUT, T, DM, DM, G, bx); EpiX1 E{a.in[I_X], (const float*)(ws + WS_MOD), (bf16_t*)(ws + WS_X1B)}; pg8::gemm_phase<EpiX1, DenseSched>(lds, DM, S, E); } } SYNC(6);
    REP(7) { if (rep_) { GSYNC(); if (bx == 0 && tid < 32) ((int*)(ws + WS_CTL))[tid] = 0; GSYNC(); }
        if (IN(7)) { p5_hn2_route(a, lds, vcu, G); } } SYNC(7);
    if (IN(8) || IN(9)) {
        LAS int* tp = (LAS int*)(lds + L_CTL); const int* cnt = (const int*)(ws + WS_CTL);
        __syncthreads();
        if (tid == 0) { int s = 0; for (int e = 0; e < 32; ++e) { tp[e] = s; s += (cnt[e] + 255) >> 8; } tp[32] = s; }
        __syncthreads();
        if (tid < 192) { int e = 0; for (int q = 1; q < 32; ++q) e += (tp[q] <= tid) ? 1 : 0; ((LAS unsigned short*)(tp + 160))[tid] = (unsigned short)e; }
        __syncthreads();
    }
    if (IN(8)) { const LAS int* tp = (const LAS int*)(lds + L_CTL); const int nGU = tp[32] * 4, R = nGU / G, rem = nGU - R * G, Ne = G - rem;
        { MoeSched<4, true> S{tp, (const int*)(ws + WS_CTL), (const int*)(ws + WS_LIST), (const char*)(ws + WS_HN), (const char*)(ws + WS_WGU), DM, vcu, G, R * G};
          EpiGateUp E{(bf16_t*)(ws + WS_HEXP)}; pg8::gemm_phase<EpiGateUp, MoeSched<4, true>>(lds, DM, S, E); }
        if (rem > 0) {
            GSYNC();
            if (vcu < rem) { MoeSched<4, true> S{tp, (const int*)(ws + WS_CTL), (const int*)(ws + WS_LIST), (const char*)(ws + WS_HN), (const char*)(ws + WS_WGU), DM, R * G + vcu, G, nGU};
                EpiGateUp E{(bf16_t*)(ws + WS_HEXP)}; pg8::gemm_phase<EpiGateUp, MoeSched<4, true>>(lds, DM, S, E); }
            else if (R >= 1) { MoeSched<8, false> S{tp, (const int*)(ws + WS_CTL), (const int*)(ws + WS_LIST), (const char*)(ws + WS_HEXP), (const char*)(ws + WS_WDN), 512, vcu - rem, Ne, 2 * Ne};
                EpiDown E{(bf16_t*)(ws + WS_YS), (const int*)(ws + WS_CTL), (const int*)(ws + WS_LIST), (const float*)(ws + WS_LISTW)}; pg8::gemm_phase<EpiDown, MoeSched<8, false>>(lds, 512, S, E); }
        }
    } SYNC(8);
    if (IN(9)) { const LAS int* tp = (const LAS int*)(lds + L_CTL); const int nGU = tp[32] * 4, R = nGU / G, rem = nGU - R * G, Ne = G - rem;
        MoeSched<8, false> S{tp, (const int*)(ws + WS_CTL), (const int*)(ws + WS_LIST), (const char*)(ws + WS_HEXP), (const char*)(ws + WS_WDN), 512, ((rem > 0 && R >= 1) ? 2 * Ne : 0) + vcu, G, tp[32] * 8};
        EpiDown E{(bf16_t*)(ws + WS_YS), (const int*)(ws + WS_CTL), (const int*)(ws + WS_LIST), (const float*)(ws + WS_LISTW)}; pg8::gemm_phase<EpiDown, MoeSched<8, false>>(lds, 512, S, E); } SYNC(9);
#if REP_PHASE == 10
    if (IN(10)) { p9_final(a, vcu, G, (float*)(ws + WS_WGU)); GSYNC(); }
#endif
#if REP_PHASE == 99
    for (int q = 0; q < 20; ++q) GSYNC();
#endif
    if (IN(10)) { p9_final(a, vcu, G, a.out); }
#undef IN
#undef SYNC
}

static int g_grid = 0;
static bool setup() {
    if (g_grid) return g_grid > 0;
    int dev = 0, cus = 0, per_cu = 0;
    if (hipGetDevice(&dev) != hipSuccess || hipDeviceGetAttribute(&cus, hipDeviceAttributeMultiprocessorCount, dev) != hipSuccess) { g_grid = -1; return false; }
    if (hipFuncSetAttribute((const void*)fwd, hipFuncAttributeMaxDynamicSharedMemorySize, LDS_BYTES) != hipSuccess) { fprintf(stderr, "hipFuncSetAttribute failed\n"); g_grid = -1; return false; }
    if (hipOccupancyMaxActiveBlocksPerMultiprocessor(&per_cu, (const void*)fwd, 512, LDS_BYTES) != hipSuccess || per_cu < 1) { fprintf(stderr, "occupancy query: %d\n", per_cu); (void)hipGetLastError(); g_grid = -1; return false; }
    g_grid = cus;
    return true;
}
static void run(void* const* d_in, float* out, unsigned char* ws, hipStream_t st, int lo, int hi, bool coop) {
    if (!setup()) return;
    (void)hipMemsetAsync(ws + WS_CTL, 0, CTL_ZERO_BYTES, st);
    Args a{};
    for (int i = 0; i < 25; ++i) a.in[i] = (const float*)d_in[i];
    a.out = out; a.ws = ws;
    if (coop) { a.ph_lo = lo; a.ph_hi = hi;
        hipLaunchKernelGGL(fwd, dim3(g_grid), dim3(512), LDS_BYTES, st, a);
    } else {
        for (int p = lo; p < hi; ++p) { a.ph_lo = p; a.ph_hi = p + 1; hipLaunchKernelGGL(fwd, dim3(g_grid), dim3(512), LDS_BYTES, st, a); }
    }
}
}
#ifndef DBG_STAGE
#define DBG_STAGE 0
#endif
#ifndef N_LAUNCHES
#define N_LAUNCHES 1
#endif
#if DBG_STAGE
namespace dbg {
template <typename TIn> __global__ void k_sample(const TIn* src, int ld, int col0, int ncols, int stride, float* dst) {
    const int i = blockIdx.x; const size_t row = (size_t)i * stride;
    for (int c = threadIdx.x; c < ncols; c += blockDim.x) { float v; if (sizeof(TIn) == 2) v = __builtin_bit_cast(float, (unsigned)(*(const unsigned short*)&src[row * ld + col0 + c]) << 16); else v = (float)(*(const float*)&src[row * ld + col0 + c]); dst[(size_t)i * ncols + c] = v; }
}
__global__ void k_cmp(const float* smp, int sld, int scol0, int n, int stride, const float* ref, int ldr, int rcol0, const float* rowscale, float* acc) {
    __shared__ float r0[256], r1[256];
    const int i = blockIdx.x; const size_t row = (size_t)i * stride; const float sc = rowscale ? rowscale[row] : 1.f;
    float d2 = 0.f, f2 = 0.f;
    for (int c = threadIdx.x; c < n; c += blockDim.x) { const float r = ref[row * ldr + rcol0 + c] * sc, s = smp[(size_t)i * sld + scol0 + c]; const float d = s - r; d2 += d * d; f2 += r * r; }
    r0[threadIdx.x] = d2; r1[threadIdx.x] = f2; __syncthreads();
    for (int o = 128; o > 0; o >>= 1) { if (threadIdx.x < o) { r0[threadIdx.x] += r0[threadIdx.x + o]; r1[threadIdx.x] += r1[threadIdx.x + o]; } __syncthreads(); }
    if (threadIdx.x == 0) { atomicAdd(&acc[0], r0[0]); atomicAdd(&acc[1], r1[0]); }
}
__global__ void k_scale(float* out, const float* acc, int nchk, int raw, float tol) {
    float delta = 0.f;
    if (raw >= 0) { const float e = sqrtf(acc[2 * raw] / fmaxf(acc[2 * raw + 1], 1e-30f)); delta = 4.f * fminf(e, 2.f); if (!(e == e)) delta = 9.f; }
    else for (int i = 0; i < nchk; ++i) { const float e = sqrtf(acc[2 * i] / fmaxf(acc[2 * i + 1], 1e-30f)); if (!(e <= tol)) { delta = 0.1f * (i + 1) + 0.05f * ((e == e) ? fminf(e, 1.f) : 1.f); break; } }
    const size_t idx = (size_t)blockIdx.x * blockDim.x + threadIdx.x;
    out[idx] *= (1.f + delta);
}
struct Ctx { unsigned char* ws; float* out; float* smp; float* acc; };
#ifndef DBG_RAW
#define DBG_RAW -1
#endif
#ifndef DBG_TOL
#define DBG_TOL 0.02f
#endif
constexpr size_t SM0 = 0, SM1 = 2 * 1024 * 1024 + 65536;
static void hook(int stage, void* vctx, hipStream_t st) {
    Ctx& c = *(Ctx*)vctx; unsigned char* ws = c.ws;
    const float* bufA = (const float*)(ws + nv::W_A); const float* proj = (const float*)(ws + nv::W_B); const float* ymr = (const float*)(ws + nv::W_C);
#if DBG_STAGE == 3
    if (stage == 2) k_cmp<<<964, 256, 0, st>>>(c.smp + SM0, 2048, 0, 2048, 17, bufA, 2048, 0, nullptr, c.acc + 0);
    if (stage == 3) { k_cmp<<<529, 256, 0, st>>>(c.smp + SM1, 6144, 0, 4096, 31, proj, nv::INW, 0, nullptr, c.acc + 2);
                      k_cmp<<<529, 256, 0, st>>>(c.smp + SM1, 6144, 4096, 2048, 31, proj, nv::INW, 4104, nullptr, c.acc + 4); }
#elif DBG_STAGE == 6
    if (stage == 6) { k_cmp<<<964, 256, 0, st>>>(c.smp + SM0, 2048, 0, 1024, 17, ymr, 2048, 0, nullptr, c.acc + 0);
                      k_cmp<<<964, 256, 0, st>>>(c.smp + SM0, 2048, 1024, 1024, 17, ymr, 2048, 1024, nullptr, c.acc + 2); }
#elif DBG_STAGE == 7
    if (stage == 7) k_cmp<<<964, 256, 0, st>>>(c.smp + SM0, 2048, 0, 2048, 17, c.out, 2048, 0, nullptr, c.acc + 0);
#elif DBG_STAGE == 8
    if (stage == 8) k_cmp<<<964, 256, 0, st>>>(c.smp + SM0, 2048, 0, 2048, 17, bufA, 2048, 0, nullptr, c.acc + 0);
    if (stage == 9) { k_cmp<<<964, 256, 0, st>>>(c.smp + SM1, 4, 0, 2, 17, (const float*)(ws + nv::W_R4), 4, 0, nullptr, c.acc + 2);
                      k_cmp<<<964, 256, 0, st>>>(c.smp + SM1, 4, 2, 2, 17, (const float*)(ws + nv::W_R4), 4, 2, nullptr, c.acc + 4); }
#elif DBG_STAGE == 10
    if (stage == 10) k_cmp<<<1928, 256, 0, st>>>(c.smp + SM0, 2048, 0, 2048, 17, proj + (size_t)4 * nv::T_ * 512, 2048, 0, (const float*)(ws + nv::W_GW), c.acc + 0);
#endif
}
}
#endif

extern "C" void kernel_launch(void* const* d_in, const int* in_sizes, int n_in, void* d_out, int out_size, void* d_ws, size_t ws_size, hipStream_t stream) {
    if (n_in != 25 || ws_size < fk::WS_END) { fprintf(stderr, "kernel_launch: unexpected n_in %d / ws_size %zu\n", n_in, ws_size); return; }
    unsigned char* ws = (unsigned char*)d_ws; float* out = (float*)d_out;
#if DBG_STAGE == 0
    fk::run(d_in, out, ws, stream, 0, fk::NPHASE, N_LAUNCHES == 1);
#else
    if (ws_size < nv::W_END + 24 * nv::MiB_) { fprintf(stderr, "debug build: ws too small\n"); return; }
    float* smp = (float*)(ws + ws_size - 24 * nv::MiB_); float* acc = smp + 6 * 1024 * 1024 - 64;
    (void)hipMemsetAsync(acc, 0, 256, stream);
#if DBG_STAGE == 3
    fk::run(d_in, out, ws, stream, 0, 3, N_LAUNCHES == 1);
    dbg::k_sample<unsigned short><<<964, 256, 0, stream>>>((const unsigned short*)(ws + fk::WS_HN), 2048, 0, 2048, 17, smp + dbg::SM0);
    dbg::k_sample<unsigned short><<<529, 256, 0, stream>>>((const unsigned short*)(ws + fk::WS_PROJ), 6144, 0, 6144, 31, smp + dbg::SM1);
    const int nchk = 3;
#elif DBG_STAGE == 6
    fk::run(d_in, out, ws, stream, 0, 6, N_LAUNCHES == 1);
    dbg::k_sample<unsigned short><<<964, 256, 0, stream>>>((const unsigned short*)(ws + fk::WS_HN), 2048, 0, 2048, 17, smp + dbg::SM0);
    const int nchk = 2;
#elif DBG_STAGE == 7
    fk::run(d_in, out, ws, stream, 0, 7, N_LAUNCHES == 1);
    dbg::k_sample<float><<<964, 256, 0, stream>>>(out, 2048, 0, 2048, 17, smp + dbg::SM0);
    const int nchk = 1;
#elif DBG_STAGE == 8
    fk::run(d_in, out, ws, stream, 0, 8, N_LAUNCHES == 1);
    dbg::k_sample<unsigned short><<<964, 256, 0, stream>>>((const unsigned short*)(ws + fk::WS_HN), 2048, 0, 2048, 17, smp + dbg::SM0);
    dbg::k_sample<float><<<964, 256, 0, stream>>>((const float*)(ws + fk::WS_ROUTE), 4, 0, 4, 17, smp + dbg::SM1);
    const int nchk = 3;
#elif DBG_STAGE == 10
    fk::run(d_in, out, ws, stream, 0, 10, N_LAUNCHES == 1);
    dbg::k_sample<unsigned short><<<1928, 256, 0, stream>>>((const unsigned short*)(ws + fk::WS_YS), 2048, 0, 2048, 17, smp + dbg::SM0);
    const int nchk = 1;
#endif
    nv::In I; { const float** p = (const float**)&I; for (int i = 0; i < 25; ++i) p[i] = (const float*)d_in[i]; }
    dbg::Ctx ctx{ws, out, smp, acc};
    nv::run(I, out, ws, stream, dbg::hook, &ctx);
    dbg::k_scale<<<(fk::T * fk::DM) / 256, 256, 0, stream>>>(out, acc, nchk, DBG_RAW, DBG_TOL);
#endif
}
```

```cpp
#define DBG_STAGE 0
#define N_LAUNCHES 1
#define DBG_RAW -1
#include <hip/hip_runtime.h>
#include <hip/hip_cooperative_groups.h>
#include <cstdio>
#include <cstdint>
#include <cmath>
#define LAS __attribute__((address_space(3)))
#define GAS __attribute__((address_space(1)))
typedef unsigned short bf16_t;
typedef short bf16x8 __attribute__((ext_vector_type(8)));
typedef float f32x4 __attribute__((ext_vector_type(4)));
typedef float f32x2 __attribute__((ext_vector_type(2)));
typedef float f32x16 __attribute__((ext_vector_type(16)));
typedef unsigned u32x4 __attribute__((ext_vector_type(4)));
typedef unsigned u32x2 __attribute__((ext_vector_type(2)));

__device__ __forceinline__ unsigned f2bf(float f) { unsigned u = __builtin_bit_cast(unsigned, f); return (u + 0x7fffu + ((u >> 16) & 1u)) >> 16; }
__device__ __forceinline__ unsigned pk2(float lo, float hi) { return f2bf(lo) | (f2bf(hi) << 16); }
__device__ __forceinline__ float bflo(unsigned u) { return __builtin_bit_cast(float, u << 16); }
__device__ __forceinline__ float bfhi(unsigned u) { return __builtin_bit_cast(float, u & 0xffff0000u); }
__device__ __forceinline__ float bf1(bf16_t b) { return __builtin_bit_cast(float, (unsigned)b << 16); }
__device__ __forceinline__ float wave_sum(float v) {
#pragma unroll
    for (int o = 1; o < 64; o <<= 1) v += __shfl_xor(v, o);
    return v;
}
__device__ __forceinline__ float frcp(float x) { return __builtin_amdgcn_rcpf(x); }
__device__ __forceinline__ float fsigmoid(float x) { return frcp(1.f + __expf(-x)); }
__device__ __forceinline__ float fsilu(float x) { return x * frcp(1.f + __expf(-x)); }
__device__ __forceinline__ float flogsigmoid(float x) { return fminf(x, 0.f) - log1pf(expf(-fabsf(x))); }
__device__ __forceinline__ float fgelu_tanh(float x) { const float u = 0.7978845608028654f * (x + 0.044715f * x * x * x); const float e = __expf(2.f * u); const float th = 1.f - 2.f * frcp(e + 1.f); return 0.5f * x * (1.f + th); }
template <int CTRL, int ROW_MASK> __device__ __forceinline__ float dpp_add(float x) { const int v = __builtin_amdgcn_update_dpp(0, __builtin_bit_cast(int, x), CTRL, ROW_MASK, 0xf, true); return x + __builtin_bit_cast(float, v); }
__device__ __forceinline__ float half_sum31(float x) {
    x = dpp_add<0x111, 0xf>(x);
    x = dpp_add<0x112, 0xf>(x);
    x = dpp_add<0x114, 0xf>(x);
    x = dpp_add<0x118, 0xf>(x);
    x = dpp_add<0x142, 0xa>(x);
    return x;
}

namespace pg8 {
constexpr int BM = 256, BK = 64, HALF = 128, HTB = HALF * BK * 2  , STAGE_BYTES = 8 * HTB, NXCD = 8, WGM = 8;
__host__ __device__ __forceinline__ int lds_byte(int r, int c) { const int st = (r >> 4) * 2 + (c >> 5), rr = r & 15, cc = c & 31, ob = rr * 64 + cc * 2; return st * 1024 + (ob ^ (((ob >> 9) & 1) << 5)); }
__host__ __device__ __forceinline__ void stage_rc(int b, int& R, int& C) { const int st = b / 1024, sb = b % 1024, swz = sb ^ (((sb >> 9) & 1) << 5); R = (st >> 1) * 16 + swz / 64; C = (st & 1) * 32 + (swz % 64) / 2; }
__host__ __device__ __forceinline__ int perm32(int rho) { const int n = rho >> 4, i = rho & 15; return 8 * (i >> 2) + 4 * n + (i & 3); }

struct Unit { int pm, pn, e, mt; };

template <class Epi, class Sched>
__device__ __forceinline__ void gemm_phase(LAS unsigned char* lds, const int K, const Sched& S, const Epi& E) {
    int tid_o = threadIdx.x; asm volatile("" : "+v"(tid_o));
    const int tid = tid_o, wid = __builtin_amdgcn_readfirstlane(tid >> 6), lane = tid & 63, wr = wid >> 2, wc = wid & 3, fr = lane & 15, fq = lane >> 4;
    const int nt = K / BK;
    int Rr[2], Cc[2]; unsigned voffB[2];
#pragma unroll
    for (int i = 0; i < 2; ++i) { stage_rc(tid * 16 + i * 8192, Rr[i], Cc[i]); const int Rb = Epi::PERM ? ((Rr[i] & ~31) + perm32(Rr[i] & 31)) : Rr[i]; voffB[i] = (unsigned)(Rb * K + Cc[i]) * 2u; }
    const size_t kstep = (size_t)(BK * 2);
    const size_t hstep = (size_t)HALF * K * 2;
    const unsigned ldsw = (unsigned)wid * 1024u;
    const int aoff = lds_byte(wr * 64 + fr, fq * 8), boff = lds_byte(wc * 32 + fr, fq * 8);
#define PG8_SA(b, h) (((b) * 2 + (h)) * HTB)
#define PG8_SB(b, h) ((4 + (b) * 2 + (h)) * HTB)
#define PG8_STAGE(bufoff, gbase, voff) do { const char* _gb = (const char*)(gbase); asm volatile("" : "+s"(_gb));     \
        _Pragma("unroll") for (int _i = 0; _i < 2; ++_i) \
        __builtin_amdgcn_global_load_lds((const unsigned*)(_gb + (voff)[_i]), (LAS unsigned*)(lds + (bufoff) + ldsw + _i * 8192), 16, 0, 0); } while (0)
#define PG8_LDA(dst, b, h) do { _Pragma("unroll") for (int m = 0; m < 4; ++m) _Pragma("unroll") for (int k = 0; k < 2; ++k) dst[m][k] = *(const LAS bf16x8*)(lds + PG8_SA(b, h) + aoff + m * 2048 + k * 1024); } while (0)
#define PG8_LDB(dst, b, h) do { _Pragma("unroll") for (int n = 0; n < 2; ++n) _Pragma("unroll") for (int k = 0; k < 2; ++k) dst[n][k] = *(const LAS bf16x8*)(lds + PG8_SB(b, h) + boff + n * 2048 + k * 1024); } while (0)
#define PG8_MMA(ai, bj, At, Bt) do { __builtin_amdgcn_s_setprio(1); _Pragma("unroll") for (int m = 0; m < 4; ++m) _Pragma("unroll") for (int n = 0; n < 2; ++n) _Pragma("unroll") for (int k = 0; k < 2; ++k) \
        acc[ai][bj][m][n] = __builtin_amdgcn_mfma_f32_16x16x32_bf16(Bt[n][k], At[m][k], acc[ai][bj][m][n], 0, 0, 0); __builtin_amdgcn_s_setprio(0); } while (0)
#define PG8_WAIT_V(n) asm volatile("s_waitcnt vmcnt(" #n ")" ::: "memory")
#define PG8_WAIT_L(n) asm volatile("s_waitcnt lgkmcnt(" #n ")" ::: "memory")
#define PG8_BAR __builtin_amdgcn_s_barrier()
#define PG8_SCHED __builtin_amdgcn_sched_barrier(0)
    Unit cur, nxt; int ui = 0;
    if (!S.next(0, cur)) return;
    f32x4 acc[2][2][4][2];
#pragma unroll
    for (int a = 0; a < 2; ++a)
#pragma unroll
        for (int b = 0; b < 2; ++b)
#pragma unroll
            for (int m = 0; m < 4; ++m)
#pragma unroll
                for (int n = 0; n < 2; ++n) acc[a][b][m][n] = (f32x4){0.f, 0.f, 0.f, 0.f};
    bf16x8 At[4][2], B0[2][2], B1[2][2];
    unsigned vA[2][2], nvA[2][2];
    typename Epi::State est; E.pre(est, cur, wr, fr);
    S.a_off(cur, Rr, Cc, K, vA);
    const char* cA = S.a_base(cur); const char* cB = S.b_base(cur);
    PG8_STAGE(PG8_SB(0, 0), cB, voffB); PG8_STAGE(PG8_SB(0, 1), cB + hstep, voffB); PG8_STAGE(PG8_SA(0, 0), cA, vA[0]); PG8_STAGE(PG8_SA(0, 1), cA, vA[1]);
    if (wr == 1) PG8_BAR;
    PG8_WAIT_V(2); PG8_BAR;
    PG8_STAGE(PG8_SB(1, 0), cB + kstep, voffB); PG8_STAGE(PG8_SA(1, 0), cA + kstep, vA[0]); PG8_STAGE(PG8_SB(1, 1), cB + hstep + kstep, voffB);
    PG8_WAIT_V(6); PG8_BAR;
    for (;;) {
        const bool has_next = S.next(ui + 1, nxt);
        if (!has_next) nxt = cur;
        const char* nA = S.a_base(nxt); const char* nB = S.b_base(nxt);
        S.a_off(nxt, Rr, Cc, K, nvA);
        for (int t = 0; t < nt; t += 2) {
            const bool last = (t == nt - 2);
            const char* a1 = cA + (size_t)(t + 1) * kstep;
            const char* a2 = last ? nA : cA + (size_t)(t + 2) * kstep; const char* b2 = last ? nB : cB + (size_t)(t + 2) * kstep;
            const char* a3 = a2 + kstep; const char* b3 = b2 + kstep;
            unsigned w0[2], w1[2];
#pragma unroll
            for (int i = 0; i < 2; ++i) { w0[i] = last ? nvA[0][i] : vA[0][i]; w1[i] = last ? nvA[1][i] : vA[1][i]; }
            PG8_LDB(B0, 0, 0); PG8_LDB(B1, 0, 1); PG8_SCHED; PG8_LDA(At, 0, 0); PG8_STAGE(PG8_SA(1, 1), a1, vA[1]);
            PG8_WAIT_V(8); PG8_WAIT_L(0); PG8_BAR; PG8_MMA(0, 0, At, B0); PG8_MMA(0, 1, At, B1); PG8_BAR; PG8_SCHED;
            PG8_LDA(At, 0, 1); PG8_STAGE(PG8_SB(0, 0), b2, voffB); PG8_STAGE(PG8_SB(0, 1), b2 + hstep, voffB); PG8_STAGE(PG8_SA(0, 0), a2, w0);
            PG8_WAIT_V(8); PG8_WAIT_L(0); PG8_BAR; PG8_MMA(1, 0, At, B0); PG8_MMA(1, 1, At, B1); PG8_BAR; PG8_SCHED;
            PG8_LDB(B0, 1, 0); PG8_LDB(B1, 1, 1); PG8_SCHED; PG8_LDA(At, 1, 0); PG8_STAGE(PG8_SA(0, 1), a2, w1);
            PG8_WAIT_V(8); PG8_WAIT_L(0); PG8_BAR; PG8_MMA(0, 0, At, B0); PG8_MMA(0, 1, At, B1); PG8_BAR; PG8_SCHED;
            PG8_LDA(At, 1, 1); PG8_STAGE(PG8_SB(1, 0), b3, voffB); PG8_STAGE(PG8_SB(1, 1), b3 + hstep, voffB); PG8_STAGE(PG8_SA(1, 0), a3, w0);
            PG8_WAIT_V(8); PG8_WAIT_L(0); PG8_BAR; PG8_MMA(1, 0, At, B0); PG8_MMA(1, 1, At, B1); PG8_BAR; PG8_SCHED;
        }
        if (wr == 0) PG8_BAR;
        E(acc, cur, wr, wc, fr, fq, est);
        if (!has_next) break;
#pragma unroll
        for (int a = 0; a < 2; ++a)
#pragma unroll
            for (int b = 0; b < 2; ++b)
#pragma unroll
                for (int m = 0; m < 4; ++m)
#pragma unroll
                    for (int n = 0; n < 2; ++n) acc[a][b][m][n] = (f32x4){0.f, 0.f, 0.f, 0.f};
        cur = nxt; cA = nA; cB = nB; ++ui; E.pre(est, cur, wr, fr);
#pragma unroll
        for (int h = 0; h < 2; ++h)
#pragma unroll
            for (int i = 0; i < 2; ++i) vA[h][i] = nvA[h][i];
        if (wr == 1) PG8_BAR;
    }
    PG8_WAIT_V(0);
    PG8_BAR;
#undef PG8_SA
#undef PG8_SB
#undef PG8_STAGE
#undef PG8_LDA
#undef PG8_LDB
#undef PG8_MMA
#undef PG8_WAIT_V
#undef PG8_WAIT_L
#undef PG8_BAR
#undef PG8_SCHED
}
}
namespace fk {
constexpr int T = 16384, SEQ = 8192, DM = 2048, NPROJ = 6144, INW = 6152;
constexpr float EPS = 1e-6f;
constexpr size_t MiB = 1u << 20, KiB = 1u << 10;
constexpr size_t WS_CTL = 0, WS_DONE = 1024, WS_BAR = 4096, CTL_ZERO_BYTES = 32768;
constexpr size_t WS_MODP = 1 * MiB;
constexpr size_t WS_MOD = 2 * MiB;
constexpr size_t WS_WG8 = 2 * MiB + 256 * KiB;
constexpr size_t WS_WRH = 2 * MiB + 512 * KiB, WS_WRL = WS_WRH + 192 * KiB;
constexpr size_t WS_GTB = 3 * MiB, WS_GTW = 3 * MiB + 256 * KiB, WS_GTA = 3 * MiB + 512 * KiB;
constexpr size_t WS_BLAST = 3 * MiB + 768 * KiB, WS_ALAST = WS_BLAST + 4 * KiB, WS_DTOT = WS_BLAST + 8 * KiB, WS_CVEC = WS_BLAST + 9 * KiB;
constexpr size_t WS_LNS = 4 * MiB;
constexpr size_t WS_LRUA = 4 * MiB + 256 * KiB, WS_LRUH = 4 * MiB + 512 * KiB, WS_LRUC = 4 * MiB + 768 * KiB;
constexpr size_t WS_ROUTE = 5 * MiB;
constexpr size_t WS_LIST = 6 * MiB;
constexpr size_t WS_LW = 2 * MiB + 896 * KiB;
constexpr size_t WS_LISTW = 553 * MiB;
constexpr size_t WS_WLRU = 8 * MiB;
constexpr size_t WS_WIN = 9 * MiB;
constexpr size_t WS_WOUT = 33 * MiB;
constexpr size_t WS_WGU = 41 * MiB;
constexpr size_t WS_WDN = 169 * MiB;
constexpr size_t WS_HN = 233 * MiB;
constexpr size_t WS_PROJ = 297 * MiB;
constexpr size_t WS_HEXP = WS_PROJ, WS_YS = WS_PROJ + 40 * MiB;
constexpr size_t WS_LST = 489 * MiB;
constexpr size_t WS_X1B = WS_LST;
constexpr size_t WS_HLOC = 555 * MiB, WS_ACUM = 587 * MiB;
constexpr size_t WS_END = 619 * MiB;
constexpr int LDS_BYTES = 163840;
constexpr int L_CTL = 160 * 1024 - 1024;

struct Args { const float* in[25]; float* out; unsigned char* ws; int ph_lo, ph_hi; };
enum { I_X = 0, I_C, I_WADA, I_BADA, I_WIN, I_BGATES, I_CONVQK, I_MHG, I_LCW, I_LCB, I_WLA, I_BLA, I_WLX, I_BLX, I_LAM, I_LNG, I_WOUT, I_WGRP, I_BGRP, I_WRT, I_BRT, I_WEG, I_WEU, I_WED, I_FG };

#define LDS_WAIT() asm volatile("s_waitcnt lgkmcnt(0)" ::: "memory")
#define NT_LD(p) __builtin_nontemporal_load(p)
#define NT_ST(v, p) __builtin_nontemporal_store(v, p)
typedef __bf16 bf16x2_t __attribute__((ext_vector_type(2)));
__device__ __forceinline__ unsigned cvtpk(float lo, float hi) { f32x2 v = {lo, hi}; bf16x2_t b = __builtin_convertvector(v, bf16x2_t); return __builtin_bit_cast(unsigned, b); }

struct TrItem { const float* W; bf16_t* WT; int ldw, ldt; };
__device__ __forceinline__ void tr_load(const TrItem& t, f32x4 (&v)[16], int lane) {
#pragma unroll
    for (int i = 0; i < 16; ++i) v[i] = NT_LD((const f32x4*)(t.W + (size_t)(4 * i + (lane >> 4)) * t.ldw + (lane & 15) * 4));
}
__device__ __forceinline__ void tr_store(const TrItem& t, const f32x4 (&v)[16], LAS float* scr, int lane) {
#pragma unroll
    for (int i = 0; i < 16; ++i) { LAS float* sp = scr + (4 * i + (lane >> 4)) * 65 + (lane & 15) * 4; sp[0] = v[i].x; sp[1] = v[i].y; sp[2] = v[i].z; sp[3] = v[i].w; }
    LDS_WAIT(); asm volatile("" ::: "memory");
#pragma unroll
    for (int j = 0; j < 8; ++j) { const int pair = lane + 64 * j, c = pair & 7, n = pair >> 3; const LAS float* s = scr + (8 * c) * 65 + n;
        u32x4 o; o.x = cvtpk(s[0 * 65], s[1 * 65]); o.y = cvtpk(s[2 * 65], s[3 * 65]); o.z = cvtpk(s[4 * 65], s[5 * 65]); o.w = cvtpk(s[6 * 65], s[7 * 65]);
        NT_ST(o, (u32x4*)(t.WT + (size_t)n * t.ldt + 8 * c)); }
    LDS_WAIT(); asm volatile("" ::: "memory");
}
constexpr int TR_IN = 32 * 96, TR_OUT = 32 * 32, TR_L = 64, TR_G = 32 * 256, TR_U = TR_G, TR_D = 32 * 256;
#ifndef TR_KEEP
#define TR_KEEP 5632
#endif
constexpr int TR_EARLY = TR_IN + TR_OUT + TR_L + TR_KEEP, TR_ALL = TR_IN + TR_OUT + TR_L + TR_G + TR_U + TR_D;
__device__ __forceinline__ TrItem tr_mk(const float* W, int ldw, int k0, int n0src, bf16_t* WT, int ldt, int rowdst0) { TrItem t; t.W = W + (size_t)k0 * ldw + n0src; t.WT = WT + (size_t)rowdst0 * ldt + k0; t.ldw = ldw; t.ldt = ldt; return t; }
__device__ __forceinline__ TrItem tr_decode(const Args& a, int it) {
    unsigned char* ws = a.ws; int r = it;
    if (r < TR_IN) { const int kb = r / 96, nb = r % 96, n0 = 64 * nb; return tr_mk(a.in[I_WIN], INW, 64 * kb, n0 + (n0 >= 4096 ? 8 : 0), (bf16_t*)(ws + WS_WIN), 2048, n0); } r -= TR_IN;
    if (r < TR_OUT) { const int kb = r / 32, nb = r % 32; return tr_mk(a.in[I_WOUT], 2048, 64 * kb, 64 * nb, (bf16_t*)(ws + WS_WOUT), 2048, 64 * nb); } r -= TR_OUT;
    if (r < TR_L) { const int mi = r / 4, q = r % 4, kb = q / 2, nb = q % 2, n = mi >> 1, g = mi & 1;
        return tr_mk((g ? a.in[I_WLX] : a.in[I_WLA]) + (size_t)n * 16384, 128, 64 * kb, 64 * nb, (bf16_t*)(ws + WS_WLRU), 128, (n * 2 + g) * 128 + 64 * nb); } r -= TR_L;
    if (r < TR_G) { const int e = r / 256, q = r % 256, kb = q / 8, nb = q % 8, n0 = 64 * nb;
        return tr_mk(a.in[I_WEG] + (size_t)e * 2048 * 512, 512, 64 * kb, n0, (bf16_t*)(ws + WS_WGU), 2048, e * 1024 + (n0 / 128) * 256 + (n0 % 128)); } r -= TR_G;
    if (r < TR_U) { const int e = r / 256, q = r % 256, kb = q / 8, nb = q % 8, n0 = 64 * nb;
        return tr_mk(a.in[I_WEU] + (size_t)e * 2048 * 512, 512, 64 * kb, n0, (bf16_t*)(ws + WS_WGU), 2048, e * 1024 + (n0 / 128) * 256 + 128 + (n0 % 128)); } r -= TR_U;
    { const int e = r / 256, q = r % 256, kb = q / 32, nb = q % 32;
        return tr_mk(a.in[I_WED] + (size_t)e * 512 * 2048, 2048, 64 * kb, 64 * nb, (bf16_t*)(ws + WS_WDN), 512, e * 2048 + 64 * nb); }
}
__device__ __forceinline__ void p2_convert(const Args& a, LAS unsigned char* lds, int cw, int ncw) {
    int tid_o = threadIdx.x; asm volatile("" : "+v"(tid_o));
    const int lane = tid_o & 63, wave = __builtin_amdgcn_readfirstlane(tid_o >> 6);
    LAS float* scr = (LAS float*)(lds + wave * 16896);
    int it = TR_EARLY + cw; if (it >= TR_ALL) return;
#ifdef CONV3
    f32x4 va[16], vb[16], vc[16]; TrItem ta = tr_decode(a, it), tb = ta, tc = ta; tr_load(ta, va, lane);
    it += ncw; bool hb = it < TR_ALL; if (hb) { tb = tr_decode(a, it); tr_load(tb, vb, lane); }
#pragma unroll 1
    for (;;) {
        it += ncw; const bool hc = it < TR_ALL; if (hc) { tc = tr_decode(a, it); tr_load(tc, vc, lane); }
        tr_store(ta, va, scr, lane); if (!hb) break;
        it += ncw; const bool ha = it < TR_ALL; if (ha) { ta = tr_decode(a, it); tr_load(ta, va, lane); }
        tr_store(tb, vb, scr, lane); if (!hc) break;
        it += ncw; hb = it < TR_ALL; if (hb) { tb = tr_decode(a, it); tr_load(tb, vb, lane); }
        tr_store(tc, vc, scr, lane); if (!ha) break;
    }
#else
    f32x4 va[16], vb[16]; TrItem ta = tr_decode(a, it), tb = ta; tr_load(ta, va, lane);
#pragma unroll 1
    for (;;) {
        it += ncw; const bool hb = it < TR_ALL; if (hb) { tb = tr_decode(a, it); tr_load(tb, vb, lane); }
        tr_store(ta, va, scr, lane); if (!hb) break;
        it += ncw; const bool ha = it < TR_ALL; if (ha) { ta = tr_decode(a, it); tr_load(ta, va, lane); }
        tr_store(tb, vb, scr, lane); if (!ha) break;
    }
#endif
}
__device__ __forceinline__ void p0_prologue(const Args& a, LAS unsigned char* lds, int vcu, int G, int nconv) {
    int tid_o = threadIdx.x; asm volatile("" : "+v"(tid_o));
    const int tid = tid_o, lane = tid & 63, wave = __builtin_amdgcn_readfirstlane(tid >> 6);
    LAS float* scr = (LAS float*)(lds + wave * 16896);
    const int gw = vcu * 8 + wave, NGW = G * 8;
    unsigned char* ws = a.ws;
    const int nGw = (2 * G < 384) ? 2 * G : 384;
    const bool isG = wave < 2 && (vcu * 2 + wave) < 384;
    if (wave < 2) for (int task = vcu * 2 + wave; task < 384; task += 2 * G) {
        const int cg = task % 48, ks = task / 48, n = cg * 256 + lane * 4;
        const float* c = a.in[I_C]; const float* wada = a.in[I_WADA];
        f32x4 a0 = {0.f, 0.f, 0.f, 0.f}, a1 = {0.f, 0.f, 0.f, 0.f};
#pragma unroll 1
        for (int k0 = ks * 256; k0 < ks * 256 + 256; k0 += 16) { f32x4 w[16];
#pragma unroll
            for (int q = 0; q < 16; ++q) w[q] = NT_LD((const f32x4*)(wada + (size_t)(k0 + q) * 12288 + n));
#pragma unroll
            for (int q = 0; q < 16; ++q) { const float s0 = fsilu(c[k0 + q]), s1 = fsilu(c[2048 + k0 + q]); a0 += s0 * w[q]; a1 += s1 * w[q]; } }
        float* modp = (float*)(ws + WS_MODP);
        *(f32x4*)(modp + (size_t)(ks * 2 + 0) * 12288 + n) = a0; *(f32x4*)(modp + (size_t)(ks * 2 + 1) * 12288 + n) = a1;
    }
    const int NITEMS = nconv ? TR_EARLY : TR_ALL;
    const int N1 = nconv ? 0 : ((G == 256) ? 5 * NGW : NITEMS);
    const int before = (2 * vcu + (wave < 2 ? wave : 2)) < nGw ? (2 * vcu + (wave < 2 ? wave : 2)) : nGw;
    const int it2_0 = N1 + (gw - before), it2_s = NGW - nGw;
    for (int pass = 0; pass < 2; ++pass)
    for (int it = pass ? it2_0 : gw; it < (pass ? NITEMS : N1); it += (pass ? it2_s : NGW)) {
        if (pass && isG) break;
        TrItem t = tr_decode(a, it); f32x4 v[16]; tr_load(t, v, lane); tr_store(t, v, scr, lane);
    }
    const int gt = vcu * 512 + tid, NGT = G * 512;
    float* wg8 = (float*)(ws + WS_WG8); bf16_t* wrh = (bf16_t*)(ws + WS_WRH); bf16_t* wrl = (bf16_t*)(ws + WS_WRL);
    for (int i = gt; i < 8 * 2048; i += NGT) { const int g = i >> 11, k = i & 2047; wg8[i] = a.in[I_WIN][(size_t)k * INW + 4096 + g]; }
    for (int i = gt; i < 48 * 2048; i += NGT) { const int c = i >> 11, k = i & 2047; const float w = c < 4 ? a.in[I_WGRP][k * 4 + c] : (c < 36 ? a.in[I_WRT][k * 32 + (c - 4)] : 0.f);
        const unsigned hi = f2bf(w); wrh[i] = (bf16_t)hi; wrl[i] = (bf16_t)f2bf(w - bf1((bf16_t)hi)); }
}

__device__ __forceinline__ void p1_hn_gates(const Args& a, LAS unsigned char* lds, int vcu, int G) {
    int tid_o = threadIdx.x; asm volatile("" : "+v"(tid_o));
    const int tid = tid_o, lane = tid & 63, wave = __builtin_amdgcn_readfirstlane(tid >> 6);
    unsigned char* ws = a.ws;
    LAS float* modv = (LAS float*)lds;
    LAS float* wgs = (LAS float*)(lds + 16384);
    LAS float* gts = (LAS float*)(lds + 16384 + 65536);
    const float* modp = (const float*)(ws + WS_MODP); const float* bada = a.in[I_BADA];
    for (int i = tid; i < 8 * 2048; i += 512) wgs[i] = ((const float*)(ws + WS_WG8))[i];
    for (int ch = vcu; ch < 256; ch += G) {
        const int b = ch >> 7;
        __syncthreads();
        for (int i = tid; i < 4096; i += 512) { float v = bada[i]; for (int ks = 0; ks < 8; ++ks) v += modp[(size_t)(ks * 2 + b) * 12288 + i]; modv[i] = v; }
        if (ch < 72) {
            const int bb = ch / 36, n = ch % 36; float p = 0.f;
            for (int k = tid; k < 2048; k += 512) { float sh = bada[6144 + k]; for (int ks = 0; ks < 8; ++ks) sh += modp[(size_t)(ks * 2 + bb) * 12288 + 6144 + k];
                p += sh * (n < 4 ? a.in[I_WGRP][k * 4 + n] : a.in[I_WRT][k * 32 + (n - 4)]); }
            p = wave_sum(p); LAS float* red = gts + 512;
            if (lane == 0) red[wave] = p;
            __syncthreads();
            if (tid == 0) { float q = 0.f; for (int w = 0; w < 8; ++w) q += red[w]; ((float*)(ws + WS_CVEC))[bb * 48 + n] = q + (n < 4 ? a.in[I_BGRP][n] : a.in[I_BRT][n - 4]); }
        }
        if (tid < 96) { const int o = ch * 96 + tid, bb = o / 12288, col = o % 12288; float v = bada[col]; for (int ks = 0; ks < 8; ++ks) v += modp[(size_t)(ks * 2 + bb) * 12288 + col]; ((float*)(ws + WS_MOD))[o] = v; }
        __syncthreads();
#pragma unroll 1
        for (int i4 = 0; i4 < 2; ++i4) {
            const int rowb = ch * 64 + wave * 8 + i4 * 4;
            f32x4 v[4][8]; float rs[4];
#pragma unroll
            for (int r = 0; r < 4; ++r) { const f32x4* xr = (const f32x4*)(a.in[I_X] + (size_t)(rowb + r) * DM) + lane;
#pragma unroll
                for (int j = 0; j < 8; ++j) v[r][j] = NT_LD(xr + 64 * j); }
#pragma unroll
            for (int r = 0; r < 4; ++r) { float s = 0.f;
#pragma unroll
                for (int j = 0; j < 8; ++j) s += (v[r][j].x * v[r][j].x + v[r][j].y * v[r][j].y) + (v[r][j].z * v[r][j].z + v[r][j].w * v[r][j].w);
                rs[r] = rsqrtf(wave_sum(s) * (1.f / DM) + EPS); }
#pragma unroll
            for (int j = 0; j < 8; ++j) { const f32x4 sh = *(const LAS f32x4*)(modv + 4 * lane + 256 * j), sc = *(const LAS f32x4*)(modv + 2048 + 4 * lane + 256 * j) + 1.f;
#pragma unroll
                for (int r = 0; r < 4; ++r) { v[r][j] = v[r][j] * rs[r] * sc + sh;
                    u32x2* o8 = (u32x2*)((bf16_t*)(ws + WS_HN) + (size_t)(rowb + r) * DM) + lane; o8[64 * j] = (u32x2){cvtpk(v[r][j].x, v[r][j].y), cvtpk(v[r][j].z, v[r][j].w)}; } }
            float gv[4] = {0.f, 0.f, 0.f, 0.f};
#pragma unroll
            for (int g = 0; g < 8; ++g) { float p[4] = {0.f, 0.f, 0.f, 0.f};
#pragma unroll
                for (int j = 0; j < 8; ++j) { const f32x4 w = *(const LAS f32x4*)(wgs + g * 2048 + 4 * lane + 256 * j);
#pragma unroll
                    for (int r = 0; r < 4; ++r) p[r] += (v[r][j].x * w.x + v[r][j].y * w.y) + (v[r][j].z * w.z + v[r][j].w * w.w); }
#pragma unroll
                for (int r = 0; r < 4; ++r) { const float q = wave_sum(p[r]); if (lane == g) gv[r] = q; } }
#pragma unroll
            for (int r = 0; r < 4; ++r) if (lane < 8) gts[(wave * 8 + i4 * 4 + r) * 8 + lane] = gv[r];
        }
        __syncthreads();
        if (wave < 4) {
            const int h = wave, row = ch * 64 + lane; const float* bg = a.in[I_BGATES];
            const float ig = gts[lane * 8 + h] + bg[h]; const float lf = flogsigmoid(gts[lane * 8 + 4 + h] + bg[4 + h]);
            float bc = lf;
#pragma unroll
            for (int o = 1; o < 64; o <<= 1) { const float t = __shfl_up(bc, o); if (lane >= o) bc += t; }
            const float w = ig - bc; float am = w;
#pragma unroll
            for (int o = 1; o < 64; o <<= 1) { const float t = __shfl_up(am, o); if (lane >= o) am = fmaxf(am, t); }
            ((float*)(ws + WS_GTB))[row * 4 + h] = bc; ((float*)(ws + WS_GTW))[row * 4 + h] = w; ((float*)(ws + WS_GTA))[row * 4 + h] = am;
            if (lane == 63) { const int bh = b * 4 + h, c = ch & 127; ((float*)(ws + WS_BLAST))[bh * 128 + c] = bc; ((float*)(ws + WS_ALAST))[bh * 128 + c] = am; }
        }
    }
    __syncthreads();
}

struct DenseSched {
    static constexpr bool GATHER = false;
    const char* A; const char* Bt; int K, nM, nN, nwg, G, c;
    __device__ __forceinline__ void init(const void* A_, const void* Bt_, int M, int N, int K_, int G_, int c_) { A = (const char*)A_; Bt = (const char*)Bt_; K = K_; nM = M / 256; nN = N / 256; nwg = nM * nN; G = G_; c = c_; }
    __device__ __forceinline__ bool next(int i, pg8::Unit& u) const {
#ifdef P2_DUP
        if (K == 2048 && nN == 24) { const int cnt = (nwg - c + G - 1) / G; if (i >= 2 * cnt) return false; if (i >= cnt) i -= cnt; }
#endif
        const long L = (long)i * G + c; if (L >= nwg) return false;
        int wgid = (int)L; { const int q = nwg / 8, r = nwg % 8, xcd = wgid % 8, off = wgid / 8; wgid = (xcd < r ? xcd * (q + 1) : r * (q + 1) + (xcd - r) * q) + off; }
        const int nig = 8 * nN, gid = wgid / nig, fm = gid * 8, gsz = (nM - fm) < 8 ? (nM - fm) : 8;
        u.pm = fm + ((wgid % nig) % gsz); u.pn = (wgid % nig) / gsz; u.e = 0; u.mt = 0; return true;
    }
    __device__ __forceinline__ const char* a_base(const pg8::Unit& u) const { return A + (size_t)u.pm * 256 * K * 2; }
    __device__ __forceinline__ const char* b_base(const pg8::Unit& u) const { return Bt + (size_t)u.pn * 256 * K * 2; }
    __device__ __forceinline__ void a_off(const pg8::Unit&, const int (&R)[2], const int (&C)[2], int K_, unsigned (&v)[2][2]) const {
#pragma unroll
        for (int h = 0; h < 2; ++h)
#pragma unroll
            for (int i = 0; i < 2; ++i) v[h][i] = (unsigned)((128 * h + R[i]) * K_ + C[i]) * 2u;
    }
};
#define EPI_NOSTATE struct State {}; __device__ __forceinline__ void pre(State&, const pg8::Unit&, int, int) const {}
struct EpiProj {
    static constexpr bool PERM = true; EPI_NOSTATE
    bf16_t* O; int ldc;
    __device__ __forceinline__ void operator()(const f32x4 (&acc)[2][2][4][2], const pg8::Unit& u, int wr, int wc, int fr, int fq, const State& est) const {
        const int row0 = u.pm * 256 + wr * 64 + fr, col0 = u.pn * 256 + wc * 32 + 8 * fq;
#pragma unroll
        for (int ai = 0; ai < 2; ++ai)
#pragma unroll
            for (int m = 0; m < 4; ++m) { bf16_t* rowp = O + (size_t)(row0 + ai * 128 + m * 16) * ldc + col0;
#pragma unroll
                for (int bj = 0; bj < 2; ++bj) { const f32x4 v0 = acc[ai][bj][m][0], v1 = acc[ai][bj][m][1];
                    u32x4 w; w.x = cvtpk(v0[0], v0[1]); w.y = cvtpk(v0[2], v0[3]); w.z = cvtpk(v1[0], v1[1]); w.w = cvtpk(v1[2], v1[3]);
                    *(u32x4*)(rowp + bj * 128) = w; } }
    }
};
struct EpiX1 {
    static constexpr bool PERM = true; EPI_NOSTATE
    const float* x; const float* mod; bf16_t* x1b;
    __device__ __forceinline__ void operator()(const f32x4 (&acc)[2][2][4][2], const pg8::Unit& u, int wr, int wc, int fr, int fq, const State& est) const {
        const int row0 = u.pm * 256 + wr * 64 + fr, col0 = u.pn * 256 + wc * 32 + 8 * fq;
        const float* g1 = mod + (size_t)((u.pm * 256) / SEQ) * 12288 + 4096;
#pragma unroll
        for (int bj = 0; bj < 2; ++bj) { const int col = col0 + bj * 128; const f32x4 ga = *(const f32x4*)(g1 + col), gb = *(const f32x4*)(g1 + col + 4);
#pragma unroll
            for (int ai = 0; ai < 2; ++ai)
#pragma unroll
                for (int m = 0; m < 4; ++m) { const size_t off = (size_t)(row0 + ai * 128 + m * 16) * DM + col; const f32x4 xa = NT_LD((const f32x4*)(x + off)), xb = NT_LD((const f32x4*)(x + off + 4));
                    const f32x4 va = xa + ga * acc[ai][bj][m][0], vb = xb + gb * acc[ai][bj][m][1];
                    *(u32x4*)(x1b + off) = (u32x4){cvtpk(va.x, va.y), cvtpk(va.z, va.w), cvtpk(vb.x, vb.y), cvtpk(vb.z, vb.w)}; } }
    }
};
template <int NT, bool GATH>
struct MoeSched {
    static constexpr bool GATHER = GATH;
    const LAS int* tp; const int* cnt; const int* list; const char* A; const char* Bt; int K, first, stride, end;
    __device__ __forceinline__ bool next(int i, pg8::Unit& u) const {
        const int L = first + i * stride; if (L >= end) return false;
        const int tile = L / NT; u.pn = L % NT;
        const int e = __builtin_amdgcn_readfirstlane((int)((const LAS unsigned short*)(tp + 160))[tile]);
        u.e = e; u.mt = tile - tp[e]; u.pm = tile; return true;
    }
    __device__ __forceinline__ const char* a_base(const pg8::Unit& u) const { return GATH ? A : A + (size_t)u.pm * 256 * K * 2; }
    __device__ __forceinline__ const char* b_base(const pg8::Unit& u) const { return Bt + ((size_t)u.e * NT + u.pn) * 256 * K * 2; }
    __device__ __forceinline__ void a_off(const pg8::Unit& u, const int (&R)[2], const int (&C)[2], int K_, unsigned (&v)[2][2]) const {
        if (GATH) { const int n = cnt[u.e]; const int* lp = list + (size_t)u.e * T + u.mt * 256;
#pragma unroll
            for (int h = 0; h < 2; ++h)
#pragma unroll
                for (int i = 0; i < 2; ++i) { const int r = 128 * h + R[i]; const int tok = (u.mt * 256 + r < n) ? (lp[r] >> 1) : 0; v[h][i] = (unsigned)(tok * K_ + C[i]) * 2u; }
        } else {
#pragma unroll
            for (int h = 0; h < 2; ++h)
#pragma unroll
                for (int i = 0; i < 2; ++i) v[h][i] = (unsigned)((128 * h + R[i]) * K_ + C[i]) * 2u;
        }
    }
};
struct EpiGateUp {
    static constexpr bool PERM = true; EPI_NOSTATE
    bf16_t* H;
    __device__ __forceinline__ void operator()(const f32x4 (&acc)[2][2][4][2], const pg8::Unit& u, int wr, int wc, int fr, int fq, const State& est) const {
        const int row0 = u.pm * 256 + wr * 64 + fr, col0 = u.pn * 128 + wc * 32 + 8 * fq;
#pragma unroll
        for (int ai = 0; ai < 2; ++ai)
#pragma unroll
            for (int m = 0; m < 4; ++m) { bf16_t* rowp = H + (size_t)(row0 + ai * 128 + m * 16) * 512 + col0;
                const f32x4 g0 = acc[ai][0][m][0], g1 = acc[ai][0][m][1], u0 = acc[ai][1][m][0], u1 = acc[ai][1][m][1];
                u32x4 w; w.x = cvtpk(fsilu(g0[0]) * u0[0], fsilu(g0[1]) * u0[1]); w.y = cvtpk(fsilu(g0[2]) * u0[2], fsilu(g0[3]) * u0[3]);
                w.z = cvtpk(fsilu(g1[0]) * u1[0], fsilu(g1[1]) * u1[1]); w.w = cvtpk(fsilu(g1[2]) * u1[2], fsilu(g1[3]) * u1[3]);
                *(u32x4*)rowp = w; }
    }
};
constexpr int L_G2T = 131072;
struct EpiDown {
    static constexpr bool PERM = true;
    struct State { unsigned pk[2][4]; };
    bf16_t* Y; const int* cnt; const int* list; const float* listw; const bf16_t* x1; const LAS float* g2t;
    __device__ __forceinline__ void pre(State& st, const pg8::Unit& u, int wr, int fr) const {
        const int n = cnt[u.e]; const size_t base = (size_t)u.e * T + u.mt * 256;
#pragma unroll
        for (int ai = 0; ai < 2; ++ai)
#pragma unroll
            for (int m = 0; m < 4; ++m) { const int r = ai * 128 + wr * 64 + m * 16 + fr; const bool ok = u.mt * 256 + r < n;
                const unsigned d = ok ? (unsigned)list[base + r] : 0xFFFFu; const float g = ok ? listw[base + r] : 0.f; st.pk[ai][m] = (cvtpk(0.f, g) & 0xffff0000u) | d; }
    }
    __device__ __forceinline__ void operator()(const f32x4 (&acc)[2][2][4][2], const pg8::Unit& u, int wr, int wc, int fr, int fq, const State& st) const {
        const int col0 = u.pn * 256 + wc * 32 + 8 * fq;
#pragma unroll
        for (int ai = 0; ai < 2; ++ai) {
            u32x4 xr[4][2];
#pragma unroll
            for (int m = 0; m < 4; ++m) { const unsigned dst = st.pk[ai][m] & 0xffffu; const bool s0 = (dst & 1u) == 0u;
#pragma unroll
                for (int bj = 0; bj < 2; ++bj) xr[m][bj] = s0 ? NT_LD((const u32x4*)(x1 + (size_t)(dst >> 1) * DM + col0 + bj * 128)) : (u32x4){0u, 0u, 0u, 0u}; }
#pragma unroll
            for (int m = 0; m < 4; ++m) { const unsigned pk = st.pk[ai][m]; const unsigned dst = pk & 0xffffu;
                if (dst != 0xFFFFu) { const float gw = bfhi(pk); bf16_t* rowp = Y + (size_t)dst * DM + col0; const LAS float* g2 = g2t + ((dst >> 1) >= (unsigned)SEQ ? 2048 : 0) + col0;
#pragma unroll
                    for (int bj = 0; bj < 2; ++bj) { const f32x4 ga = *(const LAS f32x4*)(g2 + bj * 128) * gw, gb = *(const LAS f32x4*)(g2 + bj * 128 + 4) * gw; const u32x4 x = xr[m][bj];
                        const f32x4 v0 = (f32x4){bflo(x.x), bfhi(x.x), bflo(x.y), bfhi(x.y)} + acc[ai][bj][m][0] * ga, v1 = (f32x4){bflo(x.z), bfhi(x.z), bflo(x.w), bfhi(x.w)} + acc[ai][bj][m][1] * gb;
                        u32x4 w; w.x = cvtpk(v0[0], v0[1]); w.y = cvtpk(v0[2], v0[3]); w.z = cvtpk(v1[0], v1[1]); w.w = cvtpk(v1[2], v1[3]);
                        *(u32x4*)(rowp + bj * 128) = w; } } }
        }
    }
};

constexpr int L_KWT = 0, L_VT = 36864, L_QS = 73728, L_KS = 107520, L_PS = 141312, L_F = 150528;
constexpr int L_WEXP = L_F, L_MT = L_F + 256, L_EI = L_F + 512, L_RDN = L_F + 768, L_BT = L_F + 1024, L_WK = L_F + 1280, L_NS = L_F + 1536, L_RSS = L_F + 2560, L_MCH = L_F + 4608, L_RN = L_F + 5248, L_GW = L_F + 5504, L_GA = L_GW + 1024, L_GB = L_GA + 1024, L_AL = L_GB + 1024;
static_assert(L_AL + 16 <= L_CTL, "mixer LDS map");

#define MLSTM_LOAD_RAW(cc) do { const int c_ = (cc), r0c_ = b * SEQ + c_ * 64, dp_ = tid & 127, tg_ = tid >> 7, d0_ = 2 * dp_, s0_ = 16 * tg_, tt0_ = c_ * 64 + s0_; \
          _Pragma("unroll") for (int q = 0; q < 19; ++q) { const int ti = tt0_ - 3 + q; rawk[q] = ti >= 0 ? (FULL ? NT_LD((const unsigned*)(PROJ + (size_t)(r0c_ + s0_ - 3 + q) * NPROJ + 1024 + h * 256 + d0_)) : *(const unsigned*)(PROJ + (size_t)(r0c_ + s0_ - 3 + q) * NPROJ + 1024 + h * 256 + d0_)) : 0u; } \
          } while (0)
#define MLSTM_LOAD_RAWV(cc) do { const int c_ = (cc), r0c_ = b * SEQ + c_ * 64, dp_ = tid & 127, tg_ = tid >> 7, d0_ = 2 * dp_, s0_ = 16 * tg_; \
          _Pragma("unroll") for (int q = 0; q < 16; ++q) rawv[q] = FULL ? NT_LD((const unsigned*)(PROJ + (size_t)(r0c_ + s0_ + q) * NPROJ + 2048 + h * 256 + d0_)) : *(const unsigned*)(PROJ + (size_t)(r0c_ + s0_ + q) * NPROJ + 2048 + h * 256 + d0_); } while (0)
#define MLSTM_LOAD_RAWQ(cc) do { const int c_ = (cc), r0c_ = b * SEQ + c_ * 64, dp_ = tid & 127, tg_ = tid >> 7, d0_ = 2 * dp_, s0_ = 16 * tg_, tt0_ = c_ * 64 + s0_; \
          _Pragma("unroll") for (int q = 0; q < 19; ++q) { const int ti = tt0_ - 3 + q; rawq[q] = ti >= 0 ? NT_LD((const unsigned*)(PROJ + (size_t)(r0c_ + s0_ - 3 + q) * NPROJ + h * 256 + d0_)) : 0u; } } while (0)
template <bool FULL>
__device__ __forceinline__ void mlstm_unit(const Args& a, LAS unsigned char* lds, int bh, int j) {
    int tid_o0 = threadIdx.x; asm volatile("" : "+v"(tid_o0));
    const int tid = tid_o0, lane = tid & 63, wave = __builtin_amdgcn_readfirstlane(tid >> 6), hh = lane >> 5, l31 = lane & 31;
    const int b = bh >> 2, h = bh & 3;
    unsigned char* ws = a.ws;
    const bf16_t* PROJ = (const bf16_t*)(ws + WS_PROJ);
    const float* BLAST = (const float*)(ws + WS_BLAST); const float* ALAST = (const float*)(ws + WS_ALAST);
    LAS float* mch = (LAS float*)(lds + L_MCH); LAS float* nsv = (LAS float*)(lds + L_NS);
    LAS float* WEXP = (LAS float*)(lds + L_WEXP); LAS float* MT = (LAS float*)(lds + L_MT); LAS float* EI = (LAS float*)(lds + L_EI); LAS float* RDN = (LAS float*)(lds + L_RDN);
    LAS float* BT = (LAS float*)(lds + L_BT); LAS float* WK = (LAS float*)(lds + L_WK); LAS float* RSS = (LAS float*)(lds + L_RSS); LAS float* RN = (LAS float*)(lds + L_RN);
    const int unit = bh * 32 + j;
    __syncthreads();
    if (wave == 0) {
        const float pa = BLAST[bh * 128 + 2 * lane], qa = ALAST[bh * 128 + 2 * lane] + pa, pb = BLAST[bh * 128 + 2 * lane + 1], qb = ALAST[bh * 128 + 2 * lane + 1] + pb;
        float P = pa + pb, Q = fmaxf(qa + pb, qb);
#pragma unroll
        for (int o = 1; o < 64; o <<= 1) { const float oP = __shfl_up(P, o), oQ = __shfl_up(Q, o); if (lane >= o) { Q = fmaxf(oQ + P, Q); P = oP + P; } }
        float eP = __shfl_up(P, 1), eQ = __shfl_up(Q, 1); if (lane == 0) { eP = 0.f; eQ = -INFINITY; }
        const float m0 = fmaxf(eP, eQ), m1 = fmaxf(m0 + pa, qa);
        mch[2 * lane] = m0; mch[2 * lane + 1] = m1;
    }
    f32x16 C[8];
#pragma unroll
    for (int dt = 0; dt < 8; ++dt)
#pragma unroll
        for (int r = 0; r < 16; ++r) C[dt][r] = 0.f;
    if (FULL && j > 0) {
        const bf16_t* st = (const bf16_t*)(ws + WS_LST) + (size_t)(unit - 1) * 65536;
#pragma unroll
        for (int dt = 0; dt < 8; ++dt)
#pragma unroll
            for (int q = 0; q < 4; ++q) { const u32x2 v = NT_LD((const u32x2*)(st + ((dt * 4 + q) * 512 + tid) * 4)); C[dt][4 * q] = bflo(v.x); C[dt][4 * q + 1] = bfhi(v.x); C[dt][4 * q + 2] = bflo(v.y); C[dt][4 * q + 3] = bfhi(v.y); }
    }
    if (tid < 256) nsv[tid] = (FULL && j > 0) ? ((const float*)(ws + WS_LNS))[(size_t)(unit - 1) * 256 + tid] : 0.f;
    if (tid < 256) { const int row = b * SEQ + j * 256 + tid;
        ((LAS float*)(lds + L_GW))[tid] = ((const float*)(ws + WS_GTW))[row * 4 + h]; ((LAS float*)(lds + L_GA))[tid] = ((const float*)(ws + WS_GTA))[row * 4 + h]; ((LAS float*)(lds + L_GB))[tid] = ((const float*)(ws + WS_GTB))[row * 4 + h]; }
    if (tid < 4) ((LAS float*)(lds + L_AL))[tid] = ALAST[bh * 128 + 4 * j + tid];
    float dtot_log = 0.f;
    __syncthreads();
#pragma unroll 1
    for (int i = 0; i < 4; ++i) {
        int tid_o = threadIdx.x; asm volatile("" : "+v"(tid_o));
        const int tid = tid_o, lane = tid & 63, hh = lane >> 5, l31 = lane & 31;
        const int c = 4 * j + i; const int r0c = b * SEQ + c * 64;
        const float mc = mch[c]; const float M63 = fmaxf(mc, ((const LAS float*)(lds + L_AL))[i]); const float decay = __expf(mc - M63);
        dtot_log += mc - M63;
        unsigned rawk[19], rawv[16], rawq[19]; MLSTM_LOAD_RAW(c); MLSTM_LOAD_RAWV(c); if (FULL) MLSTM_LOAD_RAWQ(c);
        float cwk[4][2], cwq[4][2];
        { const float* cw = a.in[I_CONVQK]; const int d0 = 2 * (tid & 127);
#pragma unroll
          for (int q = 0; q < 4; ++q) { cwk[q][0] = cw[q * 2048 + 1024 + h * 256 + d0]; cwk[q][1] = cw[q * 2048 + 1024 + h * 256 + d0 + 1]; if (FULL) { cwq[q][0] = cw[q * 2048 + h * 256 + d0]; cwq[q][1] = cw[q * 2048 + h * 256 + d0 + 1]; } } }
        if (tid < 64) { const float w = ((const LAS float*)(lds + L_GW))[i * 64 + tid], am = ((const LAS float*)(lds + L_GA))[i * 64 + tid], bt = ((const LAS float*)(lds + L_GB))[i * 64 + tid];
            const float Mt = fmaxf(mc, am); WEXP[tid] = w; MT[tid] = Mt; EI[tid] = __expf(mc - Mt); BT[tid] = bt; WK[tid] = __expf(w - M63); }
        __syncthreads();
        {
            const int dp = tid & 127, tg = tid >> 7, d0 = 2 * dp, s0 = 16 * tg;
            const int tt0 = c * 64 + s0;
            const float* cw = a.in[I_CONVQK];
            {
                const float (&w)[4][2] = cwk;
                const unsigned (&raw)[19] = rawk;
                unsigned pa[8], pb[8]; float ka = 0.f, kb = 0.f;
#pragma unroll
                for (int s = 0; s < 16; ++s) { float x0 = 0.f, x1 = 0.f;
#pragma unroll
                    for (int q = 0; q < 4; ++q) { x0 += w[q][0] * bflo(raw[s + q]); x1 += w[q][1] * bfhi(raw[s + q]); }
                    x0 = fsilu(x0) * 0.0625f; x1 = fsilu(x1) * 0.0625f;
                    if (FULL) *(LAS unsigned*)(lds + L_KS + (s0 + s) * 528 + d0 * 2) = cvtpk(x0, x1);
                    const float wk = WK[s0 + s]; x0 *= wk; x1 *= wk;
                    if (s & 1) { pa[s >> 1] = cvtpk(ka, x0); pb[s >> 1] = cvtpk(kb, x1); } else { ka = x0; kb = x1; } }
                *(LAS u32x4*)(lds + L_KWT + d0 * 144 + s0 * 2) = (u32x4){pa[0], pa[1], pa[2], pa[3]}; *(LAS u32x4*)(lds + L_KWT + d0 * 144 + s0 * 2 + 16) = (u32x4){pa[4], pa[5], pa[6], pa[7]};
                *(LAS u32x4*)(lds + L_KWT + (d0 + 1) * 144 + s0 * 2) = (u32x4){pb[0], pb[1], pb[2], pb[3]}; *(LAS u32x4*)(lds + L_KWT + (d0 + 1) * 144 + s0 * 2 + 16) = (u32x4){pb[4], pb[5], pb[6], pb[7]};
            }
            __builtin_amdgcn_sched_barrier(0);
            {
                const unsigned (&raw)[16] = rawv;
                unsigned pa[8], pb[8];
#pragma unroll
                for (int q = 0; q < 8; ++q) { pa[q] = (raw[2 * q] & 0xffffu) | (raw[2 * q + 1] << 16); pb[q] = (raw[2 * q] >> 16) | (raw[2 * q + 1] & 0xffff0000u); }
                *(LAS u32x4*)(lds + L_VT + d0 * 144 + s0 * 2) = (u32x4){pa[0], pa[1], pa[2], pa[3]}; *(LAS u32x4*)(lds + L_VT + d0 * 144 + s0 * 2 + 16) = (u32x4){pa[4], pa[5], pa[6], pa[7]};
                *(LAS u32x4*)(lds + L_VT + (d0 + 1) * 144 + s0 * 2) = (u32x4){pb[0], pb[1], pb[2], pb[3]}; *(LAS u32x4*)(lds + L_VT + (d0 + 1) * 144 + s0 * 2 + 16) = (u32x4){pb[4], pb[5], pb[6], pb[7]};
            }
            __builtin_amdgcn_sched_barrier(0);
            if (FULL) {
                const float (&w)[4][2] = cwq;
                const unsigned (&raw)[19] = rawq;
#pragma unroll
                for (int s = 0; s < 16; ++s) { float x0 = 0.f, x1 = 0.f;
#pragma unroll
                    for (int q = 0; q < 4; ++q) { x0 += w[q][0] * bflo(raw[s + q]); x1 += w[q][1] * bfhi(raw[s + q]); }
                    *(LAS unsigned*)(lds + L_QS + (s0 + s) * 528 + d0 * 2) = cvtpk(fsilu(x0), fsilu(x1)); }
            }
        }
        __syncthreads();
        if (FULL) {
            {
                const int tr = wave >> 1, tc0 = 2 * (wave & 1), fr = lane & 15, fq = lane >> 4;
                f32x4 s0 = {0.f, 0.f, 0.f, 0.f}, s1 = {0.f, 0.f, 0.f, 0.f};
#pragma unroll
                for (int ks = 0; ks < 8; ++ks) {
                    const bf16x8 af = *(const LAS bf16x8*)(lds + L_QS + (16 * tr + fr) * 528 + (32 * ks + 8 * fq) * 2);
                    const bf16x8 b0 = *(const LAS bf16x8*)(lds + L_KS + (16 * tc0 + fr) * 528 + (32 * ks + 8 * fq) * 2);
                    const bf16x8 b1 = *(const LAS bf16x8*)(lds + L_KS + (16 * (tc0 + 1) + fr) * 528 + (32 * ks + 8 * fq) * 2);
                    s0 = __builtin_amdgcn_mfma_f32_16x16x32_bf16(af, b0, s0, 0, 0, 0); s1 = __builtin_amdgcn_mfma_f32_16x16x32_bf16(af, b1, s1, 0, 0, 0);
                }
                const float we0 = WEXP[16 * tc0 + fr], we1 = WEXP[16 * (tc0 + 1) + fr];
#pragma unroll
                for (int r = 0; r < 4; ++r) { const int t = 16 * tr + 4 * fq + r; const float Mt = MT[t];
                    { const int s = 16 * tc0 + fr; const float ex = __expf(fminf(we0 - Mt, 0.f)); const float p = (s <= t) ? s0[r] * ex : 0.f; *(LAS bf16_t*)(lds + L_PS + t * 144 + s * 2) = (bf16_t)cvtpk(p, 0.f); }
                    { const int s = 16 * (tc0 + 1) + fr; const float ex = __expf(fminf(we1 - Mt, 0.f)); const float p = (s <= t) ? s1[r] * ex : 0.f; *(LAS bf16_t*)(lds + L_PS + t * 144 + s * 2) = (bf16_t)cvtpk(p, 0.f); } }
            }
            __syncthreads();
            u32x4 oreg[4];
#pragma unroll
            for (int q = 0; q < 4; ++q) { const int idx = q * 512 + tid, t = idx >> 5, ch = idx & 31; oreg[q] = NT_LD((const u32x4*)(PROJ + (size_t)(r0c + t) * NPROJ + 3072 + h * 256 + ch * 8)); }
            {
                const int t = tid >> 3, p = tid & 7;
                const u32x4 pv = *(const LAS u32x4*)(lds + L_PS + t * 144 + p * 16);
                float sp = (bflo(pv.x) + bfhi(pv.x)) + (bflo(pv.y) + bfhi(pv.y)) + (bflo(pv.z) + bfhi(pv.z)) + (bflo(pv.w) + bfhi(pv.w));
                float qn = 0.f;
#pragma unroll
                for (int q = 0; q < 4; ++q) { const u32x4 qv = *(const LAS u32x4*)(lds + L_QS + t * 528 + (32 * p + 8 * q) * 2); const LAS float* np = nsv + 32 * p + 8 * q;
                    qn += bflo(qv.x) * np[0] + bfhi(qv.x) * np[1] + bflo(qv.y) * np[2] + bfhi(qv.y) * np[3] + bflo(qv.z) * np[4] + bfhi(qv.z) * np[5] + bflo(qv.w) * np[6] + bfhi(qv.w) * np[7]; }
                sp += __shfl_xor(sp, 1); sp += __shfl_xor(sp, 2); sp += __shfl_xor(sp, 4);
                qn += __shfl_xor(qn, 1); qn += __shfl_xor(qn, 2); qn += __shfl_xor(qn, 4);
                if (p == 0) { const float den = sp + EI[t] * qn; RDN[t] = frcp(fmaxf(fabsf(den), __expf(-(BT[t] + MT[t])))); }
            }
            f32x16 nacc[2];
#pragma unroll
            for (int tt = 0; tt < 2; ++tt)
#pragma unroll
                for (int r = 0; r < 16; ++r) nacc[tt][r] = 0.f;
#pragma unroll
            for (int dt = 0; dt < 8; ++dt)
#pragma unroll
                for (int sp = 0; sp < 2; ++sp) {
                    __builtin_amdgcn_sched_barrier(0);
                    bf16x8 bfr; { u32x4 t4; t4.x = cvtpk(C[dt][8 * sp + 0], C[dt][8 * sp + 1]); t4.y = cvtpk(C[dt][8 * sp + 2], C[dt][8 * sp + 3]); t4.z = cvtpk(C[dt][8 * sp + 4], C[dt][8 * sp + 5]); t4.w = cvtpk(C[dt][8 * sp + 6], C[dt][8 * sp + 7]); bfr = __builtin_bit_cast(bf16x8, t4); }
#pragma unroll
                    for (int tt = 0; tt < 2; ++tt) {
                        const u32x2 lo = *(const LAS u32x2*)(lds + L_QS + (32 * tt + l31) * 528 + (32 * dt + 16 * sp + 4 * hh) * 2);
                        const u32x2 hi = *(const LAS u32x2*)(lds + L_QS + (32 * tt + l31) * 528 + (32 * dt + 16 * sp + 8 + 4 * hh) * 2);
                        const u32x4 a4 = {lo.x, lo.y, hi.x, hi.y};
                        nacc[tt] = __builtin_amdgcn_mfma_f32_32x32x16_bf16(__builtin_bit_cast(bf16x8, a4), bfr, nacc[tt], 0, 0, 0);
                    }
                }
#pragma unroll
            for (int tt = 0; tt < 2; ++tt)
#pragma unroll
                for (int r = 0; r < 16; ++r) nacc[tt][r] *= EI[32 * tt + (r & 3) + 8 * (r >> 2) + 4 * hh];
#pragma unroll
            for (int ks = 0; ks < 4; ++ks) {
                __builtin_amdgcn_sched_barrier(0);
                const bf16x8 bfr = *(const LAS bf16x8*)(lds + L_VT + (32 * wave + l31) * 144 + (16 * ks + 8 * hh) * 2);
#pragma unroll
                for (int tt = 0; tt < 2; ++tt) { const bf16x8 afr = *(const LAS bf16x8*)(lds + L_PS + (32 * tt + l31) * 144 + (16 * ks + 8 * hh) * 2);
                    nacc[tt] = __builtin_amdgcn_mfma_f32_32x32x16_bf16(afr, bfr, nacc[tt], 0, 0, 0); }
            }
#pragma unroll
            for (int q = 0; q < 4; ++q) { const int idx = q * 512 + tid, t = idx >> 5, ch = idx & 31; *(LAS u32x4*)(lds + L_KS + t * 528 + ch * 16) = oreg[q]; }
            __syncthreads();
#pragma unroll
            for (int tt = 0; tt < 2; ++tt)
#pragma unroll
                for (int r = 0; r < 16; ++r) { const int t = 32 * tt + (r & 3) + 8 * (r >> 2) + 4 * hh; const float hv = nacc[tt][r] * RDN[t]; nacc[tt][r] = hv;
                    const float q = half_sum31(hv * hv);
                    if (l31 == 31) RSS[wave * 64 + t] = q; }
            __syncthreads();
            if (tid < 64) { float q = 0.f;
#pragma unroll
                for (int w = 0; w < 8; ++w) q += RSS[w * 64 + tid];
                RN[tid] = rsqrtf(q * (1.f / 256.f) + EPS); }
            __syncthreads();
            {
                const int e = 32 * wave + l31; const float g = a.in[I_MHG][h * 256 + e];
#pragma unroll
                for (int tt = 0; tt < 2; ++tt)
#pragma unroll
                    for (int r = 0; r < 16; ++r) { const int t = 32 * tt + (r & 3) + 8 * (r >> 2) + 4 * hh;
                        const float o = bf1(*(const LAS bf16_t*)(lds + L_KS + t * 528 + e * 2));
                        *(LAS bf16_t*)(lds + L_QS + t * 528 + e * 2) = (bf16_t)cvtpk(nacc[tt][r] * RN[t] * g * fsigmoid(o), 0.f); }
            }
            __syncthreads();
            {
                bf16_t* ymr = (bf16_t*)(ws + WS_HN);
#pragma unroll
                for (int q = 0; q < 4; ++q) { const int idx = q * 512 + tid, t = idx >> 5, ch = idx & 31;
                    *(u32x4*)(ymr + (size_t)(r0c + t) * DM + h * 256 + ch * 8) = *(const LAS u32x4*)(lds + L_QS + t * 528 + ch * 16); }
            }
        }
#pragma unroll
        for (int dt = 0; dt < 8; ++dt)
#pragma unroll
            for (int r = 0; r < 16; ++r) C[dt][r] *= decay;
#pragma unroll
        for (int ks = 0; ks < 4; ++ks) {
            __builtin_amdgcn_sched_barrier(0);
            const bf16x8 bfr = *(const LAS bf16x8*)(lds + L_VT + (32 * wave + l31) * 144 + (16 * ks + 8 * hh) * 2);
#pragma unroll
            for (int dt = 0; dt < 8; ++dt) { const bf16x8 afr = *(const LAS bf16x8*)(lds + L_KWT + (32 * dt + l31) * 144 + (16 * ks + 8 * hh) * 2);
                C[dt] = __builtin_amdgcn_mfma_f32_32x32x16_bf16(afr, bfr, C[dt], 0, 0, 0); }
        }
        if (tid < 256) { float sk = 0.f;
#pragma unroll
            for (int q = 0; q < 8; ++q) { const u32x4 kv = *(const LAS u32x4*)(lds + L_KWT + tid * 144 + q * 16); sk += (bflo(kv.x) + bfhi(kv.x)) + (bflo(kv.y) + bfhi(kv.y)) + (bflo(kv.z) + bfhi(kv.z)) + (bflo(kv.w) + bfhi(kv.w)); }
            nsv[tid] = decay * nsv[tid] + sk; }
        __syncthreads();
    }
    if (!FULL) {
        bf16_t* st = (bf16_t*)(ws + WS_LST) + (size_t)unit * 65536;
#pragma unroll
        for (int dt = 0; dt < 8; ++dt)
#pragma unroll
            for (int q = 0; q < 4; ++q) *(u32x2*)(st + ((dt * 4 + q) * 512 + tid) * 4) = (u32x2){cvtpk(C[dt][4 * q], C[dt][4 * q + 1]), cvtpk(C[dt][4 * q + 2], C[dt][4 * q + 3])};
        if (tid < 256) ((float*)(ws + WS_LNS))[(size_t)unit * 256 + tid] = nsv[tid];
        if (tid == 0) ((float*)(ws + WS_DTOT))[unit] = __expf(dtot_log);
    }
}

constexpr int L_XS = 0, L_SEG = 69632, L_WL = L_SEG + 16384;
static_assert(L_WL + 2 * 128 * 272 <= L_CTL, "lru LDS map");
__device__ __forceinline__ void lru_unit(const Args& a, LAS unsigned char* lds, int b, int j, int n, bool load_w) {
    int tid_o = threadIdx.x; asm volatile("" : "+v"(tid_o));
    const int tid = tid_o, lane = tid & 63, wave = __builtin_amdgcn_readfirstlane(tid >> 6), hh = lane >> 5, l31 = lane & 31;
    unsigned char* ws = a.ws;
    const bf16_t* PROJ = (const bf16_t*)(ws + WS_PROJ);
    const int r0 = b * SEQ + j * 256, c0 = n * 128;
    const int unit = (b * 32 + j) * 8 + n;
    LAS float* SEG = (LAS float*)(lds + L_SEG);
    __syncthreads();
    if (load_w) {
        const bf16_t* WL = (const bf16_t*)(ws + WS_WLRU) + (size_t)n * 2 * 128 * 128;
#pragma unroll
        for (int q = 0; q < 8; ++q) { const int idx = q * 512 + tid, row = idx >> 4, ch = idx & 15;
            *(LAS u32x4*)(lds + L_WL + row * 272 + ch * 16) = *(const u32x4*)(WL + (size_t)row * 128 + ch * 8); }
    }
    {
        const int cp = tid & 63, tg = tid >> 6, c = 2 * cp, s0 = 32 * tg;
        const float* cw = a.in[I_LCW]; const float* cb = a.in[I_LCB];
        float w[4][2];
#pragma unroll
        for (int q = 0; q < 4; ++q) { w[q][0] = cw[q * 1024 + c0 + c]; w[q][1] = cw[q * 1024 + c0 + c + 1]; }
        const float b0 = cb[c0 + c], b1 = cb[c0 + c + 1];
        unsigned raw[35];
#pragma unroll
        for (int q = 0; q < 35; ++q) { const int ti = j * 256 + s0 - 3 + q; raw[q] = ti >= 0 ? NT_LD((const unsigned*)(PROJ + (size_t)(r0 + s0 - 3 + q) * NPROJ + 4096 + c0 + c)) : 0u; }
#pragma unroll
        for (int s = 0; s < 32; ++s) { float x0 = b0, x1 = b1;
#pragma unroll
            for (int q = 0; q < 4; ++q) { x0 += w[q][0] * bflo(raw[s + q]); x1 += w[q][1] * bfhi(raw[s + q]); }
            *(LAS unsigned*)(lds + L_XS + (s0 + s) * 272 + c * 2) = cvtpk(x0, x1); }
    }
    __syncthreads();
    float gba[4], gbx[4], glam[4];
#pragma unroll
    for (int nt = 0; nt < 4; ++nt) { const int c = c0 + 32 * nt + l31; gba[nt] = a.in[I_BLA][c]; gbx[nt] = a.in[I_BLX][c]; glam[nt] = a.in[I_LAM][c]; }
    f32x16 ar[4], ai[4];
#pragma unroll
    for (int nt = 0; nt < 4; ++nt)
#pragma unroll
        for (int r = 0; r < 16; ++r) { ar[nt][r] = 0.f; ai[nt][r] = 0.f; }
    {
        const int tau = 16 * ((l31 >> 2) & 1) + 4 * (l31 >> 3) + (l31 & 3);
#pragma unroll
        for (int ks = 0; ks < 8; ++ks) {
            const bf16x8 afr = *(const LAS bf16x8*)(lds + L_XS + (32 * wave + tau) * 272 + (16 * ks + 8 * hh) * 2);
#pragma unroll
            for (int nt = 0; nt < 4; ++nt) {
                const bf16x8 br = *(const LAS bf16x8*)(lds + L_WL + (32 * nt + l31) * 272 + (16 * ks + 8 * hh) * 2);
                const bf16x8 bi = *(const LAS bf16x8*)(lds + L_WL + (128 + 32 * nt + l31) * 272 + (16 * ks + 8 * hh) * 2);
                ar[nt] = __builtin_amdgcn_mfma_f32_32x32x16_bf16(afr, br, ar[nt], 0, 0, 0); ai[nt] = __builtin_amdgcn_mfma_f32_32x32x16_bf16(afr, bi, ai[nt], 0, 0, 0);
            }
        }
    }
#pragma unroll
    for (int nt = 0; nt < 4; ++nt) {
        __builtin_amdgcn_sched_barrier(0);
        const int d = 32 * nt + l31;
        const float ba = gba[nt], bx = gbx[nt], lsl = flogsigmoid(glam[nt]);
        float A = 1.f, H = 0.f;
#pragma unroll
        for (int r = 0; r < 16; ++r) {
            const int t = 32 * wave + 16 * hh + r;
            const float rg = fsigmoid(ar[nt][r] + ba), ig = fsigmoid(ai[nt][r] + bx);
            const float la = 8.f * rg * lsl; const float av = __expf(la);
            const float xr = bf1(*(const LAS bf16_t*)(lds + L_XS + t * 272 + d * 2));
            const float x2 = 2.f * la; const float om = (x2 > -0.02f) ? -x2 * (1.f + x2 * (0.5f + x2 * (1.f / 6.f))) : 1.f - __expf(x2);
            const float u = __builtin_amdgcn_sqrtf(om) * (ig * xr);
            ar[nt][r] = av; ai[nt][r] = u;
            A *= av; H = av * H + u;
        }
        SEG[((2 * wave + hh) * 128 + d) * 2] = A; SEG[((2 * wave + hh) * 128 + d) * 2 + 1] = H;
    }
    __syncthreads();
    if (tid < 128) {
        float hc = 0.f, At = 1.f;
#pragma unroll
        for (int sg = 0; sg < 16; ++sg) { const float A = SEG[(sg * 128 + tid) * 2], H = SEG[(sg * 128 + tid) * 2 + 1]; SEG[(sg * 128 + tid) * 2] = hc; SEG[(sg * 128 + tid) * 2 + 1] = At; hc = A * hc + H; At *= A; }
        ((float*)(ws + WS_LRUA))[(size_t)unit * 128 + tid] = At; ((float*)(ws + WS_LRUH))[(size_t)unit * 128 + tid] = hc;
    }
    __syncthreads();
#pragma unroll 1
    for (int round = 0; round < 2; ++round) {
#pragma unroll
        for (int nt = 0; nt < 4; ++nt) { const int d = 32 * nt + l31;
            float v = SEG[((2 * wave + hh) * 128 + d) * 2 + round];
#pragma unroll
            for (int r = 0; r < 16; ++r) { const int t = 32 * wave + 16 * hh + r;
                v = round ? v * ar[nt][r] : ar[nt][r] * v + ai[nt][r];
                *(LAS bf16_t*)(lds + L_XS + t * 272 + d * 2) = (bf16_t)cvtpk(v, 0.f); } }
        __syncthreads();
        bf16_t* dstb = (bf16_t*)(ws + (round ? WS_ACUM : WS_HLOC));
#pragma unroll
        for (int q = 0; q < 8; ++q) { const int idx = q * 512 + tid, t = idx >> 4, ch = idx & 15;
            *(u32x4*)(dstb + (size_t)(r0 + t) * 1024 + c0 + ch * 8) = *(const LAS u32x4*)(lds + L_XS + t * 272 + ch * 16); }
        __syncthreads();
    }
}
__device__ __forceinline__ void lru_out_unit(const Args& a, int b, int j, int n) {
    int tid_o = threadIdx.x; asm volatile("" : "+v"(tid_o));
    const int tid = tid_o, d8 = tid & 15;
    unsigned char* ws = a.ws;
    const bf16_t* PROJ = (const bf16_t*)(ws + WS_PROJ); const bf16_t* HL = (const bf16_t*)(ws + WS_HLOC); const bf16_t* AC = (const bf16_t*)(ws + WS_ACUM);
    const int r0 = b * SEQ + j * 256, c0 = n * 128 + 8 * d8;
    const float* cp = (const float*)(ws + WS_LRUC) + (size_t)(b * 32 + j) * 1024 + c0; const float* gp = a.in[I_LNG] + c0;
    const f32x4 ca = *(const f32x4*)cp, cb = *(const f32x4*)(cp + 4), ga = *(const f32x4*)gp, gb = *(const f32x4*)(gp + 4);
    u32x4 hl[8], ac[8], gr[8];
#pragma unroll
    for (int q = 0; q < 8; ++q) { const size_t t = (size_t)(r0 + (tid >> 4) + 32 * q);
        hl[q] = NT_LD((const u32x4*)(HL + t * 1024 + c0)); ac[q] = NT_LD((const u32x4*)(AC + t * 1024 + c0)); gr[q] = NT_LD((const u32x4*)(PROJ + t * NPROJ + 5120 + c0)); }
    bf16_t* ymr = (bf16_t*)(ws + WS_HN);
#pragma unroll
    for (int q = 0; q < 8; ++q) { const size_t t = (size_t)(r0 + (tid >> 4) + 32 * q);
        f32x4 ya = (f32x4){bflo(hl[q].x), bfhi(hl[q].x), bflo(hl[q].y), bfhi(hl[q].y)} + (f32x4){bflo(ac[q].x), bfhi(ac[q].x), bflo(ac[q].y), bfhi(ac[q].y)} * ca;
        f32x4 yb = (f32x4){bflo(hl[q].z), bfhi(hl[q].z), bflo(hl[q].w), bfhi(hl[q].w)} + (f32x4){bflo(ac[q].z), bfhi(ac[q].z), bflo(ac[q].w), bfhi(ac[q].w)} * cb;
        ya = ya * (f32x4){fgelu_tanh(bflo(gr[q].x)), fgelu_tanh(bfhi(gr[q].x)), fgelu_tanh(bflo(gr[q].y)), fgelu_tanh(bfhi(gr[q].y))};
        yb = yb * (f32x4){fgelu_tanh(bflo(gr[q].z)), fgelu_tanh(bfhi(gr[q].z)), fgelu_tanh(bflo(gr[q].w)), fgelu_tanh(bfhi(gr[q].w))};
        float ss = (ya.x * ya.x + ya.y * ya.y) + (ya.z * ya.z + ya.w * ya.w) + (yb.x * yb.x + yb.y * yb.y) + (yb.z * yb.z + yb.w * yb.w);
        ss += __shfl_xor(ss, 1); ss += __shfl_xor(ss, 2); ss += __shfl_xor(ss, 4); ss += __shfl_xor(ss, 8);
        const float rn = rsqrtf(ss * (1.f / 128.f) + EPS);
        ya = ya * rn * ga; yb = yb * rn * gb;
        *(u32x4*)(ymr + t * DM + 1024 + c0) = (u32x4){cvtpk(ya.x, ya.y), cvtpk(ya.z, ya.w), cvtpk(yb.x, yb.y), cvtpk(yb.z, yb.w)}; }
}

__device__ __forceinline__ void mixer_scan(const Args& a, int vcu, int G) {
    unsigned char* ws = a.ws; int tid_o = threadIdx.x; asm volatile("" : "+v"(tid_o)); const int tid = tid_o;
    const float* DT = (const float*)(ws + WS_DTOT);
    if (tid < 256) for (int g = vcu * 256 + tid; g < 65536; g += G * 256) {
        const int bh = g >> 13, i8 = g & 8191; bf16_t* base = (bf16_t*)(ws + WS_LST) + (size_t)bh * 32 * 65536 + (size_t)i8 * 8;
        f32x4 Sa = {0.f, 0.f, 0.f, 0.f}, Sb = {0.f, 0.f, 0.f, 0.f}; u32x4 Lr[31];
#pragma unroll
        for (int j = 0; j < 31; ++j) Lr[j] = NT_LD((const u32x4*)(base + (size_t)j * 65536));
#pragma unroll
        for (int j = 0; j < 31; ++j) { const float d = DT[bh * 32 + j]; const u32x4 L = Lr[j];
            Sa = d * Sa + (f32x4){bflo(L.x), bfhi(L.x), bflo(L.y), bfhi(L.y)}; Sb = d * Sb + (f32x4){bflo(L.z), bfhi(L.z), bflo(L.w), bfhi(L.w)};
            *(u32x4*)(base + (size_t)j * 65536) = (u32x4){cvtpk(Sa.x, Sa.y), cvtpk(Sa.z, Sa.w), cvtpk(Sb.x, Sb.y), cvtpk(Sb.z, Sb.w)}; }
    }
    if (tid >= 264 && tid < 266) for (int g = vcu * 2 + (tid - 264); g < 8 * 64; g += G * 2) {
        const int bh = g >> 6, i4 = g & 63; float* base = (float*)(ws + WS_LNS) + (size_t)bh * 32 * 256 + (size_t)i4 * 4;
        f32x4 S = {0.f, 0.f, 0.f, 0.f};
#pragma unroll 8
        for (int j = 0; j < 31; ++j) { const f32x4 L = *(const f32x4*)(base + (size_t)j * 256); S = DT[bh * 32 + j] * S + L; *(f32x4*)(base + (size_t)j * 256) = S; }
    }
    if (tid >= 256 && tid < 264) for (int g = vcu * 8 + (tid - 256); g < 2048; g += G * 8) {
        const int b = g >> 10, ch = g & 1023, n = ch >> 7, d = ch & 127; float hc = 0.f;
        const float* LA = (const float*)(ws + WS_LRUA); const float* LH = (const float*)(ws + WS_LRUH); float* LC = (float*)(ws + WS_LRUC);
#pragma unroll 8
        for (int j = 0; j < 32; ++j) { const size_t u = (size_t)((b * 32 + j) * 8 + n) * 128 + d; LC[(size_t)(b * 32 + j) * 1024 + ch] = hc; hc = LA[u] * hc + LH[u]; }
    }
}

__device__ __forceinline__ void p5_hn2_route(const Args& a, LAS unsigned char* lds, int vcu, int G) {
    int tid_o = threadIdx.x; asm volatile("" : "+v"(tid_o));
    const int tid = tid_o, lane = tid & 63, wave = __builtin_amdgcn_readfirstlane(tid >> 6), fr = lane & 15, kq = lane >> 4;
    unsigned char* ws = a.ws;
    LAS float* part = (LAS float*)lds;
    LAS float* rstds = (LAS float*)(lds + 49152);
    LAS float* lgs = (LAS float*)(lds + 49152 + 128);
    const float* mod = (const float*)(ws + WS_MOD); const float* cvec = (const float*)(ws + WS_CVEC);
    const bf16_t* WRH = (const bf16_t*)(ws + WS_WRH); const bf16_t* WRL = (const bf16_t*)(ws + WS_WRL);
    int* cnt = (int*)(ws + WS_CTL); int* list = (int*)(ws + WS_LIST); float* route = (float*)(ws + WS_ROUTE);
    for (int task = vcu; task < T / 32; task += G) {
        int lane_o = tid_o & 63; asm volatile("" : "+v"(lane_o));
        const int lane = lane_o, fr = lane & 15, kq = lane >> 4;
        const int row0 = task * 32, b = row0 / SEQ;
        const float* sh2 = mod + (size_t)b * 12288 + 6144; const float* sc2 = mod + (size_t)b * 12288 + 8192;
        __syncthreads();
        const bf16_t* X1 = (const bf16_t*)(ws + WS_X1B);
        f32x4 acc[2][3];
#pragma unroll
        for (int rt = 0; rt < 2; ++rt)
#pragma unroll
            for (int nt = 0; nt < 3; ++nt) acc[rt][nt] = (f32x4){0.f, 0.f, 0.f, 0.f};
        {
            u32x4 xb[8][2];
#pragma unroll
            for (int st = 0; st < 8; ++st)
#pragma unroll
                for (int rt = 0; rt < 2; ++rt) xb[st][rt] = *(const u32x4*)(X1 + (size_t)(row0 + 16 * rt + fr) * DM + 256 * wave + 32 * st + 8 * kq);
            bf16x8 Bhs[2][3], Bls[2][3]; f32x4 s0s[2], s1s[2];
#define RT_LOADB(set, stp) do { const int c0_ = 256 * wave + 32 * (stp) + 8 * kq; s0s[set] = *(const f32x4*)(sc2 + c0_); s1s[set] = *(const f32x4*)(sc2 + c0_ + 4); \
                _Pragma("unroll") for (int nt = 0; nt < 3; ++nt) { Bhs[set][nt] = *(const bf16x8*)(WRH + (size_t)(16 * nt + fr) * 2048 + c0_); Bls[set][nt] = *(const bf16x8*)(WRL + (size_t)(16 * nt + fr) * 2048 + c0_); } } while (0)
            RT_LOADB(0, 0);
#pragma unroll
            for (int st = 0; st < 8; ++st) {
                __builtin_amdgcn_sched_barrier(0);
                if (st < 7) RT_LOADB((st + 1) & 1, st + 1);
                const f32x4 s0 = s0s[st & 1] + 1.f, s1 = s1s[st & 1] + 1.f;
                bf16x8 Ah[2], Al[2];
#pragma unroll
                for (int rt = 0; rt < 2; ++rt) {
                    const u32x4 r4 = xb[st][rt];
                    const f32x4 x0 = (f32x4){bflo(r4.x), bfhi(r4.x), bflo(r4.y), bfhi(r4.y)} * s0, x1 = (f32x4){bflo(r4.z), bfhi(r4.z), bflo(r4.w), bfhi(r4.w)} * s1;
                    u32x4 h; h.x = cvtpk(x0.x, x0.y); h.y = cvtpk(x0.z, x0.w); h.z = cvtpk(x1.x, x1.y); h.w = cvtpk(x1.z, x1.w);
                    u32x4 l; l.x = cvtpk(x0.x - bflo(h.x), x0.y - bfhi(h.x)); l.y = cvtpk(x0.z - bflo(h.y), x0.w - bfhi(h.y)); l.z = cvtpk(x1.x - bflo(h.z), x1.y - bfhi(h.z)); l.w = cvtpk(x1.z - bflo(h.w), x1.w - bfhi(h.w));
                    Ah[rt] = __builtin_bit_cast(bf16x8, h); Al[rt] = __builtin_bit_cast(bf16x8, l);
                }
#pragma unroll
                for (int nt = 0; nt < 3; ++nt) {
                    const bf16x8 Bh = Bhs[st & 1][nt], Bl = Bls[st & 1][nt];
#pragma unroll
                    for (int rt = 0; rt < 2; ++rt) {
                        acc[rt][nt] = __builtin_amdgcn_mfma_f32_16x16x32_bf16(Ah[rt], Bh, acc[rt][nt], 0, 0, 0);
                        acc[rt][nt] = __builtin_amdgcn_mfma_f32_16x16x32_bf16(Al[rt], Bh, acc[rt][nt], 0, 0, 0);
                        acc[rt][nt] = __builtin_amdgcn_mfma_f32_16x16x32_bf16(Ah[rt], Bl, acc[rt][nt], 0, 0, 0);
                    }
                }
            }
        }
#undef RT_LOADB
        __builtin_amdgcn_sched_barrier(0);
        {
            u32x4 v[4][4]; float rs[4];
#pragma unroll
            for (int r = 0; r < 4; ++r)
#pragma unroll
                for (int jj = 0; jj < 4; ++jj) v[r][jj] = NT_LD((const u32x4*)(X1 + (size_t)(row0 + wave * 4 + r) * DM + 8 * lane + 512 * jj));
#pragma unroll
            for (int r = 0; r < 4; ++r) { float ssum = 0.f;
#pragma unroll
                for (int jj = 0; jj < 4; ++jj) { const u32x4 q = v[r][jj]; const float a0 = bflo(q.x), a1 = bfhi(q.x), a2 = bflo(q.y), a3 = bfhi(q.y), a4 = bflo(q.z), a5 = bfhi(q.z), a6 = bflo(q.w), a7 = bfhi(q.w);
                    ssum += ((a0 * a0 + a1 * a1) + (a2 * a2 + a3 * a3)) + ((a4 * a4 + a5 * a5) + (a6 * a6 + a7 * a7)); }
                rs[r] = rsqrtf(wave_sum(ssum) * (1.f / DM) + EPS); if (lane == 0) rstds[wave * 4 + r] = rs[r]; }
#pragma unroll
            for (int jj = 0; jj < 4; ++jj) { __builtin_amdgcn_sched_barrier(0);
                const f32x4 sha = *(const f32x4*)(sh2 + 8 * lane + 512 * jj), shb = *(const f32x4*)(sh2 + 8 * lane + 512 * jj + 4);
                const f32x4 sca = *(const f32x4*)(sc2 + 8 * lane + 512 * jj) + 1.f, scb = *(const f32x4*)(sc2 + 8 * lane + 512 * jj + 4) + 1.f;
#pragma unroll
                for (int r = 0; r < 4; ++r) { const u32x4 q = v[r][jj];
                    const f32x4 ha = (f32x4){bflo(q.x), bfhi(q.x), bflo(q.y), bfhi(q.y)} * rs[r] * sca + sha, hb = (f32x4){bflo(q.z), bfhi(q.z), bflo(q.w), bfhi(q.w)} * rs[r] * scb + shb;
                    *(u32x4*)((bf16_t*)(ws + WS_HN) + (size_t)(row0 + wave * 4 + r) * DM + 8 * lane + 512 * jj) = (u32x4){cvtpk(ha.x, ha.y), cvtpk(ha.z, ha.w), cvtpk(hb.x, hb.y), cvtpk(hb.z, hb.w)}; } }
        }
#pragma unroll
        for (int rt = 0; rt < 2; ++rt)
#pragma unroll
            for (int nt = 0; nt < 3; ++nt)
#pragma unroll
                for (int r = 0; r < 4; ++r) part[(wave * 32 + 16 * rt + 4 * kq + r) * 48 + 16 * nt + fr] = acc[rt][nt][r];
        __syncthreads();
        for (int idx = tid; idx < 32 * 36; idx += 512) { const int r = idx / 36, n = idx % 36; float q = 0.f;
#pragma unroll
            for (int w = 0; w < 8; ++w) q += part[(w * 32 + r) * 48 + n];
            lgs[r * 40 + n] = rstds[r] * q + cvec[b * 48 + n]; }
        __syncthreads();
        if (tid < 32) {
            const int t = row0 + tid; const LAS float* lg = lgs + tid * 40;
            int g = 0; float mx = lg[0];
#pragma unroll
            for (int i = 1; i < 4; ++i) { const float x = lg[i]; if (x > mx) { mx = x; g = i; } }
            float sg = 0.f;
#pragma unroll
            for (int i = 0; i < 4; ++i) sg += __expf(lg[i] - mx);
            const float pg = 1.f / sg;
            int e0 = 0; float m0 = lg[4 + g * 8];
            for (int i = 1; i < 8; ++i) { const float x = lg[4 + g * 8 + i]; if (x > m0) { m0 = x; e0 = i; } }
            int e1 = -1; float m1 = -INFINITY;
            for (int i = 0; i < 8; ++i) { const float x = lg[4 + g * 8 + i]; if (i != e0 && x > m1) { m1 = x; e1 = i; } }
            const float x1 = __expf(m1 - m0); const float w0 = pg / (1.f + x1), w1 = pg * x1 / (1.f + x1);
            const int E0 = g * 8 + e0, E1 = g * 8 + e1;
            *(f32x4*)(route + (size_t)t * 4) = (f32x4){w0, w1, (float)E0, (float)E1};
            LAS int* lcnt = (LAS int*)(lds + 49152 + 128 + 5120); LAS int* lbase = lcnt + 32;
            lcnt[tid] = 0;
            LDS_WAIT(); asm volatile("" ::: "memory");
            const int rk0 = __hip_atomic_fetch_add(lcnt + E0, 1, __ATOMIC_RELAXED, __HIP_MEMORY_SCOPE_WORKGROUP);
            const int rk1 = __hip_atomic_fetch_add(lcnt + E1, 1, __ATOMIC_RELAXED, __HIP_MEMORY_SCOPE_WORKGROUP);
            LDS_WAIT(); asm volatile("" ::: "memory");
            const int lc = lcnt[tid];
            lbase[tid] = lc ? atomicAdd(&cnt[tid], lc) : 0;
            LDS_WAIT(); asm volatile("" ::: "memory");
            float* listw = (float*)(ws + WS_LISTW);
            { const size_t p0 = (size_t)E0 * T + lbase[E0] + rk0, p1 = (size_t)E1 * T + lbase[E1] + rk1;
              list[p0] = t * 2; listw[p0] = w0; list[p1] = t * 2 + 1; listw[p1] = w1; }
        }
    }
}

__device__ __forceinline__ void p9_final(const Args& a, int vcu, int G, float* dstbase) {
    int tid_o = threadIdx.x; asm volatile("" : "+v"(tid_o));
    const int tid = tid_o, lane = tid & 63, wave = __builtin_amdgcn_readfirstlane(tid >> 6);
    unsigned char* ws = a.ws; const float* mod = (const float*)(ws + WS_MOD); const bf16_t* YS = (const bf16_t*)(ws + WS_YS);
    const bf16_t* X1 = (const bf16_t*)(ws + WS_X1B);
    for (int rp = vcu * 8 + wave; rp < T / 2; rp += G * 8) {
        const int b = (2 * rp) / SEQ; const float* g2 = mod + (size_t)b * 12288 + 10240;
        u32x4 y0[2][4], y1[2][4];
#pragma unroll
        for (int q = 0; q < 2; ++q)
#pragma unroll
            for (int jj = 0; jj < 4; ++jj) { const int row = 2 * rp + q; y0[q][jj] = NT_LD((const u32x4*)(YS + (size_t)(2 * row) * DM + 8 * lane + 512 * jj)); y1[q][jj] = NT_LD((const u32x4*)(YS + (size_t)(2 * row + 1) * DM + 8 * lane + 512 * jj)); }
#pragma unroll
        for (int q = 0; q < 2; ++q) {
            const int row = 2 * rp + q; f32x4 v[4][2]; float s = 0.f;
#pragma unroll
            for (int jj = 0; jj < 4; ++jj) { const u32x4 p0 = y0[q][jj], p1 = y1[q][jj];
                v[jj][0] = (f32x4){bflo(p0.x) + bflo(p1.x), bfhi(p0.x) + bfhi(p1.x), bflo(p0.y) + bflo(p1.y), bfhi(p0.y) + bfhi(p1.y)};
                v[jj][1] = (f32x4){bflo(p0.z) + bflo(p1.z), bfhi(p0.z) + bfhi(p1.z), bflo(p0.w) + bflo(p1.w), bfhi(p0.w) + bfhi(p1.w)};
#pragma unroll
                for (int z = 0; z < 2; ++z) s += (v[jj][z].x * v[jj][z].x + v[jj][z].y * v[jj][z].y) + (v[jj][z].z * v[jj][z].z + v[jj][z].w * v[jj][z].w); }
            const float rstd = rsqrtf(wave_sum(s) * (1.f / DM) + EPS);
#pragma unroll
            for (int jj = 0; jj < 4; ++jj) { const f32x4 fa = *(const f32x4*)(a.in[I_FG] + 8 * lane + 512 * jj), fb = *(const f32x4*)(a.in[I_FG] + 8 * lane + 512 * jj + 4);
                float* dr = dstbase + (size_t)row * DM + 8 * lane + 512 * jj; NT_ST(v[jj][0] * rstd * fa, (f32x4*)dr); NT_ST(v[jj][1] * rstd * fb, (f32x4*)(dr + 4)); }
        }
    }
}
}
namespace fk {
#define XB_TMO      128
#define XB_XCNT(j)  (256  + 64 * (j))
#define XB_XSUB(j)  (1280 + 64 * (j))
#define XB_XGEN(j)  (2304 + 64 * (j))
#define XB_TOP      3328
#define XB_TOPGEN   3392
#define XCD_BAR_WORDS 3456
#define XB_SPIN_CAP (1u << 18)

__device__ __forceinline__ unsigned xb_ld(unsigned* p)              { return __hip_atomic_load(p, __ATOMIC_RELAXED, __HIP_MEMORY_SCOPE_AGENT); }
__device__ __forceinline__ unsigned xb_add(unsigned* p, unsigned v) { return __hip_atomic_fetch_add(p, v, __ATOMIC_RELAXED, __HIP_MEMORY_SCOPE_AGENT); }
__device__ __forceinline__ unsigned xb_xcc_id() { return (unsigned)__builtin_amdgcn_s_getreg((3 << 11) | 20) & 0xFu; }
#define XB_SPIN(cond, bar) do { unsigned _sp = 0; while (cond) { __builtin_amdgcn_s_sleep(1); \
    if ((++_sp & 255u) == 0u) { if (xb_ld(&(bar)[XB_TMO])) break; if (_sp > XB_SPIN_CAP) { atomicAdd(&(bar)[XB_TMO], 1u); break; } } } } while (0)

struct XcdBarrier {
    unsigned* bar; unsigned x;
    volatile LAS unsigned* st;
};

__device__ __forceinline__ XcdBarrier xcd_barrier_post(unsigned* bar, volatile LAS unsigned* st) {
    XcdBarrier b; b.bar = bar; b.x = xb_xcc_id(); b.st = st;
    if (threadIdx.x == 0) (void)xb_add(&bar[XB_XCNT(b.x)], 1u);
    return b;
}
__device__ __forceinline__ void xcd_barrier_complete(unsigned* bar, unsigned x, unsigned& nloc, unsigned& nx) {
    const unsigned G = gridDim.x * gridDim.y * gridDim.z;
    unsigned sum, cnt, mine, sp = 0u;
    for (;;) {
        sum = 0u; cnt = 0u; mine = 0u;
#pragma unroll
        for (unsigned j = 0; j < 16; ++j) { const unsigned c = xb_ld(&bar[XB_XCNT(j)]); sum += c; cnt += (c > 0u) ? 1u : 0u; mine = (j == x) ? c : mine; }
        if (sum == G) break;
        __builtin_amdgcn_s_sleep(1);
        if ((++sp & 255u) == 0u) { if (xb_ld(&bar[XB_TMO])) break; if (sp > XB_SPIN_CAP) { atomicAdd(&bar[XB_TMO], 1u); break; } }
    }
    nloc = mine > 0u ? mine : 1u; nx = cnt > 0u ? cnt : 1u;
}

__device__ __forceinline__ void xcd_barrier(const XcdBarrier& b) {
    asm volatile("s_waitcnt vmcnt(0)" ::: "memory");
    __syncthreads();
    if (threadIdx.x == 0) {
        unsigned* bar = b.bar;
        __builtin_amdgcn_s_waitcnt(0);
        unsigned nloc = b.st[0], nx = b.st[1];
        if (nloc == 0u) { xcd_barrier_complete(bar, b.x, nloc, nx); b.st[0] = nloc; b.st[1] = nx; }
        const unsigned old = xb_add(&bar[XB_XSUB(b.x)], 1u);
        const unsigned gen = old / nloc;
        if (old + 1u == (gen + 1u) * nloc) {
            __builtin_amdgcn_fence(__ATOMIC_RELEASE, "agent");
            asm volatile("s_waitcnt vmcnt(0)" ::: "memory");
            const unsigned og = xb_add(&bar[XB_TOP], 1u);
            const unsigned tg = og / nx;
            if (og + 1u == (tg + 1u) * nx) xb_add(&bar[XB_TOPGEN], 1u);
            else XB_SPIN(xb_ld(&bar[XB_TOPGEN]) == tg, bar);
            __builtin_amdgcn_fence(__ATOMIC_ACQUIRE, "agent");
            xb_add(&bar[XB_XGEN(b.x)], 1u);
            asm volatile("s_waitcnt vmcnt(0)" ::: "memory");
        } else {
            XB_SPIN(xb_ld(&bar[XB_XGEN(b.x)]) == gen, bar);
            __builtin_amdgcn_fence(__ATOMIC_ACQUIRE, "agent");
            asm volatile("s_waitcnt vmcnt(0)" ::: "memory");
        }
    }
    __syncthreads();
}
}
namespace fk {
constexpr int NPHASE = 11;
#ifndef NCONV
#define NCONV 36
#endif
__global__ void __launch_bounds__(512, 2) fwd(Args a) {
    extern __shared__ __attribute__((aligned(16))) unsigned char lds_raw[];
    LAS unsigned char* lds = (LAS unsigned char*)lds_raw;
    const int G = gridDim.x, bx = blockIdx.x, tid = threadIdx.x;
    const int vcu = (G % 8 == 0) ? (bx % 8) * (G / 8) + bx / 8 : bx;
    const int lo = a.ph_lo, hi = a.ph_hi;
    unsigned char* ws = a.ws;
    volatile LAS unsigned* bst = (volatile LAS unsigned*)(lds + L_CTL + 512);
    if (tid < 2) bst[tid] = 0u;
    __syncthreads();
    XcdBarrier bar; bar.bar = (unsigned*)(ws + WS_BAR); bar.x = 0; bar.st = bst;
    if (hi - lo > 1) bar = xcd_barrier_post((unsigned*)(ws + WS_BAR), bst);
#ifndef PH_ONLY
#define PH_ONLY -1
#endif
#define IN(k) ((PH_ONLY < 0 || PH_ONLY == (k)) && lo <= (k) && (k) < hi)
#define GSYNC() xcd_barrier(bar)
#define SYNC(k) do { if (IN(k) && IN((k) + 1)) GSYNC(); } while (0)
#ifndef REP_PHASE
#define REP_PHASE -1
#endif
#ifndef REP_SKIPL
#define REP_SKIPL 0
#endif
#define REP(k) _Pragma("unroll 1") for (int rep_ = 0; rep_ < ((REP_PHASE == (k)) ? 2 : 1); ++rep_)
#define RSYNC() do { if (rep_) GSYNC(); } while (0)
    const int nconv = (G == 256 && IN(0) && IN(2)) ? NCONV : 0;
    REP(0) { RSYNC(); if (IN(0)) { p0_prologue(a, lds, vcu, G, nconv); } } SYNC(0);
    REP(1) { RSYNC(); if (IN(1)) { p1_hn_gates(a, lds, vcu, G); } } SYNC(1);
    REP(2) { RSYNC(); if (IN(2)) {
        if (bx < G - nconv) { DenseSched S; S.init(ws + WS_HN, ws + WS_WIN, T, NPROJ, DM, G - nconv, bx); EpiProj E{(bf16_t*)(ws + WS_PROJ), NPROJ}; pg8::gemm_phase<EpiProj, DenseSched>(lds, DM, S, E); }
        else if (!rep_) { p2_convert(a, lds, (bx - (G - nconv)) * 8 + (tid >> 6), nconv * 8);
#ifdef CONV_DUP
            p2_convert(a, lds, (bx - (G - nconv)) * 8 + (tid >> 6), nconv * 8);
#endif
        }
    } } SYNC(2);
    REP(34) { RSYNC(); REP(3) { RSYNC(); if (IN(3)) {
#ifndef NO_MLSTM
                 for (int u = vcu; u < 256; u += G) mlstm_unit<false>(a, lds, u >> 5, u & 31);
#endif
#ifndef NO_LRU
                 if (!(REP_SKIPL && rep_)) for (int u = vcu, pn_ = -1; u < 512; u += G) { lru_unit(a, lds, u >> 8, (u >> 3) & 31, u & 7, (u & 7) != pn_); pn_ = u & 7; }
#endif
    } } SYNC(3);
    if (IN(4)) { mixer_scan(a, vcu, G); } } SYNC(4);
    REP(5) { RSYNC(); if (IN(5)) {
                 if (vcu & 1) { for (int u = vcu; u < 512; u += G) lru_out_unit(a, u >> 8, (u >> 3) & 31, u & 7); }
                 for (int u = vcu; u < 256; u += G) mlstm_unit<true>(a, lds, u >> 5, u & 31);
                 if (!(vcu & 1)) { for (int u = vcu; u < 512; u += G) lru_out_unit(a, u >> 8, (u >> 3) & 31, u & 7); }
    } } SYNC(5);
    REP(6) { RSYNC(); if (IN(6)) { __syncthreads(); DenseSched S; S.init(ws + WS_HN, ws + WS_WOUT, T, DM, DM, G, bx); EpiX1 E{a.in[I_X], (const float*)(ws + WS_MOD), (bf16_t*)(ws + WS_X1B)}; pg8::gemm_phase<EpiX1, DenseSched>(lds, DM, S, E); } } SYNC(6);
    REP(7) { if (rep_) { GSYNC(); if (bx == 0 && tid < 32) ((int*)(ws + WS_CTL))[tid] = 0; GSYNC(); }
        if (IN(7)) { p5_hn2_route(a, lds, vcu, G); } } SYNC(7);
    if (IN(8) || IN(9)) {
        LAS int* tp = (LAS int*)(lds + L_CTL); const int* cnt = (const int*)(ws + WS_CTL);
        __syncthreads();
        for (int i = tid; i < 4096; i += 512) ((LAS float*)(lds + L_G2T))[i] = ((const float*)(ws + WS_MOD))[(size_t)(i >> 11) * 12288 + 10240 + (i & 2047)];
        if (tid == 0) { int s = 0; for (int e = 0; e < 32; ++e) { tp[e] = s; s += (cnt[e] + 255) >> 8; } tp[32] = s; }
        __syncthreads();
        if (tid < 192) { int e = 0; for (int q = 1; q < 32; ++q) e += (tp[q] <= tid) ? 1 : 0; ((LAS unsigned short*)(tp + 160))[tid] = (unsigned short)e; }
        __syncthreads();
    }
    if (IN(8)) { const LAS int* tp = (const LAS int*)(lds + L_CTL); const int nGU = tp[32] * 4, R = nGU / G, rem = nGU - R * G, Ne = G - rem;
        { MoeSched<4, true> S{tp, (const int*)(ws + WS_CTL), (const int*)(ws + WS_LIST), (const char*)(ws + WS_HN), (const char*)(ws + WS_WGU), DM, vcu, G, R * G};
          EpiGateUp E{(bf16_t*)(ws + WS_HEXP)}; pg8::gemm_phase<EpiGateUp, MoeSched<4, true>>(lds, DM, S, E); }
        if (rem > 0) {
            GSYNC();
            if (vcu < rem) { MoeSched<4, true> S{tp, (const int*)(ws + WS_CTL), (const int*)(ws + WS_LIST), (const char*)(ws + WS_HN), (const char*)(ws + WS_WGU), DM, R * G + vcu, G, nGU};
                EpiGateUp E{(bf16_t*)(ws + WS_HEXP)}; pg8::gemm_phase<EpiGateUp, MoeSched<4, true>>(lds, DM, S, E); }
            else if (R >= 1) { MoeSched<8, false> S{tp, (const int*)(ws + WS_CTL), (const int*)(ws + WS_LIST), (const char*)(ws + WS_HEXP), (const char*)(ws + WS_WDN), 512, vcu - rem, Ne, 2 * Ne};
                EpiDown E{(bf16_t*)(ws + WS_YS), (const int*)(ws + WS_CTL), (const int*)(ws + WS_LIST), (const float*)(ws + WS_LISTW), (const bf16_t*)(ws + WS_X1B), (const LAS float*)(lds + L_G2T)}; pg8::gemm_phase<EpiDown, MoeSched<8, false>>(lds, 512, S, E); }
        }
    } SYNC(8);
    if (IN(9)) { const LAS int* tp = (const LAS int*)(lds + L_CTL); const int nGU = tp[32] * 4, R = nGU / G, rem = nGU - R * G, Ne = G - rem;
        MoeSched<8, false> S{tp, (const int*)(ws + WS_CTL), (const int*)(ws + WS_LIST), (const char*)(ws + WS_HEXP), (const char*)(ws + WS_WDN), 512, ((rem > 0 && R >= 1) ? 2 * Ne : 0) + vcu, G, tp[32] * 8};
        EpiDown E{(bf16_t*)(ws + WS_YS), (const int*)(ws + WS_CTL), (const int*)(ws + WS_LIST), (const float*)(ws + WS_LISTW), (const bf16_t*)(ws + WS_X1B), (const LAS float*)(lds + L_G2T)}; pg8::gemm_phase<EpiDown, MoeSched<8, false>>(lds, 512, S, E); } SYNC(9);
#if REP_PHASE == 10
    if (IN(10)) { p9_final(a, vcu, G, (float*)(ws + WS_WGU)); GSYNC(); }
#endif
#if REP_PHASE == 99
    for (int q = 0; q < 20; ++q) GSYNC();
#endif
    if (IN(10)) { p9_final(a, vcu, G, a.out); }
#undef IN
#undef SYNC
}

static int g_grid = 0;
static bool setup() {
    if (g_grid) return g_grid > 0;
    int dev = 0, cus = 0, per_cu = 0;
    if (hipGetDevice(&dev) != hipSuccess || hipDeviceGetAttribute(&cus, hipDeviceAttributeMultiprocessorCount, dev) != hipSuccess) { g_grid = -1; return false; }
    if (hipFuncSetAttribute((const void*)fwd, hipFuncAttributeMaxDynamicSharedMemorySize, LDS_BYTES) != hipSuccess) { fprintf(stderr, "hipFuncSetAttribute failed\n"); g_grid = -1; return false; }
    if (hipOccupancyMaxActiveBlocksPerMultiprocessor(&per_cu, (const void*)fwd, 512, LDS_BYTES) != hipSuccess || per_cu < 1) { fprintf(stderr, "occupancy query: %d\n", per_cu); (void)hipGetLastError(); g_grid = -1; return false; }
    g_grid = cus;
    return true;
}
static void run(void* const* d_in, float* out, unsigned char* ws, hipStream_t st, int lo, int hi, bool coop) {
    if (!setup()) return;
    (void)hipMemsetAsync(ws + WS_CTL, 0, CTL_ZERO_BYTES, st);
    Args a{};
    for (int i = 0; i < 25; ++i) a.in[i] = (const float*)d_in[i];
    a.out = out; a.ws = ws;
    if (coop) { a.ph_lo = lo; a.ph_hi = hi;
        hipLaunchKernelGGL(fwd, dim3(g_grid), dim3(512), LDS_BYTES, st, a);
    } else {
        for (int p = lo; p < hi; ++p) { a.ph_lo = p; a.ph_hi = p + 1; hipLaunchKernelGGL(fwd, dim3(g_grid), dim3(512), LDS_BYTES, st, a); }
    }
}
}
#ifndef DBG_STAGE
#define DBG_STAGE 0
#endif
#ifndef N_LAUNCHES
#define N_LAUNCHES 1
#endif
#if DBG_STAGE
namespace dbg {
template <typename TIn> __global__ void k_sample(const TIn* src, int ld, int col0, int ncols, int stride, float* dst) {
    const int i = blockIdx.x; const size_t row = (size_t)i * stride;
    for (int c = threadIdx.x; c < ncols; c += blockDim.x) { float v; if (sizeof(TIn) == 2) v = __builtin_bit_cast(float, (unsigned)(*(const unsigned short*)&src[row * ld + col0 + c]) << 16); else v = (float)(*(const float*)&src[row * ld + col0 + c]); dst[(size_t)i * ncols + c] = v; }
}
__global__ void k_cmp(const float* smp, int sld, int scol0, int n, int stride, const float* ref, int ldr, int rcol0, const float* rowscale, float* acc) {
    __shared__ float r0[256], r1[256];
    const int i = blockIdx.x; const size_t row = (size_t)i * stride; const float sc = rowscale ? rowscale[row] : 1.f;
    float d2 = 0.f, f2 = 0.f;
    for (int c = threadIdx.x; c < n; c += blockDim.x) { const float r = ref[row * ldr + rcol0 + c] * sc, s = smp[(size_t)i * sld + scol0 + c]; const float d = s - r; d2 += d * d; f2 += r * r; }
    r0[threadIdx.x] = d2; r1[threadIdx.x] = f2; __syncthreads();
    for (int o = 128; o > 0; o >>= 1) { if (threadIdx.x < o) { r0[threadIdx.x] += r0[threadIdx.x + o]; r1[threadIdx.x] += r1[threadIdx.x + o]; } __syncthreads(); }
    if (threadIdx.x == 0) { atomicAdd(&acc[0], r0[0]); atomicAdd(&acc[1], r1[0]); }
}
__global__ void k_scale(float* out, const float* acc, int nchk, int raw, float tol) {
    float delta = 0.f;
    if (raw >= 0) { const float e = sqrtf(acc[2 * raw] / fmaxf(acc[2 * raw + 1], 1e-30f)); delta = 4.f * fminf(e, 2.f); if (!(e == e)) delta = 9.f; }
    else for (int i = 0; i < nchk; ++i) { const float e = sqrtf(acc[2 * i] / fmaxf(acc[2 * i + 1], 1e-30f)); if (!(e <= tol)) { delta = 0.1f * (i + 1) + 0.05f * ((e == e) ? fminf(e, 1.f) : 1.f); break; } }
    const size_t idx = (size_t)blockIdx.x * blockDim.x + threadIdx.x;
    out[idx] *= (1.f + delta);
}
struct Ctx { unsigned char* ws; float* out; float* smp; float* acc; };
#ifndef DBG_RAW
#define DBG_RAW -1
#endif
#ifndef DBG_TOL
#define DBG_TOL 0.02f
#endif
constexpr size_t SM0 = 0, SM1 = 2 * 1024 * 1024 + 65536;
static void hook(int stage, void* vctx, hipStream_t st) {
    Ctx& c = *(Ctx*)vctx; unsigned char* ws = c.ws;
    const float* bufA = (const float*)(ws + nv::W_A); const float* proj = (const float*)(ws + nv::W_B); const float* ymr = (const float*)(ws + nv::W_C);
#if DBG_STAGE == 3
    if (stage == 2) k_cmp<<<964, 256, 0, st>>>(c.smp + SM0, 2048, 0, 2048, 17, bufA, 2048, 0, nullptr, c.acc + 0);
    if (stage == 3) { k_cmp<<<529, 256, 0, st>>>(c.smp + SM1, 6144, 0, 4096, 31, proj, nv::INW, 0, nullptr, c.acc + 2);
                      k_cmp<<<529, 256, 0, st>>>(c.smp + SM1, 6144, 4096, 2048, 31, proj, nv::INW, 4104, nullptr, c.acc + 4); }
#elif DBG_STAGE == 6
    if (stage == 6) { k_cmp<<<964, 256, 0, st>>>(c.smp + SM0, 2048, 0, 1024, 17, ymr, 2048, 0, nullptr, c.acc + 0);
                      k_cmp<<<964, 256, 0, st>>>(c.smp + SM0, 2048, 1024, 1024, 17, ymr, 2048, 1024, nullptr, c.acc + 2); }
#elif DBG_STAGE == 7
    if (stage == 7) k_cmp<<<964, 256, 0, st>>>(c.smp + SM0, 2048, 0, 2048, 17, c.out, 2048, 0, nullptr, c.acc + 0);
#elif DBG_STAGE == 8
    if (stage == 8) k_cmp<<<964, 256, 0, st>>>(c.smp + SM0, 2048, 0, 2048, 17, bufA, 2048, 0, nullptr, c.acc + 0);
    if (stage == 9) { k_cmp<<<964, 256, 0, st>>>(c.smp + SM1, 4, 0, 2, 17, (const float*)(ws + nv::W_R4), 4, 0, nullptr, c.acc + 2);
                      k_cmp<<<964, 256, 0, st>>>(c.smp + SM1, 4, 2, 2, 17, (const float*)(ws + nv::W_R4), 4, 2, nullptr, c.acc + 4); }
#elif DBG_STAGE == 10
    if (stage == 10) k_cmp<<<1928, 256, 0, st>>>(c.smp + SM0, 2048, 0, 2048, 17, proj + (size_t)4 * nv::T_ * 512, 2048, 0, (const float*)(ws + nv::W_GW), c.acc + 0);
#endif
}
}
#endif

extern "C" void kernel_launch(void* const* d_in, const int* in_sizes, int n_in, void* d_out, int out_size, void* d_ws, size_t ws_size, hipStream_t stream) {
    if (n_in != 25 || ws_size < fk::WS_END) { fprintf(stderr, "kernel_launch: unexpected n_in %d / ws_size %zu\n", n_in, ws_size); return; }
    unsigned char* ws = (unsigned char*)d_ws; float* out = (float*)d_out;
#if DBG_STAGE == 0
    fk::run(d_in, out, ws, stream, 0, fk::NPHASE, N_LAUNCHES == 1);
#else
    if (ws_size < nv::W_END + 24 * nv::MiB_) { fprintf(stderr, "debug build: ws too small\n"); return; }
    float* smp = (float*)(ws + ws_size - 24 * nv::MiB_); float* acc = smp + 6 * 1024 * 1024 - 64;
    (void)hipMemsetAsync(acc, 0, 256, stream);
#if DBG_STAGE == 3
    fk::run(d_in, out, ws, stream, 0, 3, N_LAUNCHES == 1);
    dbg::k_sample<unsigned short><<<964, 256, 0, stream>>>((const unsigned short*)(ws + fk::WS_HN), 2048, 0, 2048, 17, smp + dbg::SM0);
    dbg::k_sample<unsigned short><<<529, 256, 0, stream>>>((const unsigned short*)(ws + fk::WS_PROJ), 6144, 0, 6144, 31, smp + dbg::SM1);
    const int nchk = 3;
#elif DBG_STAGE == 6
    fk::run(d_in, out, ws, stream, 0, 6, N_LAUNCHES == 1);
    dbg::k_sample<unsigned short><<<964, 256, 0, stream>>>((const unsigned short*)(ws + fk::WS_HN), 2048, 0, 2048, 17, smp + dbg::SM0);
    const int nchk = 2;
#elif DBG_STAGE == 7
    fk::run(d_in, out, ws, stream, 0, 7, N_LAUNCHES == 1);
    dbg::k_sample<float><<<964, 256, 0, stream>>>(out, 2048, 0, 2048, 17, smp + dbg::SM0);
    const int nchk = 1;
#elif DBG_STAGE == 8
    fk::run(d_in, out, ws, stream, 0, 8, N_LAUNCHES == 1);
    dbg::k_sample<unsigned short><<<964, 256, 0, stream>>>((const unsigned short*)(ws + fk::WS_HN), 2048, 0, 2048, 17, smp + dbg::SM0);
    dbg::k_sample<float><<<964, 256, 0, stream>>>((const float*)(ws + fk::WS_ROUTE), 4, 0, 4, 17, smp + dbg::SM1);
    const int nchk = 3;
#elif DBG_STAGE == 10
    fk::run(d_in, out, ws, stream, 0, 10, N_LAUNCHES == 1);
    dbg::k_sample<unsigned short><<<1928, 256, 0, stream>>>((const unsigned short*)(ws + fk::WS_YS), 2048, 0, 2048, 17, smp + dbg::SM0);
    const int nchk = 1;
#endif
    nv::In I; { const float** p = (const float**)&I; for (int i = 0; i < 25; ++i) p[i] = (const float*)d_in[i]; }
    dbg::Ctx ctx{ws, out, smp, acc};
    nv::run(I, out, ws, stream, dbg::hook, &ctx);
    dbg::k_scale<<<(fk::T * fk::DM) / 256, 256, 0, stream>>>(out, acc, nchk, DBG_RAW, DBG_TOL);
#endif
}
```

```cpp
#define DBG_STAGE 0
#define N_LAUNCHES 1
#define DBG_RAW -1
#include <hip/hip_runtime.h>
#include <hip/hip_cooperative_groups.h>
#include <cstdio>
#include <cstdint>
#include <cmath>
#define LAS __attribute__((address_space(3)))
#define GAS __attribute__((address_space(1)))
typedef unsigned short bf16_t;
typedef short bf16x8 __attribute__((ext_vector_type(8)));
typedef float f32x4 __attribute__((ext_vector_type(4)));
typedef float f32x2 __attribute__((ext_vector_type(2)));
typedef float f32x16 __attribute__((ext_vector_type(16)));
typedef unsigned u32x4 __attribute__((ext_vector_type(4)));
typedef unsigned u32x2 __attribute__((ext_vector_type(2)));

__device__ __forceinline__ unsigned f2bf(float f) { unsigned u = __builtin_bit_cast(unsigned, f); return (u + 0x7fffu + ((u >> 16) & 1u)) >> 16; }
__device__ __forceinline__ unsigned pk2(float lo, float hi) { return f2bf(lo) | (f2bf(hi) << 16); }
__device__ __forceinline__ float bflo(unsigned u) { return __builtin_bit_cast(float, u << 16); }
__device__ __forceinline__ float bfhi(unsigned u) { return __builtin_bit_cast(float, u & 0xffff0000u); }
__device__ __forceinline__ float bf1(bf16_t b) { return __builtin_bit_cast(float, (unsigned)b << 16); }
__device__ __forceinline__ float wave_sum(float v) {
#pragma unroll
    for (int o = 1; o < 64; o <<= 1) v += __shfl_xor(v, o);
    return v;
}
__device__ __forceinline__ float frcp(float x) { return __builtin_amdgcn_rcpf(x); }
__device__ __forceinline__ float fsigmoid(float x) { return frcp(1.f + __expf(-x)); }
__device__ __forceinline__ float fsilu(float x) { return x * frcp(1.f + __expf(-x)); }
__device__ __forceinline__ float flogsigmoid(float x) { return fminf(x, 0.f) - log1pf(expf(-fabsf(x))); }
__device__ __forceinline__ float fgelu_tanh(float x) { const float u = 0.7978845608028654f * (x + 0.044715f * x * x * x); const float e = __expf(2.f * u); const float th = 1.f - 2.f * frcp(e + 1.f); return 0.5f * x * (1.f + th); }
template <int CTRL, int ROW_MASK> __device__ __forceinline__ float dpp_add(float x) { const int v = __builtin_amdgcn_update_dpp(0, __builtin_bit_cast(int, x), CTRL, ROW_MASK, 0xf, true); return x + __builtin_bit_cast(float, v); }
__device__ __forceinline__ float half_sum31(float x) {
    x = dpp_add<0x111, 0xf>(x);
    x = dpp_add<0x112, 0xf>(x);
    x = dpp_add<0x114, 0xf>(x);
    x = dpp_add<0x118, 0xf>(x);
    x = dpp_add<0x142, 0xa>(x);
    return x;
}

namespace pg8 {
constexpr int BM = 256, BK = 64, HALF = 128, HTB = HALF * BK * 2  , STAGE_BYTES = 8 * HTB, NXCD = 8, WGM = 8;
__host__ __device__ __forceinline__ int lds_byte(int r, int c) { const int st = (r >> 4) * 2 + (c >> 5), rr = r & 15, cc = c & 31, ob = rr * 64 + cc * 2; return st * 1024 + (ob ^ (((ob >> 9) & 1) << 5)); }
__host__ __device__ __forceinline__ void stage_rc(int b, int& R, int& C) { const int st = b / 1024, sb = b % 1024, swz = sb ^ (((sb >> 9) & 1) << 5); R = (st >> 1) * 16 + swz / 64; C = (st & 1) * 32 + (swz % 64) / 2; }
__host__ __device__ __forceinline__ int perm32(int rho) { const int n = rho >> 4, i = rho & 15; return 8 * (i >> 2) + 4 * n + (i & 3); }

struct Unit { int pm, pn, e, mt; };

template <class Epi, class Sched>
__device__ __forceinline__ void gemm_phase(LAS unsigned char* lds, const int K, const Sched& S, const Epi& E) {
    int tid_o = threadIdx.x; asm volatile("" : "+v"(tid_o));
    const int tid = tid_o, wid = __builtin_amdgcn_readfirstlane(tid >> 6), lane = tid & 63, wr = wid >> 2, wc = wid & 3, fr = lane & 15, fq = lane >> 4;
    const int nt = K / BK;
    int Rr[2], Cc[2]; unsigned voffB[2];
#pragma unroll
    for (int i = 0; i < 2; ++i) { stage_rc(tid * 16 + i * 8192, Rr[i], Cc[i]); const int Rb = Epi::PERM ? ((Rr[i] & ~31) + perm32(Rr[i] & 31)) : Rr[i]; voffB[i] = (unsigned)(Rb * K + Cc[i]) * 2u; }
    const size_t kstep = (size_t)(BK * 2);
    const size_t hstep = (size_t)HALF * K * 2;
    const unsigned ldsw = (unsigned)wid * 1024u;
    const int aoff = lds_byte(wr * 64 + fr, fq * 8), boff = lds_byte(wc * 32 + fr, fq * 8);
#define PG8_SA(b, h) (((b) * 2 + (h)) * HTB)
#define PG8_SB(b, h) ((4 + (b) * 2 + (h)) * HTB)
#define PG8_STAGE(bufoff, gbase, voff) do { const char* _gb = (const char*)(gbase); asm volatile("" : "+s"(_gb));     \
        _Pragma("unroll") for (int _i = 0; _i < 2; ++_i) \
        __builtin_amdgcn_global_load_lds((const unsigned*)(_gb + (voff)[_i]), (LAS unsigned*)(lds + (bufoff) + ldsw + _i * 8192), 16, 0, 0); } while (0)
#define PG8_LDA(dst, b, h) do { _Pragma("unroll") for (int m = 0; m < 4; ++m) _Pragma("unroll") for (int k = 0; k < 2; ++k) dst[m][k] = *(const LAS bf16x8*)(lds + PG8_SA(b, h) + aoff + m * 2048 + k * 1024); } while (0)
#define PG8_LDB(dst, b, h) do { _Pragma("unroll") for (int n = 0; n < 2; ++n) _Pragma("unroll") for (int k = 0; k < 2; ++k) dst[n][k] = *(const LAS bf16x8*)(lds + PG8_SB(b, h) + boff + n * 2048 + k * 1024); } while (0)
#define PG8_MMA(ai, bj, At, Bt) do { __builtin_amdgcn_s_setprio(1); _Pragma("unroll") for (int m = 0; m < 4; ++m) _Pragma("unroll") for (int n = 0; n < 2; ++n) _Pragma("unroll") for (int k = 0; k < 2; ++k) \
        acc[ai][bj][m][n] = __builtin_amdgcn_mfma_f32_16x16x32_bf16(Bt[n][k], At[m][k], acc[ai][bj][m][n], 0, 0, 0); __builtin_amdgcn_s_setprio(0); } while (0)
#define PG8_WAIT_V(n) asm volatile("s_waitcnt vmcnt(" #n ")" ::: "memory")
#define PG8_WAIT_L(n) asm volatile("s_waitcnt lgkmcnt(" #n ")" ::: "memory")
#define PG8_BAR __builtin_amdgcn_s_barrier()
#define PG8_SCHED __builtin_amdgcn_sched_barrier(0)
    Unit cur, nxt; int ui = 0;
    if (!S.next(0, cur)) return;
    f32x4 acc[2][2][4][2];
#pragma unroll
    for (int a = 0; a < 2; ++a)
#pragma unroll
        for (int b = 0; b < 2; ++b)
#pragma unroll
            for (int m = 0; m < 4; ++m)
#pragma unroll
                for (int n = 0; n < 2; ++n) acc[a][b][m][n] = (f32x4){0.f, 0.f, 0.f, 0.f};
    bf16x8 At[4][2], B0[2][2], B1[2][2];
    unsigned vA[2][2], nvA[2][2];
    typename Epi::State est; E.pre(est, cur, wr, fr);
    S.a_off(cur, Rr, Cc, K, vA);
    const char* cA = S.a_base(cur); const char* cB = S.b_base(cur);
    PG8_STAGE(PG8_SB(0, 0), cB, voffB); PG8_STAGE(PG8_SB(0, 1), cB + hstep, voffB); PG8_STAGE(PG8_SA(0, 0), cA, vA[0]); PG8_STAGE(PG8_SA(0, 1), cA, vA[1]);
    if (wr == 1) PG8_BAR;
    PG8_WAIT_V(2); PG8_BAR;
    PG8_STAGE(PG8_SB(1, 0), cB + kstep, voffB); PG8_STAGE(PG8_SA(1, 0), cA + kstep, vA[0]); PG8_STAGE(PG8_SB(1, 1), cB + hstep + kstep, voffB);
    PG8_WAIT_V(6); PG8_BAR;
    for (;;) {
        const bool has_next = S.next(ui + 1, nxt);
        if (!has_next) nxt = cur;
        const char* nA = S.a_base(nxt); const char* nB = S.b_base(nxt);
        S.a_off(nxt, Rr, Cc, K, nvA);
        for (int t = 0; t < nt; t += 2) {
            const bool last = (t == nt - 2);
            const char* a1 = cA + (size_t)(t + 1) * kstep;
            const char* a2 = last ? nA : cA + (size_t)(t + 2) * kstep; const char* b2 = last ? nB : cB + (size_t)(t + 2) * kstep;
            const char* a3 = a2 + kstep; const char* b3 = b2 + kstep;
            unsigned w0[2], w1[2];
#pragma unroll
            for (int i = 0; i < 2; ++i) { w0[i] = last ? nvA[0][i] : vA[0][i]; w1[i] = last ? nvA[1][i] : vA[1][i]; }
            PG8_LDB(B0, 0, 0); PG8_LDB(B1, 0, 1); PG8_SCHED; PG8_LDA(At, 0, 0); PG8_STAGE(PG8_SA(1, 1), a1, vA[1]);
            PG8_WAIT_V(8); PG8_WAIT_L(0); PG8_BAR; PG8_MMA(0, 0, At, B0); PG8_MMA(0, 1, At, B1); PG8_BAR; PG8_SCHED;
            PG8_LDA(At, 0, 1); PG8_STAGE(PG8_SB(0, 0), b2, voffB); PG8_STAGE(PG8_SB(0, 1), b2 + hstep, voffB); PG8_STAGE(PG8_SA(0, 0), a2, w0);
            PG8_WAIT_V(8); PG8_WAIT_L(0); PG8_BAR; PG8_MMA(1, 0, At, B0); PG8_MMA(1, 1, At, B1); PG8_BAR; PG8_SCHED;
            PG8_LDB(B0, 1, 0); PG8_LDB(B1, 1, 1); PG8_SCHED; PG8_LDA(At, 1, 0); PG8_STAGE(PG8_SA(0, 1), a2, w1);
            PG8_WAIT_V(8); PG8_WAIT_L(0); PG8_BAR; PG8_MMA(0, 0, At, B0); PG8_MMA(0, 1, At, B1); PG8_BAR; PG8_SCHED;
            PG8_LDA(At, 1, 1); PG8_STAGE(PG8_SB(1, 0), b3, voffB); PG8_STAGE(PG8_SB(1, 1), b3 + hstep, voffB); PG8_STAGE(PG8_SA(1, 0), a3, w0);
            PG8_WAIT_V(8); PG8_WAIT_L(0); PG8_BAR; PG8_MMA(1, 0, At, B0); PG8_MMA(1, 1, At, B1); PG8_BAR; PG8_SCHED;
        }
        if (wr == 0) PG8_BAR;
        E(acc, cur, wr, wc, fr, fq, est);
        if (!has_next) break;
#pragma unroll
        for (int a = 0; a < 2; ++a)
#pragma unroll
            for (int b = 0; b < 2; ++b)
#pragma unroll
                for (int m = 0; m < 4; ++m)
#pragma unroll
                    for (int n = 0; n < 2; ++n) acc[a][b][m][n] = (f32x4){0.f, 0.f, 0.f, 0.f};
        cur = nxt; cA = nA; cB = nB; ++ui; E.pre(est, cur, wr, fr);
#pragma unroll
        for (int h = 0; h < 2; ++h)
#pragma unroll
            for (int i = 0; i < 2; ++i) vA[h][i] = nvA[h][i];
        if (wr == 1) PG8_BAR;
    }
    PG8_WAIT_V(0);
    PG8_BAR;
#undef PG8_SA
#undef PG8_SB
#undef PG8_STAGE
#undef PG8_LDA
#undef PG8_LDB
#undef PG8_MMA
#undef PG8_WAIT_V
#undef PG8_WAIT_L
#undef PG8_BAR
#undef PG8_SCHED
}
}
namespace fk {
constexpr int T = 16384, SEQ = 8192, DM = 2048, NPROJ = 6144, INW = 6152;
constexpr float EPS = 1e-6f;
constexpr size_t MiB = 1u << 20, KiB = 1u << 10;
constexpr size_t WS_CTL = 0, WS_DONE = 1024, WS_BAR = 4096, CTL_ZERO_BYTES = 32768;
constexpr int NKS = 16;
constexpr size_t WS_MODP = 619 * MiB;
constexpr size_t WS_MOD = 2 * MiB;
constexpr size_t WS_WG8 = 2 * MiB + 256 * KiB;
constexpr size_t WS_WRH = 2 * MiB + 512 * KiB, WS_WRL = WS_WRH + 192 * KiB;
constexpr size_t WS_GTB = 3 * MiB, WS_GTW = 3 * MiB + 256 * KiB, WS_GTA = 3 * MiB + 512 * KiB;
constexpr size_t WS_BLAST = 3 * MiB + 768 * KiB, WS_ALAST = WS_BLAST + 4 * KiB, WS_DTOT = WS_BLAST + 8 * KiB, WS_CVEC = WS_BLAST + 9 * KiB;
constexpr size_t WS_LNS = 4 * MiB;
constexpr size_t WS_LRUA = 4 * MiB + 256 * KiB, WS_LRUH = 4 * MiB + 512 * KiB, WS_LRUC = 4 * MiB + 768 * KiB;
constexpr size_t WS_ROUTE = 5 * MiB;
constexpr size_t WS_LIST = 6 * MiB;
constexpr size_t WS_LW = 2 * MiB + 896 * KiB;
constexpr size_t WS_LISTW = 553 * MiB;
constexpr size_t WS_WLRU = 8 * MiB;
constexpr size_t WS_WIN = 9 * MiB;
constexpr size_t WS_WOUT = 33 * MiB;
constexpr size_t WS_WGU = 41 * MiB;
constexpr size_t WS_WDN = 169 * MiB;
constexpr size_t WS_HN = 233 * MiB;
constexpr size_t WS_PROJ = 297 * MiB;
constexpr size_t WS_HEXP = WS_PROJ, WS_YS = WS_PROJ + 40 * MiB;
constexpr size_t WS_LST = 489 * MiB;
constexpr size_t WS_X1B = WS_LST;
constexpr size_t WS_HLOC = 555 * MiB, WS_ACUM = 587 * MiB;
constexpr size_t WS_END = 621 * MiB;
constexpr int LDS_BYTES = 163840;
constexpr int L_CTL = 160 * 1024 - 1024;

struct Args { const float* in[25]; float* out; unsigned char* ws; int ph_lo, ph_hi; };
enum { I_X = 0, I_C, I_WADA, I_BADA, I_WIN, I_BGATES, I_CONVQK, I_MHG, I_LCW, I_LCB, I_WLA, I_BLA, I_WLX, I_BLX, I_LAM, I_LNG, I_WOUT, I_WGRP, I_BGRP, I_WRT, I_BRT, I_WEG, I_WEU, I_WED, I_FG };

#define LDS_WAIT() asm volatile("s_waitcnt lgkmcnt(0)" ::: "memory")
#define NT_LD(p) __builtin_nontemporal_load(p)
#define NT_ST(v, p) __builtin_nontemporal_store(v, p)
typedef __bf16 bf16x2_t __attribute__((ext_vector_type(2)));
__device__ __forceinline__ unsigned cvtpk(float lo, float hi) { f32x2 v = {lo, hi}; bf16x2_t b = __builtin_convertvector(v, bf16x2_t); return __builtin_bit_cast(unsigned, b); }

struct TrItem { const float* W; bf16_t* WT; int ldw, ldt; };
__device__ __forceinline__ void tr_load(const TrItem& t, f32x4 (&v)[16], int lane) {
#pragma unroll
    for (int i = 0; i < 16; ++i) v[i] = NT_LD((const f32x4*)(t.W + (size_t)(4 * i + (lane >> 4)) * t.ldw + (lane & 15) * 4));
}
__device__ __forceinline__ void tr_store(const TrItem& t, const f32x4 (&v)[16], LAS float* scr, int lane) {
#pragma unroll
    for (int i = 0; i < 16; ++i) { LAS float* sp = scr + (4 * i + (lane >> 4)) * 65 + (lane & 15) * 4; sp[0] = v[i].x; sp[1] = v[i].y; sp[2] = v[i].z; sp[3] = v[i].w; }
    LDS_WAIT(); asm volatile("" ::: "memory");
#pragma unroll
    for (int j = 0; j < 8; ++j) { const int pair = lane + 64 * j, c = pair & 7, n = pair >> 3; const LAS float* s = scr + (8 * c) * 65 + n;
        u32x4 o; o.x = cvtpk(s[0 * 65], s[1 * 65]); o.y = cvtpk(s[2 * 65], s[3 * 65]); o.z = cvtpk(s[4 * 65], s[5 * 65]); o.w = cvtpk(s[6 * 65], s[7 * 65]);
        NT_ST(o, (u32x4*)(t.WT + (size_t)n * t.ldt + 8 * c)); }
    LDS_WAIT(); asm volatile("" ::: "memory");
}
constexpr int TR_IN = 32 * 96, TR_OUT = 32 * 32, TR_L = 64, TR_G = 32 * 256, TR_U = TR_G, TR_D = 32 * 256;
#ifndef TR_KEEP
#define TR_KEEP 0
#endif
constexpr int TR_EARLY = TR_IN + TR_OUT + TR_L + TR_KEEP, TR_ALL = TR_IN + TR_OUT + TR_L + TR_G + TR_U + TR_D;
__device__ __forceinline__ TrItem tr_mk(const float* W, int ldw, int k0, int n0src, bf16_t* WT, int ldt, int rowdst0) { TrItem t; t.W = W + (size_t)k0 * ldw + n0src; t.WT = WT + (size_t)rowdst0 * ldt + k0; t.ldw = ldw; t.ldt = ldt; return t; }
__device__ __forceinline__ TrItem tr_decode(const Args& a, int it) {
    unsigned char* ws = a.ws; int r = it;
    if (r < TR_IN) { const int kb = r / 96, nb = r % 96, n0 = 64 * nb; return tr_mk(a.in[I_WIN], INW, 64 * kb, n0 + (n0 >= 4096 ? 8 : 0), (bf16_t*)(ws + WS_WIN), 2048, n0); } r -= TR_IN;
    if (r < TR_OUT) { const int kb = r / 32, nb = r % 32; return tr_mk(a.in[I_WOUT], 2048, 64 * kb, 64 * nb, (bf16_t*)(ws + WS_WOUT), 2048, 64 * nb); } r -= TR_OUT;
    if (r < TR_L) { const int mi = r / 4, q = r % 4, kb = q / 2, nb = q % 2, n = mi >> 1, g = mi & 1;
        return tr_mk((g ? a.in[I_WLX] : a.in[I_WLA]) + (size_t)n * 16384, 128, 64 * kb, 64 * nb, (bf16_t*)(ws + WS_WLRU), 128, (n * 2 + g) * 128 + 64 * nb); } r -= TR_L;
    if (r < TR_G) { const int e = r / 256, q = r % 256, kb = q / 8, nb = q % 8, n0 = 64 * nb;
        return tr_mk(a.in[I_WEG] + (size_t)e * 2048 * 512, 512, 64 * kb, n0, (bf16_t*)(ws + WS_WGU), 2048, e * 1024 + (n0 / 128) * 256 + (n0 % 128)); } r -= TR_G;
    if (r < TR_U) { const int e = r / 256, q = r % 256, kb = q / 8, nb = q % 8, n0 = 64 * nb;
        return tr_mk(a.in[I_WEU] + (size_t)e * 2048 * 512, 512, 64 * kb, n0, (bf16_t*)(ws + WS_WGU), 2048, e * 1024 + (n0 / 128) * 256 + 128 + (n0 % 128)); } r -= TR_U;
    { const int e = r / 256, q = r % 256, kb = q / 32, nb = q % 32;
        return tr_mk(a.in[I_WED] + (size_t)e * 512 * 2048, 2048, 64 * kb, 64 * nb, (bf16_t*)(ws + WS_WDN), 512, e * 2048 + 64 * nb); }
}
__device__ __forceinline__ void p2_convert(const Args& a, LAS unsigned char* lds, int cw, int ncw, int it_lo, int it_hi) {
    int tid_o = threadIdx.x; asm volatile("" : "+v"(tid_o));
    const int lane = tid_o & 63, wave = __builtin_amdgcn_readfirstlane(tid_o >> 6);
    LAS float* scr = (LAS float*)(lds + wave * 16896);
    int it = __builtin_amdgcn_readfirstlane(it_lo + cw); if (it >= it_hi) return;
    f32x4 va[16], vb[16]; TrItem ta = tr_decode(a, it), tb = ta; tr_load(ta, va, lane);
#pragma unroll 1
    for (;;) {
        it += ncw; const bool hb = it < it_hi; if (hb) { tb = tr_decode(a, it); tr_load(tb, vb, lane); }
        tr_store(ta, va, scr, lane); if (!hb) break;
        it += ncw; const bool ha = it < it_hi; if (ha) { ta = tr_decode(a, it); tr_load(ta, va, lane); }
        tr_store(tb, vb, scr, lane); if (!ha) break;
    }
}
__device__ __forceinline__ void p0_prologue(const Args& a, LAS unsigned char* lds, int vcu, int G, int nconv) {
    int tid_o = threadIdx.x; asm volatile("" : "+v"(tid_o));
    const int tid = tid_o, lane = tid & 63, wave = __builtin_amdgcn_readfirstlane(tid >> 6);
    LAS float* scr = (LAS float*)(lds + wave * 16896);
    const int gw = vcu * 8 + wave, NGW = G * 8;
    unsigned char* ws = a.ws;
    constexpr int NTASK = 48 * NKS, KPT = 2048 / NKS;
    const int nGw = (3 * G < NTASK) ? 3 * G : NTASK;
    const bool isG = wave < 3 && (vcu * 3 + wave) < NTASK;
    if (wave < 3) for (int task = vcu * 3 + wave; task < NTASK; task += 3 * G) {
        const int cg = task % 48, ks = task / 48, n = cg * 256 + lane * 4;
        const float* c = a.in[I_C]; const float* wada = a.in[I_WADA];
        f32x4 a0 = {0.f, 0.f, 0.f, 0.f}, a1 = {0.f, 0.f, 0.f, 0.f};
#pragma unroll 1
        for (int k0 = ks * KPT; k0 < ks * KPT + KPT; k0 += 16) { f32x4 w[16];
#pragma unroll
            for (int q = 0; q < 16; ++q) w[q] = NT_LD((const f32x4*)(wada + (size_t)(k0 + q) * 12288 + n));
#pragma unroll
            for (int q = 0; q < 16; ++q) { const float s0 = fsilu(c[k0 + q]), s1 = fsilu(c[2048 + k0 + q]); a0 += s0 * w[q]; a1 += s1 * w[q]; } }
        float* modp = (float*)(ws + WS_MODP);
        *(f32x4*)(modp + (size_t)(ks * 2 + 0) * 12288 + n) = a0; *(f32x4*)(modp + (size_t)(ks * 2 + 1) * 12288 + n) = a1;
    }
    const int NITEMS = nconv ? TR_EARLY : TR_ALL;
    const int N1 = (G == 256) ? (nconv ? 0 : 10 * NGW) : NITEMS;
    const int before = (3 * vcu + (wave < 3 ? wave : 3)) < nGw ? (3 * vcu + (wave < 3 ? wave : 3)) : nGw;
    const int it2_0 = N1 + (gw - before), it2_s = NGW - nGw;
    for (int pass = 0; pass < 2; ++pass)
    for (int it = pass ? it2_0 : gw; it < (pass ? NITEMS : N1); it += (pass ? it2_s : NGW)) {
        if (pass && isG) break;
        TrItem t = tr_decode(a, it); f32x4 v[16]; tr_load(t, v, lane); tr_store(t, v, scr, lane);
    }
    const int gt = vcu * 512 + tid, NGT = G * 512;
    float* wg8 = (float*)(ws + WS_WG8); bf16_t* wrh = (bf16_t*)(ws + WS_WRH); bf16_t* wrl = (bf16_t*)(ws + WS_WRL);
    for (int i = gt; i < 8 * 2048; i += NGT) { const int g = i >> 11, k = i & 2047; wg8[i] = a.in[I_WIN][(size_t)k * INW + 4096 + g]; }
    for (int i = gt; i < 48 * 2048; i += NGT) { const int c = i >> 11, k = i & 2047; const float w = c < 4 ? a.in[I_WGRP][k * 4 + c] : (c < 36 ? a.in[I_WRT][k * 32 + (c - 4)] : 0.f);
        const unsigned hi = f2bf(w); wrh[i] = (bf16_t)hi; wrl[i] = (bf16_t)f2bf(w - bf1((bf16_t)hi)); }
}

__device__ __forceinline__ void p1_hn_gates(const Args& a, LAS unsigned char* lds, int vcu, int G) {
    int tid_o = threadIdx.x; asm volatile("" : "+v"(tid_o));
    const int tid = tid_o, lane = tid & 63, wave = __builtin_amdgcn_readfirstlane(tid >> 6);
    unsigned char* ws = a.ws;
    LAS float* modv = (LAS float*)lds;
    LAS float* wgs = (LAS float*)(lds + 16384);
    LAS float* gts = (LAS float*)(lds + 16384 + 65536);
    const float* modp = (const float*)(ws + WS_MODP); const float* bada = a.in[I_BADA];
    for (int i = tid; i < 8 * 2048; i += 512) wgs[i] = ((const float*)(ws + WS_WG8))[i];
    for (int ch = vcu; ch < 256; ch += G) {
        const int b = ch >> 7;
        __syncthreads();
        for (int i = tid; i < 4096; i += 512) { float v = bada[i]; for (int ks = 0; ks < NKS; ++ks) v += modp[(size_t)(ks * 2 + b) * 12288 + i]; modv[i] = v; }
        if (ch < 72) {
            const int bb = ch / 36, n = ch % 36; float p = 0.f;
            for (int k = tid; k < 2048; k += 512) { float sh = bada[6144 + k]; for (int ks = 0; ks < NKS; ++ks) sh += modp[(size_t)(ks * 2 + bb) * 12288 + 6144 + k];
                p += sh * (n < 4 ? a.in[I_WGRP][k * 4 + n] : a.in[I_WRT][k * 32 + (n - 4)]); }
            p = wave_sum(p); LAS float* red = gts + 512;
            if (lane == 0) red[wave] = p;
            __syncthreads();
            if (tid == 0) { float q = 0.f; for (int w = 0; w < 8; ++w) q += red[w]; ((float*)(ws + WS_CVEC))[bb * 48 + n] = q + (n < 4 ? a.in[I_BGRP][n] : a.in[I_BRT][n - 4]); }
        }
        if (tid < 96) { const int o = ch * 96 + tid, bb = o / 12288, col = o % 12288; float v = bada[col]; for (int ks = 0; ks < NKS; ++ks) v += modp[(size_t)(ks * 2 + bb) * 12288 + col]; ((float*)(ws + WS_MOD))[o] = v; }
        __syncthreads();
#pragma unroll 1
        for (int i4 = 0; i4 < 2; ++i4) {
            const int rowb = ch * 64 + wave * 8 + i4 * 4;
            f32x4 v[4][8]; float rs[4];
#pragma unroll
            for (int r = 0; r < 4; ++r) { const f32x4* xr = (const f32x4*)(a.in[I_X] + (size_t)(rowb + r) * DM) + lane;
#pragma unroll
                for (int j = 0; j < 8; ++j) v[r][j] = NT_LD(xr + 64 * j); }
#pragma unroll
            for (int r = 0; r < 4; ++r) { float s = 0.f;
#pragma unroll
                for (int j = 0; j < 8; ++j) s += (v[r][j].x * v[r][j].x + v[r][j].y * v[r][j].y) + (v[r][j].z * v[r][j].z + v[r][j].w * v[r][j].w);
                rs[r] = rsqrtf(wave_sum(s) * (1.f / DM) + EPS); }
#pragma unroll
            for (int j = 0; j < 8; ++j) { const f32x4 sh = *(const LAS f32x4*)(modv + 4 * lane + 256 * j), sc = *(const LAS f32x4*)(modv + 2048 + 4 * lane + 256 * j) + 1.f;
#pragma unroll
                for (int r = 0; r < 4; ++r) { v[r][j] = v[r][j] * rs[r] * sc + sh;
                    u32x2* o8 = (u32x2*)((bf16_t*)(ws + WS_HN) + (size_t)(rowb + r) * DM) + lane; o8[64 * j] = (u32x2){cvtpk(v[r][j].x, v[r][j].y), cvtpk(v[r][j].z, v[r][j].w)}; } }
            float gv[4] = {0.f, 0.f, 0.f, 0.f};
#pragma unroll
            for (int g = 0; g < 8; ++g) { float p[4] = {0.f, 0.f, 0.f, 0.f};
#pragma unroll
                for (int j = 0; j < 8; ++j) { const f32x4 w = *(const LAS f32x4*)(wgs + g * 2048 + 4 * lane + 256 * j);
#pragma unroll
                    for (int r = 0; r < 4; ++r) p[r] += (v[r][j].x * w.x + v[r][j].y * w.y) + (v[r][j].z * w.z + v[r][j].w * w.w); }
#pragma unroll
                for (int r = 0; r < 4; ++r) { const float q = wave_sum(p[r]); if (lane == g) gv[r] = q; } }
#pragma unroll
            for (int r = 0; r < 4; ++r) if (lane < 8) gts[(wave * 8 + i4 * 4 + r) * 8 + lane] = gv[r];
        }
        __syncthreads();
        if (wave < 4) {
            const int h = wave, row = ch * 64 + lane; const float* bg = a.in[I_BGATES];
            const float ig = gts[lane * 8 + h] + bg[h]; const float lf = flogsigmoid(gts[lane * 8 + 4 + h] + bg[4 + h]);
            float bc = lf;
#pragma unroll
            for (int o = 1; o < 64; o <<= 1) { const float t = __shfl_up(bc, o); if (lane >= o) bc += t; }
            const float w = ig - bc; float am = w;
#pragma unroll
            for (int o = 1; o < 64; o <<= 1) { const float t = __shfl_up(am, o); if (lane >= o) am = fmaxf(am, t); }
            ((float*)(ws + WS_GTB))[row * 4 + h] = bc; ((float*)(ws + WS_GTW))[row * 4 + h] = w; ((float*)(ws + WS_GTA))[row * 4 + h] = am;
            if (lane == 63) { const int bh = b * 4 + h, c = ch & 127; ((float*)(ws + WS_BLAST))[bh * 128 + c] = bc; ((float*)(ws + WS_ALAST))[bh * 128 + c] = am; }
        }
    }
    __syncthreads();
}

struct DenseSched {
    static constexpr bool GATHER = false;
    const char* A; const char* Bt; int K, nM, nN, nwg, G, c;
    __device__ __forceinline__ void init(const void* A_, const void* Bt_, int M, int N, int K_, int G_, int c_) { A = (const char*)A_; Bt = (const char*)Bt_; K = K_; nM = M / 256; nN = N / 256; nwg = nM * nN; G = G_; c = c_; }
    __device__ __forceinline__ bool next(int i, pg8::Unit& u) const {
#ifdef P2_DUP
        if (K == 2048 && nN == 24) { const int cnt = (nwg - c + G - 1) / G; if (i >= 2 * cnt) return false; if (i >= cnt) i -= cnt; }
#endif
        const long L = (long)i * G + c; if (L >= nwg) return false;
        int wgid = (int)L; { const int q = nwg / 8, r = nwg % 8, xcd = wgid % 8, off = wgid / 8; wgid = (xcd < r ? xcd * (q + 1) : r * (q + 1) + (xcd - r) * q) + off; }
        const int nig = 8 * nN, gid = wgid / nig, fm = gid * 8, gsz = (nM - fm) < 8 ? (nM - fm) : 8;
        u.pm = fm + ((wgid % nig) % gsz); u.pn = (wgid % nig) / gsz; u.e = 0; u.mt = 0; return true;
    }
    __device__ __forceinline__ const char* a_base(const pg8::Unit& u) const { return A + (size_t)u.pm * 256 * K * 2; }
    __device__ __forceinline__ const char* b_base(const pg8::Unit& u) const { return Bt + (size_t)u.pn * 256 * K * 2; }
    __device__ __forceinline__ void a_off(const pg8::Unit&, const int (&R)[2], const int (&C)[2], int K_, unsigned (&v)[2][2]) const {
#pragma unroll
        for (int h = 0; h < 2; ++h)
#pragma unroll
            for (int i = 0; i < 2; ++i) v[h][i] = (unsigned)((128 * h + R[i]) * K_ + C[i]) * 2u;
    }
};
#define EPI_NOSTATE struct State {}; __device__ __forceinline__ void pre(State&, const pg8::Unit&, int, int) const {}
struct EpiProj {
    static constexpr bool PERM = true; EPI_NOSTATE
    bf16_t* O; int ldc;
    __device__ __forceinline__ void operator()(const f32x4 (&acc)[2][2][4][2], const pg8::Unit& u, int wr, int wc, int fr, int fq, const State& est) const {
        const int row0 = u.pm * 256 + wr * 64 + fr, col0 = u.pn * 256 + wc * 32 + 8 * fq;
#pragma unroll
        for (int ai = 0; ai < 2; ++ai)
#pragma unroll
            for (int m = 0; m < 4; ++m) { bf16_t* rowp = O + (size_t)(row0 + ai * 128 + m * 16) * ldc + col0;
#pragma unroll
                for (int bj = 0; bj < 2; ++bj) { const f32x4 v0 = acc[ai][bj][m][0], v1 = acc[ai][bj][m][1];
                    u32x4 w; w.x = cvtpk(v0[0], v0[1]); w.y = cvtpk(v0[2], v0[3]); w.z = cvtpk(v1[0], v1[1]); w.w = cvtpk(v1[2], v1[3]);
                    *(u32x4*)(rowp + bj * 128) = w; } }
    }
};
struct EpiX1 {
    static constexpr bool PERM = true; EPI_NOSTATE
    const float* x; const float* mod; bf16_t* x1b;
    __device__ __forceinline__ void operator()(const f32x4 (&acc)[2][2][4][2], const pg8::Unit& u, int wr, int wc, int fr, int fq, const State& est) const {
        const int row0 = u.pm * 256 + wr * 64 + fr, col0 = u.pn * 256 + wc * 32 + 8 * fq;
        const float* g1 = mod + (size_t)((u.pm * 256) / SEQ) * 12288 + 4096;
#pragma unroll
        for (int bj = 0; bj < 2; ++bj) { const int col = col0 + bj * 128; const f32x4 ga = *(const f32x4*)(g1 + col), gb = *(const f32x4*)(g1 + col + 4);
#pragma unroll
            for (int ai = 0; ai < 2; ++ai)
#pragma unroll
                for (int m = 0; m < 4; ++m) { const size_t off = (size_t)(row0 + ai * 128 + m * 16) * DM + col; const f32x4 xa = NT_LD((const f32x4*)(x + off)), xb = NT_LD((const f32x4*)(x + off + 4));
                    const f32x4 va = xa + ga * acc[ai][bj][m][0], vb = xb + gb * acc[ai][bj][m][1];
                    *(u32x4*)(x1b + off) = (u32x4){cvtpk(va.x, va.y), cvtpk(va.z, va.w), cvtpk(vb.x, vb.y), cvtpk(vb.z, vb.w)}; } }
    }
};
template <int NT, bool GATH>
struct MoeSched {
    static constexpr bool GATHER = GATH;
    const LAS int* tp; const int* cnt; const int* list; const char* A; const char* Bt; int K, first, stride, end;
    __device__ __forceinline__ bool next(int i, pg8::Unit& u) const {
        const int L = first + i * stride; if (L >= end) return false;
        const int tile = L / NT; u.pn = L % NT;
        const int e = __builtin_amdgcn_readfirstlane((int)((const LAS unsigned short*)(tp + 160))[tile]);
        u.e = e; u.mt = tile - tp[e]; u.pm = tile; return true;
    }
    __device__ __forceinline__ const char* a_base(const pg8::Unit& u) const { return GATH ? A : A + (size_t)u.pm * 256 * K * 2; }
    __device__ __forceinline__ const char* b_base(const pg8::Unit& u) const { return Bt + ((size_t)u.e * NT + u.pn) * 256 * K * 2; }
    __device__ __forceinline__ void a_off(const pg8::Unit& u, const int (&R)[2], const int (&C)[2], int K_, unsigned (&v)[2][2]) const {
        if (GATH) { const int n = cnt[u.e]; const int* lp = list + (size_t)u.e * T + u.mt * 256;
#pragma unroll
            for (int h = 0; h < 2; ++h)
#pragma unroll
                for (int i = 0; i < 2; ++i) { const int r = 128 * h + R[i]; const int tok = (u.mt * 256 + r < n) ? (lp[r] >> 1) : 0; v[h][i] = (unsigned)(tok * K_ + C[i]) * 2u; }
        } else {
#pragma unroll
            for (int h = 0; h < 2; ++h)
#pragma unroll
                for (int i = 0; i < 2; ++i) v[h][i] = (unsigned)((128 * h + R[i]) * K_ + C[i]) * 2u;
        }
    }
};
struct EpiGateUp {
    static constexpr bool PERM = true; EPI_NOSTATE
    bf16_t* H;
    __device__ __forceinline__ void operator()(const f32x4 (&acc)[2][2][4][2], const pg8::Unit& u, int wr, int wc, int fr, int fq, const State& est) const {
        const int row0 = u.pm * 256 + wr * 64 + fr, col0 = u.pn * 128 + wc * 32 + 8 * fq;
#pragma unroll
        for (int ai = 0; ai < 2; ++ai)
#pragma unroll
            for (int m = 0; m < 4; ++m) { bf16_t* rowp = H + (size_t)(row0 + ai * 128 + m * 16) * 512 + col0;
                const f32x4 g0 = acc[ai][0][m][0], g1 = acc[ai][0][m][1], u0 = acc[ai][1][m][0], u1 = acc[ai][1][m][1];
                u32x4 w; w.x = cvtpk(fsilu(g0[0]) * u0[0], fsilu(g0[1]) * u0[1]); w.y = cvtpk(fsilu(g0[2]) * u0[2], fsilu(g0[3]) * u0[3]);
                w.z = cvtpk(fsilu(g1[0]) * u1[0], fsilu(g1[1]) * u1[1]); w.w = cvtpk(fsilu(g1[2]) * u1[2], fsilu(g1[3]) * u1[3]);
                *(u32x4*)rowp = w; }
    }
};
constexpr int L_G2T = 131072;
struct EpiDown {
    static constexpr bool PERM = true;
    struct State { unsigned pk[2][4]; };
    bf16_t* Y; const int* cnt; const int* list; const float* listw; const bf16_t* x1; const LAS float* g2t;
    __device__ __forceinline__ void pre(State& st, const pg8::Unit& u, int wr, int fr) const {
        const int n = cnt[u.e]; const size_t base = (size_t)u.e * T + u.mt * 256;
#pragma unroll
        for (int ai = 0; ai < 2; ++ai)
#pragma unroll
            for (int m = 0; m < 4; ++m) { const int r = ai * 128 + wr * 64 + m * 16 + fr; const bool ok = u.mt * 256 + r < n;
                const unsigned d = ok ? (unsigned)list[base + r] : 0xFFFFu; const float g = ok ? listw[base + r] : 0.f; st.pk[ai][m] = (cvtpk(0.f, g) & 0xffff0000u) | d; }
    }
    __device__ __forceinline__ void operator()(const f32x4 (&acc)[2][2][4][2], const pg8::Unit& u, int wr, int wc, int fr, int fq, const State& st) const {
        const int col0 = u.pn * 256 + wc * 32 + 8 * fq;
#pragma unroll
        for (int ai = 0; ai < 2; ++ai) {
            u32x4 xr[4][2];
#pragma unroll
            for (int m = 0; m < 4; ++m) { const unsigned dst = st.pk[ai][m] & 0xffffu; const bool s0 = (dst & 1u) == 0u;
#pragma unroll
                for (int bj = 0; bj < 2; ++bj) xr[m][bj] = s0 ? NT_LD((const u32x4*)(x1 + (size_t)(dst >> 1) * DM + col0 + bj * 128)) : (u32x4){0u, 0u, 0u, 0u}; }
#pragma unroll
            for (int m = 0; m < 4; ++m) { const unsigned pk = st.pk[ai][m]; const unsigned dst = pk & 0xffffu;
                if (dst != 0xFFFFu) { const float gw = bfhi(pk); bf16_t* rowp = Y + (size_t)dst * DM + col0; const LAS float* g2 = g2t + ((dst >> 1) >= (unsigned)SEQ ? 2048 : 0) + col0;
#pragma unroll
                    for (int bj = 0; bj < 2; ++bj) { const f32x4 ga = *(const LAS f32x4*)(g2 + bj * 128) * gw, gb = *(const LAS f32x4*)(g2 + bj * 128 + 4) * gw; const u32x4 x = xr[m][bj];
                        const f32x4 v0 = (f32x4){bflo(x.x), bfhi(x.x), bflo(x.y), bfhi(x.y)} + acc[ai][bj][m][0] * ga, v1 = (f32x4){bflo(x.z), bfhi(x.z), bflo(x.w), bfhi(x.w)} + acc[ai][bj][m][1] * gb;
                        u32x4 w; w.x = cvtpk(v0[0], v0[1]); w.y = cvtpk(v0[2], v0[3]); w.z = cvtpk(v1[0], v1[1]); w.w = cvtpk(v1[2], v1[3]);
                        *(u32x4*)(rowp + bj * 128) = w; } } }
        }
    }
};

constexpr int L_KWT = 0, L_VT = 36864, L_QS = 73728, L_KS = 107520, L_PS = 141312, L_F = 150528;
constexpr int L_WEXP = L_F, L_MT = L_F + 256, L_EI = L_F + 512, L_RDN = L_F + 768, L_BT = L_F + 1024, L_WK = L_F + 1280, L_NS = L_F + 1536, L_RSS = L_F + 2560, L_MCH = L_F + 4608, L_RN = L_F + 5248, L_GW = L_F + 5504, L_GA = L_GW + 1024, L_GB = L_GA + 1024, L_AL = L_GB + 1024;
static_assert(L_AL + 16 <= L_CTL, "mixer LDS map");

#define MLSTM_LOAD_RAW(cc) do { const int c_ = (cc), r0c_ = b * SEQ + c_ * 64, dp_ = tid & 127, tg_ = tid >> 7, d0_ = 2 * dp_, s0_ = 16 * tg_, tt0_ = c_ * 64 + s0_; \
          _Pragma("unroll") for (int q = 0; q < 19; ++q) { const int ti = tt0_ - 3 + q; rawk[q] = ti >= 0 ? (FULL ? NT_LD((const unsigned*)(PROJ + (size_t)(r0c_ + s0_ - 3 + q) * NPROJ + 1024 + h * 256 + d0_)) : *(const unsigned*)(PROJ + (size_t)(r0c_ + s0_ - 3 + q) * NPROJ + 1024 + h * 256 + d0_)) : 0u; } \
          } while (0)
#define MLSTM_LOAD_RAWV(cc) do { const int c_ = (cc), r0c_ = b * SEQ + c_ * 64, dp_ = tid & 127, tg_ = tid >> 7, d0_ = 2 * dp_, s0_ = 16 * tg_; \
          _Pragma("unroll") for (int q = 0; q < 16; ++q) rawv[q] = FULL ? NT_LD((const unsigned*)(PROJ + (size_t)(r0c_ + s0_ + q) * NPROJ + 2048 + h * 256 + d0_)) : *(const unsigned*)(PROJ + (size_t)(r0c_ + s0_ + q) * NPROJ + 2048 + h * 256 + d0_); } while (0)
#define MLSTM_LOAD_RAWQ(cc) do { const int c_ = (cc), r0c_ = b * SEQ + c_ * 64, dp_ = tid & 127, tg_ = tid >> 7, d0_ = 2 * dp_, s0_ = 16 * tg_, tt0_ = c_ * 64 + s0_; \
          _Pragma("unroll") for (int q = 0; q < 19; ++q) { const int ti = tt0_ - 3 + q; rawq[q] = ti >= 0 ? NT_LD((const unsigned*)(PROJ + (size_t)(r0c_ + s0_ - 3 + q) * NPROJ + h * 256 + d0_)) : 0u; } } while (0)
template <bool FULL>
__device__ __forceinline__ void mlstm_unit(const Args& a, LAS unsigned char* lds, int bh, int j) {
    int tid_o0 = threadIdx.x; asm volatile("" : "+v"(tid_o0));
    const int tid = tid_o0, lane = tid & 63, wave = __builtin_amdgcn_readfirstlane(tid >> 6), hh = lane >> 5, l31 = lane & 31;
    const int b = bh >> 2, h = bh & 3;
    unsigned char* ws = a.ws;
    const bf16_t* PROJ = (const bf16_t*)(ws + WS_PROJ);
    const float* BLAST = (const float*)(ws + WS_BLAST); const float* ALAST = (const float*)(ws + WS_ALAST);
    LAS float* mch = (LAS float*)(lds + L_MCH); LAS float* nsv = (LAS float*)(lds + L_NS);
    LAS float* WEXP = (LAS float*)(lds + L_WEXP); LAS float* MT = (LAS float*)(lds + L_MT); LAS float* EI = (LAS float*)(lds + L_EI); LAS float* RDN = (LAS float*)(lds + L_RDN);
    LAS float* BT = (LAS float*)(lds + L_BT); LAS float* WK = (LAS float*)(lds + L_WK); LAS float* RSS = (LAS float*)(lds + L_RSS); LAS float* RN = (LAS float*)(lds + L_RN);
    const int unit = bh * 32 + j;
    __syncthreads();
    if (wave == 0) {
        const float pa = BLAST[bh * 128 + 2 * lane], qa = ALAST[bh * 128 + 2 * lane] + pa, pb = BLAST[bh * 128 + 2 * lane + 1], qb = ALAST[bh * 128 + 2 * lane + 1] + pb;
        float P = pa + pb, Q = fmaxf(qa + pb, qb);
#pragma unroll
        for (int o = 1; o < 64; o <<= 1) { const float oP = __shfl_up(P, o), oQ = __shfl_up(Q, o); if (lane >= o) { Q = fmaxf(oQ + P, Q); P = oP + P; } }
        float eP = __shfl_up(P, 1), eQ = __shfl_up(Q, 1); if (lane == 0) { eP = 0.f; eQ = -INFINITY; }
        const float m0 = fmaxf(eP, eQ), m1 = fmaxf(m0 + pa, qa);
        mch[2 * lane] = m0; mch[2 * lane + 1] = m1;
    }
    f32x16 C[8];
#pragma unroll
    for (int dt = 0; dt < 8; ++dt)
#pragma unroll
        for (int r = 0; r < 16; ++r) C[dt][r] = 0.f;
    if (FULL && j > 0) {
        const bf16_t* st = (const bf16_t*)(ws + WS_LST) + (size_t)(unit - 1) * 65536;
#pragma unroll
        for (int dt = 0; dt < 8; ++dt)
#pragma unroll
            for (int q = 0; q < 4; ++q) { const u32x2 v = NT_LD((const u32x2*)(st + ((dt * 4 + q) * 512 + tid) * 4)); C[dt][4 * q] = bflo(v.x); C[dt][4 * q + 1] = bfhi(v.x); C[dt][4 * q + 2] = bflo(v.y); C[dt][4 * q + 3] = bfhi(v.y); }
    }
    if (tid < 256) nsv[tid] = (FULL && j > 0) ? ((const float*)(ws + WS_LNS))[(size_t)(unit - 1) * 256 + tid] : 0.f;
    if (tid < 256) { const int row = b * SEQ + j * 256 + tid;
        ((LAS float*)(lds + L_GW))[tid] = ((const float*)(ws + WS_GTW))[row * 4 + h]; ((LAS float*)(lds + L_GA))[tid] = ((const float*)(ws + WS_GTA))[row * 4 + h]; ((LAS float*)(lds + L_GB))[tid] = ((const float*)(ws + WS_GTB))[row * 4 + h]; }
    if (tid < 4) ((LAS float*)(lds + L_AL))[tid] = ALAST[bh * 128 + 4 * j + tid];
    float dtot_log = 0.f;
    __syncthreads();
#pragma unroll 1
    for (int i = 0; i < 4; ++i) {
        int tid_o = threadIdx.x; asm volatile("" : "+v"(tid_o));
        const int tid = tid_o, lane = tid & 63, hh = lane >> 5, l31 = lane & 31;
        const int c = 4 * j + i; const int r0c = b * SEQ + c * 64;
        const float mc = mch[c]; const float M63 = fmaxf(mc, ((const LAS float*)(lds + L_AL))[i]); const float decay = __expf(mc - M63);
        dtot_log += mc - M63;
        unsigned rawk[19], rawv[16], rawq[19]; MLSTM_LOAD_RAW(c); MLSTM_LOAD_RAWV(c); if (FULL) MLSTM_LOAD_RAWQ(c);
        float cwk[4][2], cwq[4][2];
        { const float* cw = a.in[I_CONVQK]; const int d0 = 2 * (tid & 127);
#pragma unroll
          for (int q = 0; q < 4; ++q) { cwk[q][0] = cw[q * 2048 + 1024 + h * 256 + d0]; cwk[q][1] = cw[q * 2048 + 1024 + h * 256 + d0 + 1]; if (FULL) { cwq[q][0] = cw[q * 2048 + h * 256 + d0]; cwq[q][1] = cw[q * 2048 + h * 256 + d0 + 1]; } } }
        if (tid < 64) { const float w = ((const LAS float*)(lds + L_GW))[i * 64 + tid], am = ((const LAS float*)(lds + L_GA))[i * 64 + tid], bt = ((const LAS float*)(lds + L_GB))[i * 64 + tid];
            const float Mt = fmaxf(mc, am); WEXP[tid] = w; MT[tid] = Mt; EI[tid] = __expf(mc - Mt); BT[tid] = bt; WK[tid] = __expf(w - M63); }
        __syncthreads();
        {
            const int dp = tid & 127, tg = tid >> 7, d0 = 2 * dp, s0 = 16 * tg;
            const int tt0 = c * 64 + s0;
            const float* cw = a.in[I_CONVQK];
            {
                const float (&w)[4][2] = cwk;
                const unsigned (&raw)[19] = rawk;
                unsigned pa[8], pb[8]; float ka = 0.f, kb = 0.f;
#pragma unroll
                for (int s = 0; s < 16; ++s) { float x0 = 0.f, x1 = 0.f;
#pragma unroll
                    for (int q = 0; q < 4; ++q) { x0 += w[q][0] * bflo(raw[s + q]); x1 += w[q][1] * bfhi(raw[s + q]); }
                    x0 = fsilu(x0) * 0.0625f; x1 = fsilu(x1) * 0.0625f;
                    if (FULL) *(LAS unsigned*)(lds + L_KS + (s0 + s) * 528 + d0 * 2) = cvtpk(x0, x1);
                    const float wk = WK[s0 + s]; x0 *= wk; x1 *= wk;
                    if (s & 1) { pa[s >> 1] = cvtpk(ka, x0); pb[s >> 1] = cvtpk(kb, x1); } else { ka = x0; kb = x1; } }
                *(LAS u32x4*)(lds + L_KWT + d0 * 144 + s0 * 2) = (u32x4){pa[0], pa[1], pa[2], pa[3]}; *(LAS u32x4*)(lds + L_KWT + d0 * 144 + s0 * 2 + 16) = (u32x4){pa[4], pa[5], pa[6], pa[7]};
                *(LAS u32x4*)(lds + L_KWT + (d0 + 1) * 144 + s0 * 2) = (u32x4){pb[0], pb[1], pb[2], pb[3]}; *(LAS u32x4*)(lds + L_KWT + (d0 + 1) * 144 + s0 * 2 + 16) = (u32x4){pb[4], pb[5], pb[6], pb[7]};
            }
            __builtin_amdgcn_sched_barrier(0);
            {
                const unsigned (&raw)[16] = rawv;
                unsigned pa[8], pb[8];
#pragma unroll
                for (int q = 0; q < 8; ++q) { pa[q] = (raw[2 * q] & 0xffffu) | (raw[2 * q + 1] << 16); pb[q] = (raw[2 * q] >> 16) | (raw[2 * q + 1] & 0xffff0000u); }
                *(LAS u32x4*)(lds + L_VT + d0 * 144 + s0 * 2) = (u32x4){pa[0], pa[1], pa[2], pa[3]}; *(LAS u32x4*)(lds + L_VT + d0 * 144 + s0 * 2 + 16) = (u32x4){pa[4], pa[5], pa[6], pa[7]};
                *(LAS u32x4*)(lds + L_VT + (d0 + 1) * 144 + s0 * 2) = (u32x4){pb[0], pb[1], pb[2], pb[3]}; *(LAS u32x4*)(lds + L_VT + (d0 + 1) * 144 + s0 * 2 + 16) = (u32x4){pb[4], pb[5], pb[6], pb[7]};
            }
            __builtin_amdgcn_sched_barrier(0);
            if (FULL) {
                const float (&w)[4][2] = cwq;
                const unsigned (&raw)[19] = rawq;
#pragma unroll
                for (int s = 0; s < 16; ++s) { float x0 = 0.f, x1 = 0.f;
#pragma unroll
                    for (int q = 0; q < 4; ++q) { x0 += w[q][0] * bflo(raw[s + q]); x1 += w[q][1] * bfhi(raw[s + q]); }
                    *(LAS unsigned*)(lds + L_QS + (s0 + s) * 528 + d0 * 2) = cvtpk(fsilu(x0), fsilu(x1)); }
            }
        }
        __syncthreads();
        if (FULL) {
            {
                const int tr = wave >> 1, tc0 = 2 * (wave & 1), fr = lane & 15, fq = lane >> 4;
                f32x4 s0 = {0.f, 0.f, 0.f, 0.f}, s1 = {0.f, 0.f, 0.f, 0.f};
#pragma unroll
                for (int ks = 0; ks < 8; ++ks) {
                    const bf16x8 af = *(const LAS bf16x8*)(lds + L_QS + (16 * tr + fr) * 528 + (32 * ks + 8 * fq) * 2);
                    const bf16x8 b0 = *(const LAS bf16x8*)(lds + L_KS + (16 * tc0 + fr) * 528 + (32 * ks + 8 * fq) * 2);
                    const bf16x8 b1 = *(const LAS bf16x8*)(lds + L_KS + (16 * (tc0 + 1) + fr) * 528 + (32 * ks + 8 * fq) * 2);
                    s0 = __builtin_amdgcn_mfma_f32_16x16x32_bf16(af, b0, s0, 0, 0, 0); s1 = __builtin_amdgcn_mfma_f32_16x16x32_bf16(af, b1, s1, 0, 0, 0);
                }
                const float we0 = WEXP[16 * tc0 + fr], we1 = WEXP[16 * (tc0 + 1) + fr];
#pragma unroll
                for (int r = 0; r < 4; ++r) { const int t = 16 * tr + 4 * fq + r; const float Mt = MT[t];
                    { const int s = 16 * tc0 + fr; const float ex = __expf(fminf(we0 - Mt, 0.f)); const float p = (s <= t) ? s0[r] * ex : 0.f; *(LAS bf16_t*)(lds + L_PS + t * 144 + s * 2) = (bf16_t)cvtpk(p, 0.f); }
                    { const int s = 16 * (tc0 + 1) + fr; const float ex = __expf(fminf(we1 - Mt, 0.f)); const float p = (s <= t) ? s1[r] * ex : 0.f; *(LAS bf16_t*)(lds + L_PS + t * 144 + s * 2) = (bf16_t)cvtpk(p, 0.f); } }
            }
            __syncthreads();
            u32x4 oreg[4];
#pragma unroll
            for (int q = 0; q < 4; ++q) { const int idx = q * 512 + tid, t = idx >> 5, ch = idx & 31; oreg[q] = NT_LD((const u32x4*)(PROJ + (size_t)(r0c + t) * NPROJ + 3072 + h * 256 + ch * 8)); }
            {
                const int t = tid >> 3, p = tid & 7;
                const u32x4 pv = *(const LAS u32x4*)(lds + L_PS + t * 144 + p * 16);
                float sp = (bflo(pv.x) + bfhi(pv.x)) + (bflo(pv.y) + bfhi(pv.y)) + (bflo(pv.z) + bfhi(pv.z)) + (bflo(pv.w) + bfhi(pv.w));
                float qn = 0.f;
#pragma unroll
                for (int q = 0; q < 4; ++q) { const u32x4 qv = *(const LAS u32x4*)(lds + L_QS + t * 528 + (32 * p + 8 * q) * 2); const LAS float* np = nsv + 32 * p + 8 * q;
                    qn += bflo(qv.x) * np[0] + bfhi(qv.x) * np[1] + bflo(qv.y) * np[2] + bfhi(qv.y) * np[3] + bflo(qv.z) * np[4] + bfhi(qv.z) * np[5] + bflo(qv.w) * np[6] + bfhi(qv.w) * np[7]; }
                sp += __shfl_xor(sp, 1); sp += __shfl_xor(sp, 2); sp += __shfl_xor(sp, 4);
                qn += __shfl_xor(qn, 1); qn += __shfl_xor(qn, 2); qn += __shfl_xor(qn, 4);
                if (p == 0) { const float den = sp + EI[t] * qn; RDN[t] = frcp(fmaxf(fabsf(den), __expf(-(BT[t] + MT[t])))); }
            }
            f32x16 nacc[2];
#pragma unroll
            for (int tt = 0; tt < 2; ++tt)
#pragma unroll
                for (int r = 0; r < 16; ++r) nacc[tt][r] = 0.f;
#pragma unroll
            for (int dt = 0; dt < 8; ++dt)
#pragma unroll
                for (int sp = 0; sp < 2; ++sp) {
                    __builtin_amdgcn_sched_barrier(0);
                    bf16x8 bfr; { u32x4 t4; t4.x = cvtpk(C[dt][8 * sp + 0], C[dt][8 * sp + 1]); t4.y = cvtpk(C[dt][8 * sp + 2], C[dt][8 * sp + 3]); t4.z = cvtpk(C[dt][8 * sp + 4], C[dt][8 * sp + 5]); t4.w = cvtpk(C[dt][8 * sp + 6], C[dt][8 * sp + 7]); bfr = __builtin_bit_cast(bf16x8, t4); }
#pragma unroll
                    for (int tt = 0; tt < 2; ++tt) {
                        const u32x2 lo = *(const LAS u32x2*)(lds + L_QS + (32 * tt + l31) * 528 + (32 * dt + 16 * sp + 4 * hh) * 2);
                        const u32x2 hi = *(const LAS u32x2*)(lds + L_QS + (32 * tt + l31) * 528 + (32 * dt + 16 * sp + 8 + 4 * hh) * 2);
                        const u32x4 a4 = {lo.x, lo.y, hi.x, hi.y};
                        nacc[tt] = __builtin_amdgcn_mfma_f32_32x32x16_bf16(__builtin_bit_cast(bf16x8, a4), bfr, nacc[tt], 0, 0, 0);
                    }
                }
#pragma unroll
            for (int tt = 0; tt < 2; ++tt)
#pragma unroll
                for (int r = 0; r < 16; ++r) nacc[tt][r] *= EI[32 * tt + (r & 3) + 8 * (r >> 2) + 4 * hh];
#pragma unroll
            for (int ks = 0; ks < 4; ++ks) {
                __builtin_amdgcn_sched_barrier(0);
                const bf16x8 bfr = *(const LAS bf16x8*)(lds + L_VT + (32 * wave + l31) * 144 + (16 * ks + 8 * hh) * 2);
#pragma unroll
                for (int tt = 0; tt < 2; ++tt) { const bf16x8 afr = *(const LAS bf16x8*)(lds + L_PS + (32 * tt + l31) * 144 + (16 * ks + 8 * hh) * 2);
                    nacc[tt] = __builtin_amdgcn_mfma_f32_32x32x16_bf16(afr, bfr, nacc[tt], 0, 0, 0); }
            }
#pragma unroll
            for (int q = 0; q < 4; ++q) { const int idx = q * 512 + tid, t = idx >> 5, ch = idx & 31; *(LAS u32x4*)(lds + L_KS + t * 528 + ch * 16) = oreg[q]; }
            __syncthreads();
#pragma unroll
            for (int tt = 0; tt < 2; ++tt)
#pragma unroll
                for (int r = 0; r < 16; ++r) { const int t = 32 * tt + (r & 3) + 8 * (r >> 2) + 4 * hh; const float hv = nacc[tt][r] * RDN[t]; nacc[tt][r] = hv;
                    const float q = half_sum31(hv * hv);
                    if (l31 == 31) RSS[wave * 64 + t] = q; }
            __syncthreads();
            if (tid < 64) { float q = 0.f;
#pragma unroll
                for (int w = 0; w < 8; ++w) q += RSS[w * 64 + tid];
                RN[tid] = rsqrtf(q * (1.f / 256.f) + EPS); }
            __syncthreads();
            {
                const int e = 32 * wave + l31; const float g = a.in[I_MHG][h * 256 + e];
#pragma unroll
                for (int tt = 0; tt < 2; ++tt)
#pragma unroll
                    for (int r = 0; r < 16; ++r) { const int t = 32 * tt + (r & 3) + 8 * (r >> 2) + 4 * hh;
                        const float o = bf1(*(const LAS bf16_t*)(lds + L_KS + t * 528 + e * 2));
                        *(LAS bf16_t*)(lds + L_QS + t * 528 + e * 2) = (bf16_t)cvtpk(nacc[tt][r] * RN[t] * g * fsigmoid(o), 0.f); }
            }
            __syncthreads();
            {
                bf16_t* ymr = (bf16_t*)(ws + WS_HN);
#pragma unroll
                for (int q = 0; q < 4; ++q) { const int idx = q * 512 + tid, t = idx >> 5, ch = idx & 31;
                    *(u32x4*)(ymr + (size_t)(r0c + t) * DM + h * 256 + ch * 8) = *(const LAS u32x4*)(lds + L_QS + t * 528 + ch * 16); }
            }
        }
#pragma unroll
        for (int dt = 0; dt < 8; ++dt)
#pragma unroll
            for (int r = 0; r < 16; ++r) C[dt][r] *= decay;
#pragma unroll
        for (int ks = 0; ks < 4; ++ks) {
            __builtin_amdgcn_sched_barrier(0);
            const bf16x8 bfr = *(const LAS bf16x8*)(lds + L_VT + (32 * wave + l31) * 144 + (16 * ks + 8 * hh) * 2);
#pragma unroll
            for (int dt = 0; dt < 8; ++dt) { const bf16x8 afr = *(const LAS bf16x8*)(lds + L_KWT + (32 * dt + l31) * 144 + (16 * ks + 8 * hh) * 2);
                C[dt] = __builtin_amdgcn_mfma_f32_32x32x16_bf16(afr, bfr, C[dt], 0, 0, 0); }
        }
        if (tid < 256) { float sk = 0.f;
#pragma unroll
            for (int q = 0; q < 8; ++q) { const u32x4 kv = *(const LAS u32x4*)(lds + L_KWT + tid * 144 + q * 16); sk += (bflo(kv.x) + bfhi(kv.x)) + (bflo(kv.y) + bfhi(kv.y)) + (bflo(kv.z) + bfhi(kv.z)) + (bflo(kv.w) + bfhi(kv.w)); }
            nsv[tid] = decay * nsv[tid] + sk; }
        __syncthreads();
    }
    if (!FULL) {
        bf16_t* st = (bf16_t*)(ws + WS_LST) + (size_t)unit * 65536;
#pragma unroll
        for (int dt = 0; dt < 8; ++dt)
#pragma unroll
            for (int q = 0; q < 4; ++q) *(u32x2*)(st + ((dt * 4 + q) * 512 + tid) * 4) = (u32x2){cvtpk(C[dt][4 * q], C[dt][4 * q + 1]), cvtpk(C[dt][4 * q + 2], C[dt][4 * q + 3])};
        if (tid < 256) ((float*)(ws + WS_LNS))[(size_t)unit * 256 + tid] = nsv[tid];
        if (tid == 0) ((float*)(ws + WS_DTOT))[unit] = __expf(dtot_log);
    }
}

constexpr int L_XS = 0, L_SEG = 69632, L_WL = L_SEG + 16384;
static_assert(L_WL + 2 * 128 * 272 <= L_CTL, "lru LDS map");
__device__ __forceinline__ void lru_unit(const Args& a, LAS unsigned char* lds, int b, int j, int n, bool load_w) {
    int tid_o = threadIdx.x; asm volatile("" : "+v"(tid_o));
    const int tid = tid_o, lane = tid & 63, wave = __builtin_amdgcn_readfirstlane(tid >> 6), hh = lane >> 5, l31 = lane & 31;
    unsigned char* ws = a.ws;
    const bf16_t* PROJ = (const bf16_t*)(ws + WS_PROJ);
    const int r0 = b * SEQ + j * 256, c0 = n * 128;
    const int unit = (b * 32 + j) * 8 + n;
    LAS float* SEG = (LAS float*)(lds + L_SEG);
    __syncthreads();
    if (load_w) {
        const bf16_t* WL = (const bf16_t*)(ws + WS_WLRU) + (size_t)n * 2 * 128 * 128;
#pragma unroll
        for (int q = 0; q < 8; ++q) { const int idx = q * 512 + tid, row = idx >> 4, ch = idx & 15;
            *(LAS u32x4*)(lds + L_WL + row * 272 + ch * 16) = *(const u32x4*)(WL + (size_t)row * 128 + ch * 8); }
    }
    {
        const int cp = tid & 63, tg = tid >> 6, c = 2 * cp, s0 = 32 * tg;
        const float* cw = a.in[I_LCW]; const float* cb = a.in[I_LCB];
        float w[4][2];
#pragma unroll
        for (int q = 0; q < 4; ++q) { w[q][0] = cw[q * 1024 + c0 + c]; w[q][1] = cw[q * 1024 + c0 + c + 1]; }
        const float b0 = cb[c0 + c], b1 = cb[c0 + c + 1];
        unsigned raw[35];
#pragma unroll
        for (int q = 0; q < 35; ++q) { const int ti = j * 256 + s0 - 3 + q; raw[q] = ti >= 0 ? NT_LD((const unsigned*)(PROJ + (size_t)(r0 + s0 - 3 + q) * NPROJ + 4096 + c0 + c)) : 0u; }
#pragma unroll
        for (int s = 0; s < 32; ++s) { float x0 = b0, x1 = b1;
#pragma unroll
            for (int q = 0; q < 4; ++q) { x0 += w[q][0] * bflo(raw[s + q]); x1 += w[q][1] * bfhi(raw[s + q]); }
            *(LAS unsigned*)(lds + L_XS + (s0 + s) * 272 + c * 2) = cvtpk(x0, x1); }
    }
    __syncthreads();
    float gba[4], gbx[4], glam[4];
#pragma unroll
    for (int nt = 0; nt < 4; ++nt) { const int c = c0 + 32 * nt + l31; gba[nt] = a.in[I_BLA][c]; gbx[nt] = a.in[I_BLX][c]; glam[nt] = a.in[I_LAM][c]; }
    f32x16 ar[4], ai[4];
#pragma unroll
    for (int nt = 0; nt < 4; ++nt)
#pragma unroll
        for (int r = 0; r < 16; ++r) { ar[nt][r] = 0.f; ai[nt][r] = 0.f; }
    {
        const int tau = 16 * ((l31 >> 2) & 1) + 4 * (l31 >> 3) + (l31 & 3);
#pragma unroll
        for (int ks = 0; ks < 8; ++ks) {
            const bf16x8 afr = *(const LAS bf16x8*)(lds + L_XS + (32 * wave + tau) * 272 + (16 * ks + 8 * hh) * 2);
#pragma unroll
            for (int nt = 0; nt < 4; ++nt) {
                const bf16x8 br = *(const LAS bf16x8*)(lds + L_WL + (32 * nt + l31) * 272 + (16 * ks + 8 * hh) * 2);
                const bf16x8 bi = *(const LAS bf16x8*)(lds + L_WL + (128 + 32 * nt + l31) * 272 + (16 * ks + 8 * hh) * 2);
                ar[nt] = __builtin_amdgcn_mfma_f32_32x32x16_bf16(afr, br, ar[nt], 0, 0, 0); ai[nt] = __builtin_amdgcn_mfma_f32_32x32x16_bf16(afr, bi, ai[nt], 0, 0, 0);
            }
        }
    }
#pragma unroll
    for (int nt = 0; nt < 4; ++nt) {
        __builtin_amdgcn_sched_barrier(0);
        const int d = 32 * nt + l31;
        const float ba = gba[nt], bx = gbx[nt], lsl = flogsigmoid(glam[nt]);
        float A = 1.f, H = 0.f;
#pragma unroll
        for (int r = 0; r < 16; ++r) {
            const int t = 32 * wave + 16 * hh + r;
            const float rg = fsigmoid(ar[nt][r] + ba), ig = fsigmoid(ai[nt][r] + bx);
            const float la = 8.f * rg * lsl; const float av = __expf(la);
            const float xr = bf1(*(const LAS bf16_t*)(lds + L_XS + t * 272 + d * 2));
            const float x2 = 2.f * la; const float om = (x2 > -0.02f) ? -x2 * (1.f + x2 * (0.5f + x2 * (1.f / 6.f))) : 1.f - __expf(x2);
            const float u = __builtin_amdgcn_sqrtf(om) * (ig * xr);
            ar[nt][r] = av; ai[nt][r] = u;
            A *= av; H = av * H + u;
        }
        SEG[((2 * wave + hh) * 128 + d) * 2] = A; SEG[((2 * wave + hh) * 128 + d) * 2 + 1] = H;
    }
    __syncthreads();
    if (tid < 128) {
        float hc = 0.f, At = 1.f;
#pragma unroll
        for (int sg = 0; sg < 16; ++sg) { const float A = SEG[(sg * 128 + tid) * 2], H = SEG[(sg * 128 + tid) * 2 + 1]; SEG[(sg * 128 + tid) * 2] = hc; SEG[(sg * 128 + tid) * 2 + 1] = At; hc = A * hc + H; At *= A; }
        ((float*)(ws + WS_LRUA))[(size_t)unit * 128 + tid] = At; ((float*)(ws + WS_LRUH))[(size_t)unit * 128 + tid] = hc;
    }
    __syncthreads();
#pragma unroll 1
    for (int round = 0; round < 2; ++round) {
#pragma unroll
        for (int nt = 0; nt < 4; ++nt) { const int d = 32 * nt + l31;
            float v = SEG[((2 * wave + hh) * 128 + d) * 2 + round];
#pragma unroll
            for (int r = 0; r < 16; ++r) { const int t = 32 * wave + 16 * hh + r;
                v = round ? v * ar[nt][r] : ar[nt][r] * v + ai[nt][r];
                *(LAS bf16_t*)(lds + L_XS + t * 272 + d * 2) = (bf16_t)cvtpk(v, 0.f); } }
        __syncthreads();
        bf16_t* dstb = (bf16_t*)(ws + (round ? WS_ACUM : WS_HLOC));
#pragma unroll
        for (int q = 0; q < 8; ++q) { const int idx = q * 512 + tid, t = idx >> 4, ch = idx & 15;
            *(u32x4*)(dstb + (size_t)(r0 + t) * 1024 + c0 + ch * 8) = *(const LAS u32x4*)(lds + L_XS + t * 272 + ch * 16); }
        __syncthreads();
    }
}
__device__ __forceinline__ void lru_out_unit(const Args& a, int b, int j, int n) {
    int tid_o = threadIdx.x; asm volatile("" : "+v"(tid_o));
    const int tid = tid_o, d8 = tid & 15;
    unsigned char* ws = a.ws;
    const bf16_t* PROJ = (const bf16_t*)(ws + WS_PROJ); const bf16_t* HL = (const bf16_t*)(ws + WS_HLOC); const bf16_t* AC = (const bf16_t*)(ws + WS_ACUM);
    const int r0 = b * SEQ + j * 256, c0 = n * 128 + 8 * d8;
    const float* cp = (const float*)(ws + WS_LRUC) + (size_t)(b * 32 + j) * 1024 + c0; const float* gp = a.in[I_LNG] + c0;
    const f32x4 ca = *(const f32x4*)cp, cb = *(const f32x4*)(cp + 4), ga = *(const f32x4*)gp, gb = *(const f32x4*)(gp + 4);
    u32x4 hl[8], ac[8], gr[8];
#pragma unroll
    for (int q = 0; q < 8; ++q) { const size_t t = (size_t)(r0 + (tid >> 4) + 32 * q);
        hl[q] = NT_LD((const u32x4*)(HL + t * 1024 + c0)); ac[q] = NT_LD((const u32x4*)(AC + t * 1024 + c0)); gr[q] = NT_LD((const u32x4*)(PROJ + t * NPROJ + 5120 + c0)); }
    bf16_t* ymr = (bf16_t*)(ws + WS_HN);
#pragma unroll
    for (int q = 0; q < 8; ++q) { const size_t t = (size_t)(r0 + (tid >> 4) + 32 * q);
        f32x4 ya = (f32x4){bflo(hl[q].x), bfhi(hl[q].x), bflo(hl[q].y), bfhi(hl[q].y)} + (f32x4){bflo(ac[q].x), bfhi(ac[q].x), bflo(ac[q].y), bfhi(ac[q].y)} * ca;
        f32x4 yb = (f32x4){bflo(hl[q].z), bfhi(hl[q].z), bflo(hl[q].w), bfhi(hl[q].w)} + (f32x4){bflo(ac[q].z), bfhi(ac[q].z), bflo(ac[q].w), bfhi(ac[q].w)} * cb;
        ya = ya * (f32x4){fgelu_tanh(bflo(gr[q].x)), fgelu_tanh(bfhi(gr[q].x)), fgelu_tanh(bflo(gr[q].y)), fgelu_tanh(bfhi(gr[q].y))};
        yb = yb * (f32x4){fgelu_tanh(bflo(gr[q].z)), fgelu_tanh(bfhi(gr[q].z)), fgelu_tanh(bflo(gr[q].w)), fgelu_tanh(bfhi(gr[q].w))};
        float ss = (ya.x * ya.x + ya.y * ya.y) + (ya.z * ya.z + ya.w * ya.w) + (yb.x * yb.x + yb.y * yb.y) + (yb.z * yb.z + yb.w * yb.w);
        ss += __shfl_xor(ss, 1); ss += __shfl_xor(ss, 2); ss += __shfl_xor(ss, 4); ss += __shfl_xor(ss, 8);
        const float rn = rsqrtf(ss * (1.f / 128.f) + EPS);
        ya = ya * rn * ga; yb = yb * rn * gb;
        *(u32x4*)(ymr + t * DM + 1024 + c0) = (u32x4){cvtpk(ya.x, ya.y), cvtpk(ya.z, ya.w), cvtpk(yb.x, yb.y), cvtpk(yb.z, yb.w)}; }
}

__device__ __forceinline__ void mixer_scan(const Args& a, int vcu, int G) {
    unsigned char* ws = a.ws; int tid_o = threadIdx.x; asm volatile("" : "+v"(tid_o)); const int tid = tid_o;
    const float* DT = (const float*)(ws + WS_DTOT);
    if (tid < 256) for (int g = vcu * 256 + tid; g < 65536; g += G * 256) {
        const int bh = g >> 13, i8 = g & 8191; bf16_t* base = (bf16_t*)(ws + WS_LST) + (size_t)bh * 32 * 65536 + (size_t)i8 * 8;
        f32x4 Sa = {0.f, 0.f, 0.f, 0.f}, Sb = {0.f, 0.f, 0.f, 0.f}; u32x4 Lr[31];
#pragma unroll
        for (int j = 0; j < 31; ++j) Lr[j] = NT_LD((const u32x4*)(base + (size_t)j * 65536));
#pragma unroll
        for (int j = 0; j < 31; ++j) { const float d = DT[bh * 32 + j]; const u32x4 L = Lr[j];
            Sa = d * Sa + (f32x4){bflo(L.x), bfhi(L.x), bflo(L.y), bfhi(L.y)}; Sb = d * Sb + (f32x4){bflo(L.z), bfhi(L.z), bflo(L.w), bfhi(L.w)};
            *(u32x4*)(base + (size_t)j * 65536) = (u32x4){cvtpk(Sa.x, Sa.y), cvtpk(Sa.z, Sa.w), cvtpk(Sb.x, Sb.y), cvtpk(Sb.z, Sb.w)}; }
    }
    if (tid >= 264 && tid < 266) for (int g = vcu * 2 + (tid - 264); g < 8 * 64; g += G * 2) {
        const int bh = g >> 6, i4 = g & 63; float* base = (float*)(ws + WS_LNS) + (size_t)bh * 32 * 256 + (size_t)i4 * 4;
        f32x4 S = {0.f, 0.f, 0.f, 0.f};
#pragma unroll 8
        for (int j = 0; j < 31; ++j) { const f32x4 L = *(const f32x4*)(base + (size_t)j * 256); S = DT[bh * 32 + j] * S + L; *(f32x4*)(base + (size_t)j * 256) = S; }
    }
    if (tid >= 256 && tid < 264) for (int g = vcu * 8 + (tid - 256); g < 2048; g += G * 8) {
        const int b = g >> 10, ch = g & 1023, n = ch >> 7, d = ch & 127; float hc = 0.f;
        const float* LA = (const float*)(ws + WS_LRUA); const float* LH = (const float*)(ws + WS_LRUH); float* LC = (float*)(ws + WS_LRUC);
#pragma unroll 8
        for (int j = 0; j < 32; ++j) { const size_t u = (size_t)((b * 32 + j) * 8 + n) * 128 + d; LC[(size_t)(b * 32 + j) * 1024 + ch] = hc; hc = LA[u] * hc + LH[u]; }
    }
}

__device__ __forceinline__ void p5_hn2_route(const Args& a, LAS unsigned char* lds, int vcu, int G) {
    int tid_o = threadIdx.x; asm volatile("" : "+v"(tid_o));
    const int tid = tid_o, lane = tid & 63, wave = __builtin_amdgcn_readfirstlane(tid >> 6), fr = lane & 15, kq = lane >> 4;
    unsigned char* ws = a.ws;
    LAS float* part = (LAS float*)lds;
    LAS float* rstds = (LAS float*)(lds + 49152);
    LAS float* lgs = (LAS float*)(lds + 49152 + 128);
    const float* mod = (const float*)(ws + WS_MOD); const float* cvec = (const float*)(ws + WS_CVEC);
    const bf16_t* WRH = (const bf16_t*)(ws + WS_WRH); const bf16_t* WRL = (const bf16_t*)(ws + WS_WRL);
    int* cnt = (int*)(ws + WS_CTL); int* list = (int*)(ws + WS_LIST); float* route = (float*)(ws + WS_ROUTE);
    for (int task = vcu; task < T / 32; task += G) {
        int lane_o = tid_o & 63; asm volatile("" : "+v"(lane_o));
        const int lane = lane_o, fr = lane & 15, kq = lane >> 4;
        const int row0 = task * 32, b = row0 / SEQ;
        const float* sh2 = mod + (size_t)b * 12288 + 6144; const float* sc2 = mod + (size_t)b * 12288 + 8192;
        __syncthreads();
        const bf16_t* X1 = (const bf16_t*)(ws + WS_X1B);
        f32x4 acc[2][3];
#pragma unroll
        for (int rt = 0; rt < 2; ++rt)
#pragma unroll
            for (int nt = 0; nt < 3; ++nt) acc[rt][nt] = (f32x4){0.f, 0.f, 0.f, 0.f};
        {
            u32x4 xb[8][2];
#pragma unroll
            for (int st = 0; st < 8; ++st)
#pragma unroll
                for (int rt = 0; rt < 2; ++rt) xb[st][rt] = *(const u32x4*)(X1 + (size_t)(row0 + 16 * rt + fr) * DM + 256 * wave + 32 * st + 8 * kq);
            bf16x8 Bhs[2][3], Bls[2][3]; f32x4 s0s[2], s1s[2];
#define RT_LOADB(set, stp) do { const int c0_ = 256 * wave + 32 * (stp) + 8 * kq; s0s[set] = *(const f32x4*)(sc2 + c0_); s1s[set] = *(const f32x4*)(sc2 + c0_ + 4); \
                _Pragma("unroll") for (int nt = 0; nt < 3; ++nt) { Bhs[set][nt] = *(const bf16x8*)(WRH + (size_t)(16 * nt + fr) * 2048 + c0_); Bls[set][nt] = *(const bf16x8*)(WRL + (size_t)(16 * nt + fr) * 2048 + c0_); } } while (0)
            RT_LOADB(0, 0);
#pragma unroll
            for (int st = 0; st < 8; ++st) {
                __builtin_amdgcn_sched_barrier(0);
                if (st < 7) RT_LOADB((st + 1) & 1, st + 1);
                const f32x4 s0 = s0s[st & 1] + 1.f, s1 = s1s[st & 1] + 1.f;
                bf16x8 Ah[2], Al[2];
#pragma unroll
                for (int rt = 0; rt < 2; ++rt) {
                    const u32x4 r4 = xb[st][rt];
                    const f32x4 x0 = (f32x4){bflo(r4.x), bfhi(r4.x), bflo(r4.y), bfhi(r4.y)} * s0, x1 = (f32x4){bflo(r4.z), bfhi(r4.z), bflo(r4.w), bfhi(r4.w)} * s1;
                    u32x4 h; h.x = cvtpk(x0.x, x0.y); h.y = cvtpk(x0.z, x0.w); h.z = cvtpk(x1.x, x1.y); h.w = cvtpk(x1.z, x1.w);
                    u32x4 l; l.x = cvtpk(x0.x - bflo(h.x), x0.y - bfhi(h.x)); l.y = cvtpk(x0.z - bflo(h.y), x0.w - bfhi(h.y)); l.z = cvtpk(x1.x - bflo(h.z), x1.y - bfhi(h.z)); l.w = cvtpk(x1.z - bflo(h.w), x1.w - bfhi(h.w));
                    Ah[rt] = __builtin_bit_cast(bf16x8, h); Al[rt] = __builtin_bit_cast(bf16x8, l);
                }
#pragma unroll
                for (int nt = 0; nt < 3; ++nt) {
                    const bf16x8 Bh = Bhs[st & 1][nt], Bl = Bls[st & 1][nt];
#pragma unroll
                    for (int rt = 0; rt < 2; ++rt) {
                        acc[rt][nt] = __builtin_amdgcn_mfma_f32_16x16x32_bf16(Ah[rt], Bh, acc[rt][nt], 0, 0, 0);
                        acc[rt][nt] = __builtin_amdgcn_mfma_f32_16x16x32_bf16(Al[rt], Bh, acc[rt][nt], 0, 0, 0);
                        acc[rt][nt] = __builtin_amdgcn_mfma_f32_16x16x32_bf16(Ah[rt], Bl, acc[rt][nt], 0, 0, 0);
                    }
                }
            }
        }
#undef RT_LOADB
        __builtin_amdgcn_sched_barrier(0);
        {
            u32x4 v[4][4]; float rs[4];
#pragma unroll
            for (int r = 0; r < 4; ++r)
#pragma unroll
                for (int jj = 0; jj < 4; ++jj) v[r][jj] = NT_LD((const u32x4*)(X1 + (size_t)(row0 + wave * 4 + r) * DM + 8 * lane + 512 * jj));
#pragma unroll
            for (int r = 0; r < 4; ++r) { float ssum = 0.f;
#pragma unroll
                for (int jj = 0; jj < 4; ++jj) { const u32x4 q = v[r][jj]; const float a0 = bflo(q.x), a1 = bfhi(q.x), a2 = bflo(q.y), a3 = bfhi(q.y), a4 = bflo(q.z), a5 = bfhi(q.z), a6 = bflo(q.w), a7 = bfhi(q.w);
                    ssum += ((a0 * a0 + a1 * a1) + (a2 * a2 + a3 * a3)) + ((a4 * a4 + a5 * a5) + (a6 * a6 + a7 * a7)); }
                rs[r] = rsqrtf(wave_sum(ssum) * (1.f / DM) + EPS); if (lane == 0) rstds[wave * 4 + r] = rs[r]; }
#pragma unroll
            for (int jj = 0; jj < 4; ++jj) { __builtin_amdgcn_sched_barrier(0);
                const f32x4 sha = *(const f32x4*)(sh2 + 8 * lane + 512 * jj), shb = *(const f32x4*)(sh2 + 8 * lane + 512 * jj + 4);
                const f32x4 sca = *(const f32x4*)(sc2 + 8 * lane + 512 * jj) + 1.f, scb = *(const f32x4*)(sc2 + 8 * lane + 512 * jj + 4) + 1.f;
#pragma unroll
                for (int r = 0; r < 4; ++r) { const u32x4 q = v[r][jj];
                    const f32x4 ha = (f32x4){bflo(q.x), bfhi(q.x), bflo(q.y), bfhi(q.y)} * rs[r] * sca + sha, hb = (f32x4){bflo(q.z), bfhi(q.z), bflo(q.w), bfhi(q.w)} * rs[r] * scb + shb;
                    *(u32x4*)((bf16_t*)(ws + WS_HN) + (size_t)(row0 + wave * 4 + r) * DM + 8 * lane + 512 * jj) = (u32x4){cvtpk(ha.x, ha.y), cvtpk(ha.z, ha.w), cvtpk(hb.x, hb.y), cvtpk(hb.z, hb.w)}; } }
        }
#pragma unroll
        for (int rt = 0; rt < 2; ++rt)
#pragma unroll
            for (int nt = 0; nt < 3; ++nt)
#pragma unroll
                for (int r = 0; r < 4; ++r) part[(wave * 32 + 16 * rt + 4 * kq + r) * 48 + 16 * nt + fr] = acc[rt][nt][r];
        __syncthreads();
        for (int idx = tid; idx < 32 * 36; idx += 512) { const int r = idx / 36, n = idx % 36; float q = 0.f;
#pragma unroll
            for (int w = 0; w < 8; ++w) q += part[(w * 32 + r) * 48 + n];
            lgs[r * 40 + n] = rstds[r] * q + cvec[b * 48 + n]; }
        __syncthreads();
        if (tid < 32) {
            const int t = row0 + tid; const LAS float* lg = lgs + tid * 40;
            int g = 0; float mx = lg[0];
#pragma unroll
            for (int i = 1; i < 4; ++i) { const float x = lg[i]; if (x > mx) { mx = x; g = i; } }
            float sg = 0.f;
#pragma unroll
            for (int i = 0; i < 4; ++i) sg += __expf(lg[i] - mx);
            const float pg = 1.f / sg;
            int e0 = 0; float m0 = lg[4 + g * 8];
            for (int i = 1; i < 8; ++i) { const float x = lg[4 + g * 8 + i]; if (x > m0) { m0 = x; e0 = i; } }
            int e1 = -1; float m1 = -INFINITY;
            for (int i = 0; i < 8; ++i) { const float x = lg[4 + g * 8 + i]; if (i != e0 && x > m1) { m1 = x; e1 = i; } }
            const float x1 = __expf(m1 - m0); const float w0 = pg / (1.f + x1), w1 = pg * x1 / (1.f + x1);
            const int E0 = g * 8 + e0, E1 = g * 8 + e1;
            *(f32x4*)(route + (size_t)t * 4) = (f32x4){w0, w1, (float)E0, (float)E1};
            LAS int* lcnt = (LAS int*)(lds + 49152 + 128 + 5120); LAS int* lbase = lcnt + 32;
            lcnt[tid] = 0;
            LDS_WAIT(); asm volatile("" ::: "memory");
            const int rk0 = __hip_atomic_fetch_add(lcnt + E0, 1, __ATOMIC_RELAXED, __HIP_MEMORY_SCOPE_WORKGROUP);
            const int rk1 = __hip_atomic_fetch_add(lcnt + E1, 1, __ATOMIC_RELAXED, __HIP_MEMORY_SCOPE_WORKGROUP);
            LDS_WAIT(); asm volatile("" ::: "memory");
            const int lc = lcnt[tid];
            lbase[tid] = lc ? atomicAdd(&cnt[tid], lc) : 0;
            LDS_WAIT(); asm volatile("" ::: "memory");
            float* listw = (float*)(ws + WS_LISTW);
            { const size_t p0 = (size_t)E0 * T + lbase[E0] + rk0, p1 = (size_t)E1 * T + lbase[E1] + rk1;
              list[p0] = t * 2; listw[p0] = w0; list[p1] = t * 2 + 1; listw[p1] = w1; }
        }
    }
}

__device__ __forceinline__ void p9_final(const Args& a, int vcu, int G, float* dstbase) {
    int tid_o = threadIdx.x; asm volatile("" : "+v"(tid_o));
    const int tid = tid_o, lane = tid & 63, wave = __builtin_amdgcn_readfirstlane(tid >> 6);
    unsigned char* ws = a.ws; const float* mod = (const float*)(ws + WS_MOD); const bf16_t* YS = (const bf16_t*)(ws + WS_YS);
    const bf16_t* X1 = (const bf16_t*)(ws + WS_X1B);
    for (int rp = vcu * 8 + wave; rp < T / 2; rp += G * 8) {
        const int b = (2 * rp) / SEQ; const float* g2 = mod + (size_t)b * 12288 + 10240;
        u32x4 y0[2][4], y1[2][4];
#pragma unroll
        for (int q = 0; q < 2; ++q)
#pragma unroll
            for (int jj = 0; jj < 4; ++jj) { const int row = 2 * rp + q; y0[q][jj] = NT_LD((const u32x4*)(YS + (size_t)(2 * row) * DM + 8 * lane + 512 * jj)); y1[q][jj] = NT_LD((const u32x4*)(YS + (size_t)(2 * row + 1) * DM + 8 * lane + 512 * jj)); }
#pragma unroll
        for (int q = 0; q < 2; ++q) {
            const int row = 2 * rp + q; f32x4 v[4][2]; float s = 0.f;
#pragma unroll
            for (int jj = 0; jj < 4; ++jj) { const u32x4 p0 = y0[q][jj], p1 = y1[q][jj];
                v[jj][0] = (f32x4){bflo(p0.x) + bflo(p1.x), bfhi(p0.x) + bfhi(p1.x), bflo(p0.y) + bflo(p1.y), bfhi(p0.y) + bfhi(p1.y)};
                v[jj][1] = (f32x4){bflo(p0.z) + bflo(p1.z), bfhi(p0.z) + bfhi(p1.z), bflo(p0.w) + bflo(p1.w), bfhi(p0.w) + bfhi(p1.w)};
#pragma unroll
                for (int z = 0; z < 2; ++z) s += (v[jj][z].x * v[jj][z].x + v[jj][z].y * v[jj][z].y) + (v[jj][z].z * v[jj][z].z + v[jj][z].w * v[jj][z].w); }
            const float rstd = rsqrtf(wave_sum(s) * (1.f / DM) + EPS);
#pragma unroll
            for (int jj = 0; jj < 4; ++jj) { const f32x4 fa = *(const f32x4*)(a.in[I_FG] + 8 * lane + 512 * jj), fb = *(const f32x4*)(a.in[I_FG] + 8 * lane + 512 * jj + 4);
                float* dr = dstbase + (size_t)row * DM + 8 * lane + 512 * jj; NT_ST(v[jj][0] * rstd * fa, (f32x4*)dr); NT_ST(v[jj][1] * rstd * fb, (f32x4*)(dr + 4)); }
        }
    }
}
}
namespace fk {
#define XB_TMO      128
#define XB_XCNT(j)  (256  + 64 * (j))
#define XB_XSUB(j)  (1280 + 64 * (j))
#define XB_XGEN(j)  (2304 + 64 * (j))
#define XB_TOP      3328
#define XB_TOPGEN   3392
#define XCD_BAR_WORDS 3456
#define XB_SPIN_CAP (1u << 18)

__device__ __forceinline__ unsigned xb_ld(unsigned* p)              { return __hip_atomic_load(p, __ATOMIC_RELAXED, __HIP_MEMORY_SCOPE_AGENT); }
__device__ __forceinline__ unsigned xb_add(unsigned* p, unsigned v) { return __hip_atomic_fetch_add(p, v, __ATOMIC_RELAXED, __HIP_MEMORY_SCOPE_AGENT); }
__device__ __forceinline__ unsigned xb_xcc_id() { return (unsigned)__builtin_amdgcn_s_getreg((3 << 11) | 20) & 0xFu; }
#define XB_SPIN(cond, bar) do { unsigned _sp = 0; while (cond) { __builtin_amdgcn_s_sleep(1); \
    if ((++_sp & 255u) == 0u) { if (xb_ld(&(bar)[XB_TMO])) break; if (_sp > XB_SPIN_CAP) { atomicAdd(&(bar)[XB_TMO], 1u); break; } } } } while (0)

struct XcdBarrier {
    unsigned* bar; unsigned x;
    volatile LAS unsigned* st;
};

__device__ __forceinline__ XcdBarrier xcd_barrier_post(unsigned* bar, volatile LAS unsigned* st) {
    XcdBarrier b; b.bar = bar; b.x = xb_xcc_id(); b.st = st;
    if (threadIdx.x == 0) (void)xb_add(&bar[XB_XCNT(b.x)], 1u);
    return b;
}
__device__ __forceinline__ void xcd_barrier_complete(unsigned* bar, unsigned x, unsigned& nloc, unsigned& nx) {
    const unsigned G = gridDim.x * gridDim.y * gridDim.z;
    unsigned sum, cnt, mine, sp = 0u;
    for (;;) {
        sum = 0u; cnt = 0u; mine = 0u;
#pragma unroll
        for (unsigned j = 0; j < 16; ++j) { const unsigned c = xb_ld(&bar[XB_XCNT(j)]); sum += c; cnt += (c > 0u) ? 1u : 0u; mine = (j == x) ? c : mine; }
        if (sum == G) break;
        __builtin_amdgcn_s_sleep(1);
        if ((++sp & 255u) == 0u) { if (xb_ld(&bar[XB_TMO])) break; if (sp > XB_SPIN_CAP) { atomicAdd(&bar[XB_TMO], 1u); break; } }
    }
    nloc = mine > 0u ? mine : 1u; nx = cnt > 0u ? cnt : 1u;
}

__device__ __forceinline__ void xcd_barrier(const XcdBarrier& b) {
    asm volatile("s_waitcnt vmcnt(0)" ::: "memory");
    __syncthreads();
    if (threadIdx.x == 0) {
        unsigned* bar = b.bar;
        __builtin_amdgcn_s_waitcnt(0);
        unsigned nloc = b.st[0], nx = b.st[1];
        if (nloc == 0u) { xcd_barrier_complete(bar, b.x, nloc, nx); b.st[0] = nloc; b.st[1] = nx; }
        const unsigned old = xb_add(&bar[XB_XSUB(b.x)], 1u);
        const unsigned gen = old / nloc;
        if (old + 1u == (gen + 1u) * nloc) {
            __builtin_amdgcn_fence(__ATOMIC_RELEASE, "agent");
            asm volatile("s_waitcnt vmcnt(0)" ::: "memory");
            const unsigned og = xb_add(&bar[XB_TOP], 1u);
            const unsigned tg = og / nx;
            if (og + 1u == (tg + 1u) * nx) xb_add(&bar[XB_TOPGEN], 1u);
            else XB_SPIN(xb_ld(&bar[XB_TOPGEN]) == tg, bar);
            __builtin_amdgcn_fence(__ATOMIC_ACQUIRE, "agent");
            xb_add(&bar[XB_XGEN(b.x)], 1u);
            asm volatile("s_waitcnt vmcnt(0)" ::: "memory");
        } else {
            XB_SPIN(xb_ld(&bar[XB_XGEN(b.x)]) == gen, bar);
            __builtin_amdgcn_fence(__ATOMIC_ACQUIRE, "agent");
            asm volatile("s_waitcnt vmcnt(0)" ::: "memory");
        }
    }
    __syncthreads();
}
}
namespace fk {
constexpr int NPHASE = 11;
#ifndef NCONV
#define NCONV 36
#endif
#ifndef CONV_ITEMS
#define CONV_ITEMS 19296
#endif
__global__ void __launch_bounds__(512, 2) fwd(Args a) {
    extern __shared__ __attribute__((aligned(16))) unsigned char lds_raw[];
    LAS unsigned char* lds = (LAS unsigned char*)lds_raw;
    const int G = gridDim.x, bx = blockIdx.x, tid = threadIdx.x;
    const int vcu = (G % 8 == 0) ? (bx % 8) * (G / 8) + bx / 8 : bx;
    const int lo = a.ph_lo, hi = a.ph_hi;
    unsigned char* ws = a.ws;
    volatile LAS unsigned* bst = (volatile LAS unsigned*)(lds + L_CTL + 512);
    if (tid < 2) bst[tid] = 0u;
    __syncthreads();
    XcdBarrier bar; bar.bar = (unsigned*)(ws + WS_BAR); bar.x = 0; bar.st = bst;
    if (hi - lo > 1) bar = xcd_barrier_post((unsigned*)(ws + WS_BAR), bst);
#ifndef PH_ONLY
#define PH_ONLY -1
#endif
#define IN(k) ((PH_ONLY < 0 || PH_ONLY == (k)) && lo <= (k) && (k) < hi)
#define GSYNC() xcd_barrier(bar)
#define SYNC(k) do { if (IN(k) && IN((k) + 1)) GSYNC(); } while (0)
#ifndef REP_PHASE
#define REP_PHASE -1
#endif
#ifndef REP_SKIPL
#define REP_SKIPL 0
#endif
#define REP(k) _Pragma("unroll 1") for (int rep_ = 0; rep_ < ((REP_PHASE == (k)) ? 2 : 1); ++rep_)
#define RSYNC() do { if (rep_) GSYNC(); } while (0)
    const int nconv = (G == 256 && IN(0) && IN(2)) ? NCONV : 0;
    REP(0) { RSYNC(); if (IN(0)) { p0_prologue(a, lds, vcu, G, nconv); } } SYNC(0);
    REP(1) { RSYNC(); if (IN(1)) { p1_hn_gates(a, lds, vcu, G); } } SYNC(1);
    REP(2) { RSYNC(); if (IN(2)) {
        const int it_mid = nconv ? TR_EARLY + CONV_ITEMS : TR_ALL;
        if (bx < G - nconv) { const bool early = (bx & 7) < 4;
            if (nconv && early && !rep_) { p2_convert(a, lds, bx * 8 + (tid >> 6), (G - nconv) * 8, it_mid, TR_ALL); __syncthreads(); }
            DenseSched S; S.init(ws + WS_HN, ws + WS_WIN, T, NPROJ, DM, G - nconv, bx); EpiProj E{(bf16_t*)(ws + WS_PROJ), NPROJ}; pg8::gemm_phase<EpiProj, DenseSched>(lds, DM, S, E);
            if (nconv && !early && !rep_) p2_convert(a, lds, bx * 8 + (tid >> 6), (G - nconv) * 8, it_mid, TR_ALL); }
        else if (!rep_) { p2_convert(a, lds, (bx - (G - nconv)) * 8 + (tid >> 6), nconv * 8, TR_EARLY, it_mid);
#ifdef CONV_DUP
            p2_convert(a, lds, (bx - (G - nconv)) * 8 + (tid >> 6), nconv * 8, TR_EARLY, it_mid);
#endif
        }
    } } SYNC(2);
    REP(34) { RSYNC(); REP(3) { RSYNC(); if (IN(3)) {
#ifndef NO_MLSTM
                 for (int u = vcu; u < 256; u += G) mlstm_unit<false>(a, lds, u >> 5, u & 31);
#endif
#ifndef NO_LRU
                 if (!(REP_SKIPL && rep_)) for (int u = vcu, pn_ = -1; u < 512; u += G) { lru_unit(a, lds, u >> 8, (u >> 3) & 31, u & 7, (u & 7) != pn_); pn_ = u & 7; }
#endif
    } } SYNC(3);
    if (IN(4)) { mixer_scan(a, vcu, G); } } SYNC(4);
    REP(5) { RSYNC(); if (IN(5)) {
                 if (vcu & 1) { for (int u = vcu; u < 512; u += G) lru_out_unit(a, u >> 8, (u >> 3) & 31, u & 7); }
                 for (int u = vcu; u < 256; u += G) mlstm_unit<true>(a, lds, u >> 5, u & 31);
                 if (!(vcu & 1)) { for (int u = vcu; u < 512; u += G) lru_out_unit(a, u >> 8, (u >> 3) & 31, u & 7); }
    } } SYNC(5);
    REP(6) { RSYNC(); if (IN(6)) { __syncthreads(); DenseSched S; S.init(ws + WS_HN, ws + WS_WOUT, T, DM, DM, G, bx); EpiX1 E{a.in[I_X], (const float*)(ws + WS_MOD), (bf16_t*)(ws + WS_X1B)}; pg8::gemm_phase<EpiX1, DenseSched>(lds, DM, S, E); } } SYNC(6);
    REP(7) { if (rep_) { GSYNC(); if (bx == 0 && tid < 32) ((int*)(ws + WS_CTL))[tid] = 0; GSYNC(); }
        if (IN(7)) { p5_hn2_route(a, lds, vcu, G); } } SYNC(7);
    if (IN(8) || IN(9)) {
        LAS int* tp = (LAS int*)(lds + L_CTL); const int* cnt = (const int*)(ws + WS_CTL);
        __syncthreads();
        for (int i = tid; i < 4096; i += 512) ((LAS float*)(lds + L_G2T))[i] = ((const float*)(ws + WS_MOD))[(size_t)(i >> 11) * 12288 + 10240 + (i & 2047)];
        if (tid == 0) { int s = 0; for (int e = 0; e < 32; ++e) { tp[e] = s; s += (cnt[e] + 255) >> 8; } tp[32] = s; }
        __syncthreads();
        if (tid < 192) { int e = 0; for (int q = 1; q < 32; ++q) e += (tp[q] <= tid) ? 1 : 0; ((LAS unsigned short*)(tp + 160))[tid] = (unsigned short)e; }
        __syncthreads();
    }
    if (IN(8)) { const LAS int* tp = (const LAS int*)(lds + L_CTL); const int nGU = tp[32] * 4, R = nGU / G, rem = nGU - R * G, Ne = G - rem;
        { MoeSched<4, true> S{tp, (const int*)(ws + WS_CTL), (const int*)(ws + WS_LIST), (const char*)(ws + WS_HN), (const char*)(ws + WS_WGU), DM, vcu, G, R * G};
          EpiGateUp E{(bf16_t*)(ws + WS_HEXP)}; pg8::gemm_phase<EpiGateUp, MoeSched<4, true>>(lds, DM, S, E); }
        if (rem > 0) {
            GSYNC();
            if (vcu < rem) { MoeSched<4, true> S{tp, (const int*)(ws + WS_CTL), (const int*)(ws + WS_LIST), (const char*)(ws + WS_HN), (const char*)(ws + WS_WGU), DM, R * G + vcu, G, nGU};
                EpiGateUp E{(bf16_t*)(ws + WS_HEXP)}; pg8::gemm_phase<EpiGateUp, MoeSched<4, true>>(lds, DM, S, E); }
            else if (R >= 1) { MoeSched<8, false> S{tp, (const int*)(ws + WS_CTL), (const int*)(ws + WS_LIST), (const char*)(ws + WS_HEXP), (const char*)(ws + WS_WDN), 512, vcu - rem, Ne, 2 * Ne};
                EpiDown E{(bf16_t*)(ws + WS_YS), (const int*)(ws + WS_CTL), (const int*)(ws + WS_LIST), (const float*)(ws + WS_LISTW), (const bf16_t*)(ws + WS_X1B), (const LAS float*)(lds + L_G2T)}; pg8::gemm_phase<EpiDown, MoeSched<8, false>>(lds, 512, S, E); }
        }
    } SYNC(8);
    if (IN(9)) { const LAS int* tp = (const LAS int*)(lds + L_CTL); const int nGU = tp[32] * 4, R = nGU / G, rem = nGU - R * G, Ne = G - rem;
        MoeSched<8, false> S{tp, (const int*)(ws + WS_CTL), (const int*)(ws + WS_LIST), (const char*)(ws + WS_HEXP), (const char*)(ws + WS_WDN), 512, ((rem > 0 && R >= 1) ? 2 * Ne : 0) + vcu, G, tp[32] * 8};
        EpiDown E{(bf16_t*)(ws + WS_YS), (const int*)(ws + WS_CTL), (const int*)(ws + WS_LIST), (const float*)(ws + WS_LISTW), (const bf16_t*)(ws + WS_X1B), (const LAS float*)(lds + L_G2T)}; pg8::gemm_phase<EpiDown, MoeSched<8, false>>(lds, 512, S, E); } SYNC(9);
#if REP_PHASE == 10
    if (IN(10)) { p9_final(a, vcu, G, (float*)(ws + WS_WGU)); GSYNC(); }
#endif
#if REP_PHASE == 99
    for (int q = 0; q < 20; ++q) GSYNC();
#endif
    if (IN(10)) { p9_final(a, vcu, G, a.out); }
#undef IN
#undef SYNC
}

static int g_grid = 0;
static bool setup() {
    if (g_grid) return g_grid > 0;
    int dev = 0, cus = 0, per_cu = 0;
    if (hipGetDevice(&dev) != hipSuccess || hipDeviceGetAttribute(&cus, hipDeviceAttributeMultiprocessorCount, dev) != hipSuccess) { g_grid = -1; return false; }
    if (hipFuncSetAttribute((const void*)fwd, hipFuncAttributeMaxDynamicSharedMemorySize, LDS_BYTES) != hipSuccess) { fprintf(stderr, "hipFuncSetAttribute failed\n"); g_grid = -1; return false; }
    if (hipOccupancyMaxActiveBlocksPerMultiprocessor(&per_cu, (const void*)fwd, 512, LDS_BYTES) != hipSuccess || per_cu < 1) { fprintf(stderr, "occupancy query: %d\n", per_cu); (void)hipGetLastError(); g_grid = -1; return false; }
    g_grid = cus;
    return true;
}
static void run(void* const* d_in, float* out, unsigned char* ws, hipStream_t st, int lo, int hi, bool coop) {
    if (!setup()) return;
    (void)hipMemsetAsync(ws + WS_CTL, 0, CTL_ZERO_BYTES, st);
    Args a{};
    for (int i = 0; i < 25; ++i) a.in[i] = (const float*)d_in[i];
    a.out = out; a.ws = ws;
    if (coop) { a.ph_lo = lo; a.ph_hi = hi;
        hipLaunchKernelGGL(fwd, dim3(g_grid), dim3(512), LDS_BYTES, st, a);
    } else {
        for (int p = lo; p < hi; ++p) { a.ph_lo = p; a.ph_hi = p + 1; hipLaunchKernelGGL(fwd, dim3(g_grid), dim3(512), LDS_BYTES, st, a); }
    }
}
}
#ifndef DBG_STAGE
#define DBG_STAGE 0
#endif
#ifndef N_LAUNCHES
#define N_LAUNCHES 1
#endif
#if DBG_STAGE
namespace dbg {
template <typename TIn> __global__ void k_sample(const TIn* src, int ld, int col0, int ncols, int stride, float* dst) {
    const int i = blockIdx.x; const size_t row = (size_t)i * stride;
    for (int c = threadIdx.x; c < ncols; c += blockDim.x) { float v; if (sizeof(TIn) == 2) v = __builtin_bit_cast(float, (unsigned)(*(const unsigned short*)&src[row * ld + col0 + c]) << 16); else v = (float)(*(const float*)&src[row * ld + col0 + c]); dst[(size_t)i * ncols + c] = v; }
}
__global__ void k_cmp(const float* smp, int sld, int scol0, int n, int stride, const float* ref, int ldr, int rcol0, const float* rowscale, float* acc) {
    __shared__ float r0[256], r1[256];
    const int i = blockIdx.x; const size_t row = (size_t)i * stride; const float sc = rowscale ? rowscale[row] : 1.f;
    float d2 = 0.f, f2 = 0.f;
    for (int c = threadIdx.x; c < n; c += blockDim.x) { const float r = ref[row * ldr + rcol0 + c] * sc, s = smp[(size_t)i * sld + scol0 + c]; const float d = s - r; d2 += d * d; f2 += r * r; }
    r0[threadIdx.x] = d2; r1[threadIdx.x] = f2; __syncthreads();
    for (int o = 128; o > 0; o >>= 1) { if (threadIdx.x < o) { r0[threadIdx.x] += r0[threadIdx.x + o]; r1[threadIdx.x] += r1[threadIdx.x + o]; } __syncthreads(); }
    if (threadIdx.x == 0) { atomicAdd(&acc[0], r0[0]); atomicAdd(&acc[1], r1[0]); }
}
__global__ void k_scale(float* out, const float* acc, int nchk, int raw, float tol) {
    float delta = 0.f;
    if (raw >= 0) { const float e = sqrtf(acc[2 * raw] / fmaxf(acc[2 * raw + 1], 1e-30f)); delta = 4.f * fminf(e, 2.f); if (!(e == e)) delta = 9.f; }
    else for (int i = 0; i < nchk; ++i) { const float e = sqrtf(acc[2 * i] / fmaxf(acc[2 * i + 1], 1e-30f)); if (!(e <= tol)) { delta = 0.1f * (i + 1) + 0.05f * ((e == e) ? fminf(e, 1.f) : 1.f); break; } }
    const size_t idx = (size_t)blockIdx.x * blockDim.x + threadIdx.x;
    out[idx] *= (1.f + delta);
}
struct Ctx { unsigned char* ws; float* out; float* smp; float* acc; };
#ifndef DBG_RAW
#define DBG_RAW -1
#endif
#ifndef DBG_TOL
#define DBG_TOL 0.02f
#endif
constexpr size_t SM0 = 0, SM1 = 2 * 1024 * 1024 + 65536;
static void hook(int stage, void* vctx, hipStream_t st) {
    Ctx& c = *(Ctx*)vctx; unsigned char* ws = c.ws;
    const float* bufA = (const float*)(ws + nv::W_A); const float* proj = (const float*)(ws + nv::W_B); const float* ymr = (const float*)(ws + nv::W_C);
#if DBG_STAGE == 3
    if (stage == 2) k_cmp<<<964, 256, 0, st>>>(c.smp + SM0, 2048, 0, 2048, 17, bufA, 2048, 0, nullptr, c.acc + 0);
    if (stage == 3) { k_cmp<<<529, 256, 0, st>>>(c.smp + SM1, 6144, 0, 4096, 31, proj, nv::INW, 0, nullptr, c.acc + 2);
                      k_cmp<<<529, 256, 0, st>>>(c.smp + SM1, 6144, 4096, 2048, 31, proj, nv::INW, 4104, nullptr, c.acc + 4); }
#elif DBG_STAGE == 6
    if (stage == 6) { k_cmp<<<964, 256, 0, st>>>(c.smp + SM0, 2048, 0, 1024, 17, ymr, 2048, 0, nullptr, c.acc + 0);
                      k_cmp<<<964, 256, 0, st>>>(c.smp + SM0, 2048, 1024, 1024, 17, ymr, 2048, 1024, nullptr, c.acc + 2); }
#elif DBG_STAGE == 7
    if (stage == 7) k_cmp<<<964, 256, 0, st>>>(c.smp + SM0, 2048, 0, 2048, 17, c.out, 2048, 0, nullptr, c.acc + 0);
#elif DBG_STAGE == 8
    if (stage == 8) k_cmp<<<964, 256, 0, st>>>(c.smp + SM0, 2048, 0, 2048, 17, bufA, 2048, 0, nullptr, c.acc + 0);
    if (stage == 9) { k_cmp<<<964, 256, 0, st>>>(c.smp + SM1, 4, 0, 2, 17, (const float*)(ws + nv::W_R4), 4, 0, nullptr, c.acc + 2);
                      k_cmp<<<964, 256, 0, st>>>(c.smp + SM1, 4, 2, 2, 17, (const float*)(ws + nv::W_R4), 4, 2, nullptr, c.acc + 4); }
#elif DBG_STAGE == 10
    if (stage == 10) k_cmp<<<1928, 256, 0, st>>>(c.smp + SM0, 2048, 0, 2048, 17, proj + (size_t)4 * nv::T_ * 512, 2048, 0, (const float*)(ws + nv::W_GW), c.acc + 0);
#endif
}
}
#endif

extern "C" void kernel_launch(void* const* d_in, const int* in_sizes, int n_in, void* d_out, int out_size, void* d_ws, size_t ws_size, hipStream_t stream) {
    if (n_in != 25 || ws_size < fk::WS_END) { fprintf(stderr, "kernel_launch: unexpected n_in %d / ws_size %zu\n", n_in, ws_size); return; }
    unsigned char* ws = (unsigned char*)d_ws; float* out = (float*)d_out;
#if DBG_STAGE == 0
    fk::run(d_in, out, ws, stream, 0, fk::NPHASE, N_LAUNCHES == 1);
#else
    if (ws_size < nv::W_END + 24 * nv::MiB_) { fprintf(stderr, "debug build: ws too small\n"); return; }
    float* smp = (float*)(ws + ws_size - 24 * nv::MiB_); float* acc = smp + 6 * 1024 * 1024 - 64;
    (void)hipMemsetAsync(acc, 0, 256, stream);
#if DBG_STAGE == 3
    fk::run(d_in, out, ws, stream, 0, 3, N_LAUNCHES == 1);
    dbg::k_sample<unsigned short><<<964, 256, 0, stream>>>((const unsigned short*)(ws + fk::WS_HN), 2048, 0, 2048, 17, smp + dbg::SM0);
    dbg::k_sample<unsigned short><<<529, 256, 0, stream>>>((const unsigned short*)(ws + fk::WS_PROJ), 6144, 0, 6144, 31, smp + dbg::SM1);
    const int nchk = 3;
#elif DBG_STAGE == 6
    fk::run(d_in, out, ws, stream, 0, 6, N_LAUNCHES == 1);
    dbg::k_sample<unsigned short><<<964, 256, 0, stream>>>((const unsigned short*)(ws + fk::WS_HN), 2048, 0, 2048, 17, smp + dbg::SM0);
    const int nchk = 2;
#elif DBG_STAGE == 7
    fk::run(d_in, out, ws, stream, 0, 7, N_LAUNCHES == 1);
    dbg::k_sample<float><<<964, 256, 0, stream>>>(out, 2048, 0, 2048, 17, smp + dbg::SM0);
    const int nchk = 1;
#elif DBG_STAGE == 8
    fk::run(d_in, out, ws, stream, 0, 8, N_LAUNCHES == 1);
    dbg::k_sample<unsigned short><<<964, 256, 0, stream>>>((const unsigned short*)(ws + fk::WS_HN), 2048, 0, 2048, 17, smp + dbg::SM0);
    dbg::k_sample<float><<<964, 256, 0, stream>>>((const float*)(ws + fk::WS_ROUTE), 4, 0, 4, 17, smp + dbg::SM1);
    const int nchk = 3;
#elif DBG_STAGE == 10
    fk::run(d_in, out, ws, stream, 0, 10, N_LAUNCHES == 1);
    dbg::k_sample<unsigned short><<<1928, 256, 0, stream>>>((const unsigned short*)(ws + fk::WS_YS), 2048, 0, 2048, 17, smp + dbg::SM0);
    const int nchk = 1;
#endif
    nv::In I; { const float** p = (const float**)&I; for (int i = 0; i < 25; ++i) p[i] = (const float*)d_in[i]; }
    dbg::Ctx ctx{ws, out, smp, acc};
    nv::run(I, out, ws, stream, dbg::hook, &ctx);
    dbg::k_scale<<<(fk::T * fk::DM) / 256, 256, 0, stream>>>(out, acc, nchk, DBG_RAW, DBG_TOL);
#endif
}
```

```cpp
#define DBG_STAGE 0
#define N_LAUNCHES 1
#define DBG_RAW -1
#include <hip/hip_runtime.h>
#include <hip/hip_cooperative_groups.h>
#include <cstdio>
#include <cstdint>
#include <cmath>
#define LAS __attribute__((address_space(3)))
#define GAS __attribute__((address_space(1)))
typedef unsigned short bf16_t;
typedef short bf16x8 __attribute__((ext_vector_type(8)));
typedef float f32x4 __attribute__((ext_vector_type(4)));
typedef float f32x2 __attribute__((ext_vector_type(2)));
typedef float f32x16 __attribute__((ext_vector_type(16)));
typedef unsigned u32x4 __attribute__((ext_vector_type(4)));
typedef unsigned u32x2 __attribute__((ext_vector_type(2)));

__device__ __forceinline__ unsigned f2bf(float f) { unsigned u = __builtin_bit_cast(unsigned, f); return (u + 0x7fffu + ((u >> 16) & 1u)) >> 16; }
__device__ __forceinline__ unsigned pk2(float lo, float hi) { return f2bf(lo) | (f2bf(hi) << 16); }
__device__ __forceinline__ float bflo(unsigned u) { return __builtin_bit_cast(float, u << 16); }
__device__ __forceinline__ float bfhi(unsigned u) { return __builtin_bit_cast(float, u & 0xffff0000u); }
__device__ __forceinline__ float bf1(bf16_t b) { return __builtin_bit_cast(float, (unsigned)b << 16); }
__device__ __forceinline__ float wave_sum(float v) {
#pragma unroll
    for (int o = 1; o < 64; o <<= 1) v += __shfl_xor(v, o);
    return v;
}
__device__ __forceinline__ float frcp(float x) { return __builtin_amdgcn_rcpf(x); }
__device__ __forceinline__ float fsigmoid(float x) { return frcp(1.f + __expf(-x)); }
__device__ __forceinline__ float fsilu(float x) { return x * frcp(1.f + __expf(-x)); }
__device__ __forceinline__ float flogsigmoid(float x) { return fminf(x, 0.f) - log1pf(expf(-fabsf(x))); }
__device__ __forceinline__ float fgelu_tanh(float x) { const float u = 0.7978845608028654f * (x + 0.044715f * x * x * x); const float e = __expf(2.f * u); const float th = 1.f - 2.f * frcp(e + 1.f); return 0.5f * x * (1.f + th); }
template <int CTRL, int ROW_MASK> __device__ __forceinline__ float dpp_add(float x) { const int v = __builtin_amdgcn_update_dpp(0, __builtin_bit_cast(int, x), CTRL, ROW_MASK, 0xf, true); return x + __builtin_bit_cast(float, v); }
__device__ __forceinline__ float half_sum31(float x) {
    x = dpp_add<0x111, 0xf>(x);
    x = dpp_add<0x112, 0xf>(x);
    x = dpp_add<0x114, 0xf>(x);
    x = dpp_add<0x118, 0xf>(x);
    x = dpp_add<0x142, 0xa>(x);
    return x;
}

namespace pg8 {
constexpr int BM = 256, BK = 64, HALF = 128, HTB = HALF * BK * 2  , STAGE_BYTES = 8 * HTB, NXCD = 8, WGM = 8;
__host__ __device__ __forceinline__ int lds_byte(int r, int c) { const int st = (r >> 4) * 2 + (c >> 5), rr = r & 15, cc = c & 31, ob = rr * 64 + cc * 2; return st * 1024 + (ob ^ (((ob >> 9) & 1) << 5)); }
__host__ __device__ __forceinline__ void stage_rc(int b, int& R, int& C) { const int st = b / 1024, sb = b % 1024, swz = sb ^ (((sb >> 9) & 1) << 5); R = (st >> 1) * 16 + swz / 64; C = (st & 1) * 32 + (swz % 64) / 2; }
__host__ __device__ __forceinline__ int perm32(int rho) { const int n = rho >> 4, i = rho & 15; return 8 * (i >> 2) + 4 * n + (i & 3); }

struct Unit { int pm, pn, e, mt; };

template <class Epi, class Sched>
__device__ __forceinline__ void gemm_phase(LAS unsigned char* lds, const int K, const Sched& S, const Epi& E) {
    int tid_o = threadIdx.x; asm volatile("" : "+v"(tid_o));
    const int tid = tid_o, wid = __builtin_amdgcn_readfirstlane(tid >> 6), lane = tid & 63, wr = wid >> 2, wc = wid & 3, fr = lane & 15, fq = lane >> 4;
    const int nt = K / BK;
    int Rr[2], Cc[2]; unsigned voffB[2];
#pragma unroll
    for (int i = 0; i < 2; ++i) { stage_rc(tid * 16 + i * 8192, Rr[i], Cc[i]); const int Rb = Epi::PERM ? ((Rr[i] & ~31) + perm32(Rr[i] & 31)) : Rr[i]; voffB[i] = (unsigned)(Rb * K + Cc[i]) * 2u; }
    const size_t kstep = (size_t)(BK * 2);
    const size_t hstep = (size_t)HALF * K * 2;
    const unsigned ldsw = (unsigned)wid * 1024u;
    const int aoff = lds_byte(wr * 64 + fr, fq * 8), boff = lds_byte(wc * 32 + fr, fq * 8);
#define PG8_SA(b, h) (((b) * 2 + (h)) * HTB)
#define PG8_SB(b, h) ((4 + (b) * 2 + (h)) * HTB)
#define PG8_STAGE(bufoff, gbase, voff) do { const char* _gb = (const char*)(gbase); asm volatile("" : "+s"(_gb));     \
        _Pragma("unroll") for (int _i = 0; _i < 2; ++_i) \
        __builtin_amdgcn_global_load_lds((const unsigned*)(_gb + (voff)[_i]), (LAS unsigned*)(lds + (bufoff) + ldsw + _i * 8192), 16, 0, 0); } while (0)
#define PG8_LDA(dst, b, h) do { _Pragma("unroll") for (int m = 0; m < 4; ++m) _Pragma("unroll") for (int k = 0; k < 2; ++k) dst[m][k] = *(const LAS bf16x8*)(lds + PG8_SA(b, h) + aoff + m * 2048 + k * 1024); } while (0)
#define PG8_LDB(dst, b, h) do { _Pragma("unroll") for (int n = 0; n < 2; ++n) _Pragma("unroll") for (int k = 0; k < 2; ++k) dst[n][k] = *(const LAS bf16x8*)(lds + PG8_SB(b, h) + boff + n * 2048 + k * 1024); } while (0)
#define PG8_MMA(ai, bj, At, Bt) do { __builtin_amdgcn_s_setprio(1); _Pragma("unroll") for (int m = 0; m < 4; ++m) _Pragma("unroll") for (int n = 0; n < 2; ++n) _Pragma("unroll") for (int k = 0; k < 2; ++k) \
        acc[ai][bj][m][n] = __builtin_amdgcn_mfma_f32_16x16x32_bf16(Bt[n][k], At[m][k], acc[ai][bj][m][n], 0, 0, 0); __builtin_amdgcn_s_setprio(0); } while (0)
#define PG8_WAIT_V(n) asm volatile("s_waitcnt vmcnt(" #n ")" ::: "memory")
#define PG8_WAIT_L(n) asm volatile("s_waitcnt lgkmcnt(" #n ")" ::: "memory")
#define PG8_BAR __builtin_amdgcn_s_barrier()
#define PG8_SCHED __builtin_amdgcn_sched_barrier(0)
    Unit cur, nxt; int ui = 0;
    if (!S.next(0, cur)) return;
    f32x4 acc[2][2][4][2];
#pragma unroll
    for (int a = 0; a < 2; ++a)
#pragma unroll
        for (int b = 0; b < 2; ++b)
#pragma unroll
            for (int m = 0; m < 4; ++m)
#pragma unroll
                for (int n = 0; n < 2; ++n) acc[a][b][m][n] = (f32x4){0.f, 0.f, 0.f, 0.f};
    bf16x8 At[4][2], B0[2][2], B1[2][2];
    unsigned vA[2][2], nvA[2][2];
    typename Epi::State est; E.pre(est, cur, wr, fr);
    S.a_off(cur, Rr, Cc, K, vA);
    const char* cA = S.a_base(cur); const char* cB = S.b_base(cur);
    PG8_STAGE(PG8_SB(0, 0), cB, voffB); PG8_STAGE(PG8_SB(0, 1), cB + hstep, voffB); PG8_STAGE(PG8_SA(0, 0), cA, vA[0]); PG8_STAGE(PG8_SA(0, 1), cA, vA[1]);
    if (wr == 1) PG8_BAR;
    PG8_WAIT_V(2); PG8_BAR;
    PG8_STAGE(PG8_SB(1, 0), cB + kstep, voffB); PG8_STAGE(PG8_SA(1, 0), cA + kstep, vA[0]); PG8_STAGE(PG8_SB(1, 1), cB + hstep + kstep, voffB);
    PG8_WAIT_V(6); PG8_BAR;
    for (;;) {
        const bool has_next = S.next(ui + 1, nxt);
        if (!has_next) nxt = cur;
        const char* nA = S.a_base(nxt); const char* nB = S.b_base(nxt);
        S.a_off(nxt, Rr, Cc, K, nvA);
        for (int t = 0; t < nt; t += 2) {
            const bool last = (t == nt - 2);
            const char* a1 = cA + (size_t)(t + 1) * kstep;
            const char* a2 = last ? nA : cA + (size_t)(t + 2) * kstep; const char* b2 = last ? nB : cB + (size_t)(t + 2) * kstep;
            const char* a3 = a2 + kstep; const char* b3 = b2 + kstep;
            unsigned w0[2], w1[2];
#pragma unroll
            for (int i = 0; i < 2; ++i) { w0[i] = last ? nvA[0][i] : vA[0][i]; w1[i] = last ? nvA[1][i] : vA[1][i]; }
            PG8_LDB(B0, 0, 0); PG8_LDB(B1, 0, 1); PG8_SCHED; PG8_LDA(At, 0, 0); PG8_STAGE(PG8_SA(1, 1), a1, vA[1]);
            PG8_WAIT_V(8); PG8_WAIT_L(0); PG8_BAR; PG8_MMA(0, 0, At, B0); PG8_MMA(0, 1, At, B1); PG8_BAR; PG8_SCHED;
            PG8_LDA(At, 0, 1); PG8_STAGE(PG8_SB(0, 0), b2, voffB); PG8_STAGE(PG8_SB(0, 1), b2 + hstep, voffB); PG8_STAGE(PG8_SA(0, 0), a2, w0);
            PG8_WAIT_V(8); PG8_WAIT_L(0); PG8_BAR; PG8_MMA(1, 0, At, B0); PG8_MMA(1, 1, At, B1); PG8_BAR; PG8_SCHED;
            PG8_LDB(B0, 1, 0); PG8_LDB(B1, 1, 1); PG8_SCHED; PG8_LDA(At, 1, 0); PG8_STAGE(PG8_SA(0, 1), a2, w1);
            PG8_WAIT_V(8); PG8_WAIT_L(0); PG8_BAR; PG8_MMA(0, 0, At, B0); PG8_MMA(0, 1, At, B1); PG8_BAR; PG8_SCHED;
            PG8_LDA(At, 1, 1); PG8_STAGE(PG8_SB(1, 0), b3, voffB); PG8_STAGE(PG8_SB(1, 1), b3 + hstep, voffB); PG8_STAGE(PG8_SA(1, 0), a3, w0);
            PG8_WAIT_V(8); PG8_WAIT_L(0); PG8_BAR; PG8_MMA(1, 0, At, B0); PG8_MMA(1, 1, At, B1); PG8_BAR; PG8_SCHED;
        }
        if (wr == 0) PG8_BAR;
        E(acc, cur, wr, wc, fr, fq, est);
        if (!has_next) break;
#pragma unroll
        for (int a = 0; a < 2; ++a)
#pragma unroll
            for (int b = 0; b < 2; ++b)
#pragma unroll
                for (int m = 0; m < 4; ++m)
#pragma unroll
                    for (int n = 0; n < 2; ++n) acc[a][b][m][n] = (f32x4){0.f, 0.f, 0.f, 0.f};
        cur = nxt; cA = nA; cB = nB; ++ui; E.pre(est, cur, wr, fr);
#pragma unroll
        for (int h = 0; h < 2; ++h)
#pragma unroll
            for (int i = 0; i < 2; ++i) vA[h][i] = nvA[h][i];
        if (wr == 1) PG8_BAR;
    }
    PG8_WAIT_V(0);
    PG8_BAR;
#undef PG8_SA
#undef PG8_SB
#undef PG8_STAGE
#undef PG8_LDA
#undef PG8_LDB
#undef PG8_MMA
#undef PG8_WAIT_V
#undef PG8_WAIT_L
#undef PG8_BAR
#undef PG8_SCHED
}
}
namespace fk {
constexpr int T = 16384, SEQ = 8192, DM = 2048, NPROJ = 6144, INW = 6152;
constexpr float EPS = 1e-6f;
constexpr size_t MiB = 1u << 20, KiB = 1u << 10;
constexpr size_t WS_CTL = 0, WS_DONE = 1024, WS_BAR = 4096, CTL_ZERO_BYTES = 32768;
constexpr int NKS = 16;
constexpr size_t WS_MODP = 619 * MiB;
constexpr size_t WS_MOD = 2 * MiB;
constexpr size_t WS_WG8 = 2 * MiB + 256 * KiB;
constexpr size_t WS_WRH = 2 * MiB + 512 * KiB, WS_WRL = WS_WRH + 192 * KiB;
constexpr size_t WS_GTB = 3 * MiB, WS_GTW = 3 * MiB + 256 * KiB, WS_GTA = 3 * MiB + 512 * KiB;
constexpr size_t WS_BLAST = 3 * MiB + 768 * KiB, WS_ALAST = WS_BLAST + 4 * KiB, WS_DTOT = WS_BLAST + 8 * KiB, WS_CVEC = WS_BLAST + 9 * KiB;
constexpr size_t WS_LNS = 4 * MiB;
constexpr size_t WS_LRUA = 4 * MiB + 256 * KiB, WS_LRUH = 4 * MiB + 512 * KiB, WS_LRUC = 4 * MiB + 768 * KiB;
constexpr size_t WS_ROUTE = 5 * MiB;
constexpr size_t WS_LIST = 6 * MiB;
constexpr size_t WS_LW = 2 * MiB + 896 * KiB;
constexpr size_t WS_LISTW = 553 * MiB;
constexpr size_t WS_WLRU = 8 * MiB;
constexpr size_t WS_WIN = 9 * MiB;
constexpr size_t WS_WOUT = 33 * MiB;
constexpr size_t WS_WGU = 41 * MiB;
constexpr size_t WS_WDN = 169 * MiB;
constexpr size_t WS_HN = 233 * MiB;
constexpr size_t WS_PROJ = 297 * MiB;
constexpr size_t WS_HEXP = WS_PROJ, WS_YS = WS_PROJ + 40 * MiB;
constexpr size_t WS_LST = 489 * MiB;
constexpr size_t WS_X1B = WS_LST;
constexpr size_t WS_HLOC = 555 * MiB, WS_ACUM = 587 * MiB;
constexpr size_t WS_KC = 621 * MiB;
constexpr size_t WS_END = 653 * MiB;
constexpr int LDS_BYTES = 163840;
constexpr int L_CTL = 160 * 1024 - 1024;

struct Args { const float* in[25]; float* out; unsigned char* ws; int ph_lo, ph_hi; };
enum { I_X = 0, I_C, I_WADA, I_BADA, I_WIN, I_BGATES, I_CONVQK, I_MHG, I_LCW, I_LCB, I_WLA, I_BLA, I_WLX, I_BLX, I_LAM, I_LNG, I_WOUT, I_WGRP, I_BGRP, I_WRT, I_BRT, I_WEG, I_WEU, I_WED, I_FG };

#define LDS_WAIT() asm volatile("s_waitcnt lgkmcnt(0)" ::: "memory")
#define NT_LD(p) __builtin_nontemporal_load(p)
#define NT_ST(v, p) __builtin_nontemporal_store(v, p)
typedef __bf16 bf16x2_t __attribute__((ext_vector_type(2)));
__device__ __forceinline__ unsigned cvtpk(float lo, float hi) { f32x2 v = {lo, hi}; bf16x2_t b = __builtin_convertvector(v, bf16x2_t); return __builtin_bit_cast(unsigned, b); }

__device__ __forceinline__ int wr_frag_index(int c, int k) { const int w = k >> 8, st = (k >> 5) & 7, kq = (k >> 3) & 3, j = k & 7, nt = c >> 4, fr = c & 15; return ((((w * 8 + st) * 3 + nt) * 64 + 16 * kq + fr) * 8) + j; }
struct TrItem { const float* W; bf16_t* WT; int ldw, ldt; };
__device__ __forceinline__ void tr_load(const TrItem& t, f32x4 (&v)[16], int lane) {
#pragma unroll
    for (int i = 0; i < 16; ++i) v[i] = NT_LD((const f32x4*)(t.W + (size_t)(4 * i + (lane >> 4)) * t.ldw + (lane & 15) * 4));
}
__device__ __forceinline__ void tr_store(const TrItem& t, const f32x4 (&v)[16], LAS float* scr, int lane) {
#pragma unroll
    for (int i = 0; i < 16; ++i) { LAS float* sp = scr + (4 * i + (lane >> 4)) * 65 + (lane & 15) * 4; sp[0] = v[i].x; sp[1] = v[i].y; sp[2] = v[i].z; sp[3] = v[i].w; }
    LDS_WAIT(); asm volatile("" ::: "memory");
#pragma unroll
    for (int j = 0; j < 8; ++j) { const int pair = lane + 64 * j, c = pair & 7, n = pair >> 3; const LAS float* s = scr + (8 * c) * 65 + n;
        u32x4 o; o.x = cvtpk(s[0 * 65], s[1 * 65]); o.y = cvtpk(s[2 * 65], s[3 * 65]); o.z = cvtpk(s[4 * 65], s[5 * 65]); o.w = cvtpk(s[6 * 65], s[7 * 65]);
        NT_ST(o, (u32x4*)(t.WT + (size_t)n * t.ldt + 8 * c)); }
    LDS_WAIT(); asm volatile("" ::: "memory");
}
constexpr int TR_IN = 32 * 96, TR_OUT = 32 * 32, TR_L = 64, TR_G = 32 * 256, TR_U = TR_G, TR_D = 32 * 256;
#ifndef TR_KEEP
#define TR_KEEP 0
#endif
constexpr int TR_EARLY = TR_IN + TR_L + TR_KEEP, TR_ALL = TR_IN + TR_OUT + TR_L + TR_G + TR_U + TR_D;
__device__ __forceinline__ TrItem tr_mk(const float* W, int ldw, int k0, int n0src, bf16_t* WT, int ldt, int rowdst0) { TrItem t; t.W = W + (size_t)k0 * ldw + n0src; t.WT = WT + (size_t)rowdst0 * ldt + k0; t.ldw = ldw; t.ldt = ldt; return t; }
__device__ __forceinline__ TrItem tr_decode(const Args& a, int it) {
    unsigned char* ws = a.ws; int r = it;
    if (r < TR_IN) { const int kb = r / 96, nb = r % 96, n0 = 64 * nb; return tr_mk(a.in[I_WIN], INW, 64 * kb, n0 + (n0 >= 4096 ? 8 : 0), (bf16_t*)(ws + WS_WIN), 2048, n0); } r -= TR_IN;
    if (r < TR_L) { const int mi = r / 4, q = r % 4, kb = q / 2, nb = q % 2, n = mi >> 1, g = mi & 1;
        return tr_mk((g ? a.in[I_WLX] : a.in[I_WLA]) + (size_t)n * 16384, 128, 64 * kb, 64 * nb, (bf16_t*)(ws + WS_WLRU), 128, (n * 2 + g) * 128 + 64 * nb); } r -= TR_L;
    if (r < TR_OUT) { const int kb = r / 32, nb = r % 32; return tr_mk(a.in[I_WOUT], 2048, 64 * kb, 64 * nb, (bf16_t*)(ws + WS_WOUT), 2048, 64 * nb); } r -= TR_OUT;
    if (r < TR_G) { const int e = r / 256, q = r % 256, kb = q / 8, nb = q % 8, n0 = 64 * nb;
        return tr_mk(a.in[I_WEG] + (size_t)e * 2048 * 512, 512, 64 * kb, n0, (bf16_t*)(ws + WS_WGU), 2048, e * 1024 + (n0 / 128) * 256 + (n0 % 128)); } r -= TR_G;
    if (r < TR_U) { const int e = r / 256, q = r % 256, kb = q / 8, nb = q % 8, n0 = 64 * nb;
        return tr_mk(a.in[I_WEU] + (size_t)e * 2048 * 512, 512, 64 * kb, n0, (bf16_t*)(ws + WS_WGU), 2048, e * 1024 + (n0 / 128) * 256 + 128 + (n0 % 128)); } r -= TR_U;
    { const int e = r / 256, q = r % 256, kb = q / 32, nb = q % 32;
        return tr_mk(a.in[I_WED] + (size_t)e * 512 * 2048, 2048, 64 * kb, 64 * nb, (bf16_t*)(ws + WS_WDN), 512, e * 2048 + 64 * nb); }
}
__device__ __forceinline__ void p2_convert(const Args& a, LAS unsigned char* lds, int cw, int ncw, int it_lo, int it_hi) {
    int tid_o = threadIdx.x; asm volatile("" : "+v"(tid_o));
    const int lane = tid_o & 63, wave = __builtin_amdgcn_readfirstlane(tid_o >> 6);
    LAS float* scr = (LAS float*)(lds + wave * 16896);
    int it = __builtin_amdgcn_readfirstlane(it_lo + cw); if (it >= it_hi) return;
    f32x4 va[16], vb[16]; TrItem ta = tr_decode(a, it), tb = ta; tr_load(ta, va, lane);
#pragma unroll 1
    for (;;) {
        it += ncw; const bool hb = it < it_hi; if (hb) { tb = tr_decode(a, it); tr_load(tb, vb, lane); }
        tr_store(ta, va, scr, lane); if (!hb) break;
        it += ncw; const bool ha = it < it_hi; if (ha) { ta = tr_decode(a, it); tr_load(ta, va, lane); }
        tr_store(tb, vb, scr, lane); if (!ha) break;
    }
}
__device__ __forceinline__ void p0_prologue(const Args& a, LAS unsigned char* lds, int vcu, int G, int nconv) {
    int tid_o = threadIdx.x; asm volatile("" : "+v"(tid_o));
    const int tid = tid_o, lane = tid & 63, wave = __builtin_amdgcn_readfirstlane(tid >> 6);
    LAS float* scr = (LAS float*)(lds + wave * 16896);
    const int gw = vcu * 8 + wave, NGW = G * 8;
    unsigned char* ws = a.ws;
    const int gt = vcu * 512 + tid, NGT = G * 512;
    float* wg8 = (float*)(ws + WS_WG8); bf16_t* wrh = (bf16_t*)(ws + WS_WRH); bf16_t* wrl = (bf16_t*)(ws + WS_WRL);
    float pre_g = 0.f, pre_r = 0.f;
    if (gt < 8 * 2048) { const int g = gt >> 11, k = gt & 2047; pre_g = a.in[I_WIN][(size_t)k * INW + 4096 + g]; }
    if (gt < 48 * 2048) { const int c = gt >> 11, k = gt & 2047; pre_r = c < 4 ? a.in[I_WGRP][k * 4 + c] : (c < 36 ? a.in[I_WRT][k * 32 + (c - 4)] : 0.f); }
    constexpr int NTASK = 48 * NKS, KPT = 2048 / NKS;
    const int nGw = (3 * G < NTASK) ? 3 * G : NTASK;
    const bool isG = wave < 3 && (vcu * 3 + wave) < NTASK;
    if (wave < 3) for (int task = vcu * 3 + wave; task < NTASK; task += 3 * G) {
        const int cg = task % 48, ks = task / 48, n = cg * 256 + lane * 4;
        const float* c = a.in[I_C]; const float* wada = a.in[I_WADA];
        f32x4 a0 = {0.f, 0.f, 0.f, 0.f}, a1 = {0.f, 0.f, 0.f, 0.f};
#pragma unroll 1
        for (int k0 = ks * KPT; k0 < ks * KPT + KPT; k0 += 16) { f32x4 w[16];
#pragma unroll
            for (int q = 0; q < 16; ++q) w[q] = NT_LD((const f32x4*)(wada + (size_t)(k0 + q) * 12288 + n));
#pragma unroll
            for (int q = 0; q < 16; ++q) { const float s0 = fsilu(c[k0 + q]), s1 = fsilu(c[2048 + k0 + q]); a0 += s0 * w[q]; a1 += s1 * w[q]; } }
        float* modp = (float*)(ws + WS_MODP);
        *(f32x4*)(modp + (size_t)(ks * 2 + 0) * 12288 + n) = a0; *(f32x4*)(modp + (size_t)(ks * 2 + 1) * 12288 + n) = a1;
    }
    const int NITEMS = nconv ? TR_EARLY : TR_ALL;
    const int N1 = (G == 256) ? (nconv ? 0 : 10 * NGW) : NITEMS;
    const int before = (3 * vcu + (wave < 3 ? wave : 3)) < nGw ? (3 * vcu + (wave < 3 ? wave : 3)) : nGw;
    const int it2_0 = N1 + (gw - before), it2_s = NGW - nGw;
    for (int pass = 0; pass < 2; ++pass)
    for (int it = pass ? it2_0 : gw; it < (pass ? NITEMS : N1); it += (pass ? it2_s : NGW)) {
        if (pass && isG) break;
        TrItem t = tr_decode(a, it); f32x4 v[16]; tr_load(t, v, lane); tr_store(t, v, scr, lane);
    }
    if (gt < 8 * 2048) wg8[gt] = pre_g;
    if (gt < 48 * 2048) { const unsigned hi = f2bf(pre_r); const int fi = wr_frag_index(gt >> 11, gt & 2047); wrh[fi] = (bf16_t)hi; wrl[fi] = (bf16_t)f2bf(pre_r - bf1((bf16_t)hi)); }
    for (int i = gt + NGT; i < 8 * 2048; i += NGT) { const int g = i >> 11, k = i & 2047; wg8[i] = a.in[I_WIN][(size_t)k * INW + 4096 + g]; }
    for (int i = gt + NGT; i < 48 * 2048; i += NGT) { const int c = i >> 11, k = i & 2047; const float w = c < 4 ? a.in[I_WGRP][k * 4 + c] : (c < 36 ? a.in[I_WRT][k * 32 + (c - 4)] : 0.f);
        const unsigned hi = f2bf(w); const int fi = wr_frag_index(c, k); wrh[fi] = (bf16_t)hi; wrl[fi] = (bf16_t)f2bf(w - bf1((bf16_t)hi)); }
}

__device__ __forceinline__ void p1_hn_gates(const Args& a, LAS unsigned char* lds, int vcu, int G) {
    int tid_o = threadIdx.x; asm volatile("" : "+v"(tid_o));
    const int tid = tid_o, lane = tid & 63, wave = __builtin_amdgcn_readfirstlane(tid >> 6);
    unsigned char* ws = a.ws;
    LAS float* modv = (LAS float*)lds;
    LAS float* wgs = (LAS float*)(lds + 16384);
    LAS float* gts = (LAS float*)(lds + 16384 + 65536);
    const float* modp = (const float*)(ws + WS_MODP); const float* bada = a.in[I_BADA];
    {
        const f32x4* src = (const f32x4*)(ws + WS_WG8); f32x4 t[8];
#pragma unroll
        for (int q = 0; q < 8; ++q) t[q] = src[tid + 512 * q];
#pragma unroll
        for (int q = 0; q < 8; ++q) *(LAS f32x4*)(wgs + 4 * (tid + 512 * q)) = t[q];
    }
    for (int ch = vcu; ch < 256; ch += G) {
        const int b = ch >> 7;
        __syncthreads();
        {
            f32x4 acc[2], t[2][NKS];
#pragma unroll
            for (int h = 0; h < 2; ++h) { acc[h] = ((const f32x4*)bada)[tid + 512 * h];
#pragma unroll
                for (int ks = 0; ks < NKS; ++ks) t[h][ks] = ((const f32x4*)(modp + (size_t)(ks * 2 + b) * 12288))[tid + 512 * h]; }
#pragma unroll
            for (int h = 0; h < 2; ++h) {
#pragma unroll
                for (int ks = 0; ks < NKS; ++ks) acc[h] += t[h][ks];
                *(LAS f32x4*)(modv + 4 * (tid + 512 * h)) = acc[h]; }
        }
        if (tid < 96) { const int o = ch * 96 + tid, bb = o / 12288, col = o % 12288; float v = bada[col]; for (int ks = 0; ks < NKS; ++ks) v += modp[(size_t)(ks * 2 + bb) * 12288 + col]; ((float*)(ws + WS_MOD))[o] = v; }
        __syncthreads();
#define P1_LOAD(V, bi) do { _Pragma("unroll") for (int r = 0; r < 2; ++r) { const f32x4* xr = (const f32x4*)(a.in[I_X] + (size_t)(ch * 64 + wave * 8 + 2 * (bi) + r) * DM) + lane; \
            _Pragma("unroll") for (int j = 0; j < 8; ++j) V[r][j] = NT_LD(xr + 64 * j); } } while (0)
#define P1_PROC(V, bi) do { const int rowb = ch * 64 + wave * 8 + 2 * (bi); float rs[2]; \
            _Pragma("unroll") for (int r = 0; r < 2; ++r) { float s = 0.f; \
                _Pragma("unroll") for (int j = 0; j < 8; ++j) s += (V[r][j].x * V[r][j].x + V[r][j].y * V[r][j].y) + (V[r][j].z * V[r][j].z + V[r][j].w * V[r][j].w); \
                rs[r] = rsqrtf(wave_sum(s) * (1.f / DM) + EPS); } \
            _Pragma("unroll") for (int j = 0; j < 8; ++j) { const f32x4 sh = *(const LAS f32x4*)(modv + 4 * lane + 256 * j), sc = *(const LAS f32x4*)(modv + 2048 + 4 * lane + 256 * j) + 1.f; \
                _Pragma("unroll") for (int r = 0; r < 2; ++r) { V[r][j] = V[r][j] * rs[r] * sc + sh; \
                    u32x2* o8 = (u32x2*)((bf16_t*)(ws + WS_HN) + (size_t)(rowb + r) * DM) + lane; o8[64 * j] = (u32x2){cvtpk(V[r][j].x, V[r][j].y), cvtpk(V[r][j].z, V[r][j].w)}; } } \
            float gv[2] = {0.f, 0.f}; \
            _Pragma("unroll") for (int g = 0; g < 8; ++g) { float p[2] = {0.f, 0.f}; \
                _Pragma("unroll") for (int j = 0; j < 8; ++j) { const f32x4 w = *(const LAS f32x4*)(wgs + g * 2048 + 4 * lane + 256 * j); \
                    _Pragma("unroll") for (int r = 0; r < 2; ++r) p[r] += (V[r][j].x * w.x + V[r][j].y * w.y) + (V[r][j].z * w.z + V[r][j].w * w.w); } \
                _Pragma("unroll") for (int r = 0; r < 2; ++r) { const float q = wave_sum(p[r]); if (lane == g) gv[r] = q; } } \
            _Pragma("unroll") for (int r = 0; r < 2; ++r) if (lane < 8) gts[(wave * 8 + 2 * (bi) + r) * 8 + lane] = gv[r]; } while (0)
        {
            f32x4 va[2][8], vb[2][8];
            P1_LOAD(va, 0);
            P1_LOAD(vb, 1); __builtin_amdgcn_sched_barrier(0); P1_PROC(va, 0); __builtin_amdgcn_sched_barrier(0);
            P1_LOAD(va, 2); __builtin_amdgcn_sched_barrier(0); P1_PROC(vb, 1); __builtin_amdgcn_sched_barrier(0);
            P1_LOAD(vb, 3); __builtin_amdgcn_sched_barrier(0); P1_PROC(va, 2); __builtin_amdgcn_sched_barrier(0);
            P1_PROC(vb, 3);
        }
#undef P1_LOAD
#undef P1_PROC
        __syncthreads();
        if (wave < 4) {
            const int h = wave, row = ch * 64 + lane; const float* bg = a.in[I_BGATES];
            const float ig = gts[lane * 8 + h] + bg[h]; const float lf = flogsigmoid(gts[lane * 8 + 4 + h] + bg[4 + h]);
            float bc = lf;
#pragma unroll
            for (int o = 1; o < 64; o <<= 1) { const float t = __shfl_up(bc, o); if (lane >= o) bc += t; }
            const float w = ig - bc; float am = w;
#pragma unroll
            for (int o = 1; o < 64; o <<= 1) { const float t = __shfl_up(am, o); if (lane >= o) am = fmaxf(am, t); }
            ((float*)(ws + WS_GTB))[row * 4 + h] = bc; ((float*)(ws + WS_GTW))[row * 4 + h] = w; ((float*)(ws + WS_GTA))[row * 4 + h] = am;
            if (lane == 63) { const int bh = b * 4 + h, c = ch & 127; ((float*)(ws + WS_BLAST))[bh * 128 + c] = bc; ((float*)(ws + WS_ALAST))[bh * 128 + c] = am; }
        }
    }
    __syncthreads();
}

struct DenseSched {
    static constexpr bool GATHER = false;
    const char* A; const char* Bt; int K, nM, nN, nwg, G, c;
    __device__ __forceinline__ void init(const void* A_, const void* Bt_, int M, int N, int K_, int G_, int c_) { A = (const char*)A_; Bt = (const char*)Bt_; K = K_; nM = M / 256; nN = N / 256; nwg = nM * nN; G = G_; c = c_; }
    __device__ __forceinline__ bool next(int i, pg8::Unit& u) const {
#ifdef P2_DUP
        if (K == 2048 && nN == 24) { const int cnt = (nwg - c + G - 1) / G; if (i >= 2 * cnt) return false; if (i >= cnt) i -= cnt; }
#endif
        const long L = (long)i * G + c; if (L >= nwg) return false;
        int wgid = (int)L; { const int q = nwg / 8, r = nwg % 8, xcd = wgid % 8, off = wgid / 8; wgid = (xcd < r ? xcd * (q + 1) : r * (q + 1) + (xcd - r) * q) + off; }
        const int nig = 8 * nN, gid = wgid / nig, fm = gid * 8, gsz = (nM - fm) < 8 ? (nM - fm) : 8;
        u.pm = fm + ((wgid % nig) % gsz); u.pn = (wgid % nig) / gsz; u.e = 0; u.mt = 0; return true;
    }
    __device__ __forceinline__ const char* a_base(const pg8::Unit& u) const { return A + (size_t)u.pm * 256 * K * 2; }
    __device__ __forceinline__ const char* b_base(const pg8::Unit& u) const { return Bt + (size_t)u.pn * 256 * K * 2; }
    __device__ __forceinline__ void a_off(const pg8::Unit&, const int (&R)[2], const int (&C)[2], int K_, unsigned (&v)[2][2]) const {
#pragma unroll
        for (int h = 0; h < 2; ++h)
#pragma unroll
            for (int i = 0; i < 2; ++i) v[h][i] = (unsigned)((128 * h + R[i]) * K_ + C[i]) * 2u;
    }
};
#define EPI_NOSTATE struct State {}; __device__ __forceinline__ void pre(State&, const pg8::Unit&, int, int) const {}
struct EpiProj {
    static constexpr bool PERM = true; EPI_NOSTATE
    bf16_t* O; int ldc;
    __device__ __forceinline__ void operator()(const f32x4 (&acc)[2][2][4][2], const pg8::Unit& u, int wr, int wc, int fr, int fq, const State& est) const {
        const int row0 = u.pm * 256 + wr * 64 + fr, col0 = u.pn * 256 + wc * 32 + 8 * fq;
#pragma unroll
        for (int ai = 0; ai < 2; ++ai)
#pragma unroll
            for (int m = 0; m < 4; ++m) { bf16_t* rowp = O + (size_t)(row0 + ai * 128 + m * 16) * ldc + col0;
#pragma unroll
                for (int bj = 0; bj < 2; ++bj) { const f32x4 v0 = acc[ai][bj][m][0], v1 = acc[ai][bj][m][1];
                    u32x4 w; w.x = cvtpk(v0[0], v0[1]); w.y = cvtpk(v0[2], v0[3]); w.z = cvtpk(v1[0], v1[1]); w.w = cvtpk(v1[2], v1[3]);
                    *(u32x4*)(rowp + bj * 128) = w; } }
    }
};
struct EpiX1 {
    static constexpr bool PERM = true; EPI_NOSTATE
    const float* x; const float* mod; bf16_t* x1b;
    __device__ __forceinline__ void operator()(const f32x4 (&acc)[2][2][4][2], const pg8::Unit& u, int wr, int wc, int fr, int fq, const State& est) const {
        const int row0 = u.pm * 256 + wr * 64 + fr, col0 = u.pn * 256 + wc * 32 + 8 * fq;
        const float* g1 = mod + (size_t)((u.pm * 256) / SEQ) * 12288 + 4096;
#pragma unroll
        for (int bj = 0; bj < 2; ++bj) { const int col = col0 + bj * 128; const f32x4 ga = *(const f32x4*)(g1 + col), gb = *(const f32x4*)(g1 + col + 4);
#pragma unroll
            for (int ai = 0; ai < 2; ++ai)
#pragma unroll
                for (int m = 0; m < 4; ++m) { const size_t off = (size_t)(row0 + ai * 128 + m * 16) * DM + col; const f32x4 xa = NT_LD((const f32x4*)(x + off)), xb = NT_LD((const f32x4*)(x + off + 4));
                    const f32x4 va = xa + ga * acc[ai][bj][m][0], vb = xb + gb * acc[ai][bj][m][1];
                    *(u32x4*)(x1b + off) = (u32x4){cvtpk(va.x, va.y), cvtpk(va.z, va.w), cvtpk(vb.x, vb.y), cvtpk(vb.z, vb.w)}; } }
    }
};
template <int NT, bool GATH>
struct MoeSched {
    static constexpr bool GATHER = GATH;
    const LAS int* tp; const int* cnt; const int* list; const char* A; const char* Bt; int K, first, stride, end;
    __device__ __forceinline__ bool next(int i, pg8::Unit& u) const {
        const int L = first + i * stride; if (L >= end) return false;
        const int tile = L / NT; u.pn = L % NT;
        const int e = __builtin_amdgcn_readfirstlane((int)((const LAS unsigned short*)(tp + 160))[tile]);
        u.e = e; u.mt = tile - tp[e]; u.pm = tile; return true;
    }
    __device__ __forceinline__ const char* a_base(const pg8::Unit& u) const { return GATH ? A : A + (size_t)u.pm * 256 * K * 2; }
    __device__ __forceinline__ const char* b_base(const pg8::Unit& u) const { return Bt + ((size_t)u.e * NT + u.pn) * 256 * K * 2; }
    __device__ __forceinline__ void a_off(const pg8::Unit& u, const int (&R)[2], const int (&C)[2], int K_, unsigned (&v)[2][2]) const {
        if (GATH) { const int n = cnt[u.e]; const int* lp = list + (size_t)u.e * T + u.mt * 256;
#pragma unroll
            for (int h = 0; h < 2; ++h)
#pragma unroll
                for (int i = 0; i < 2; ++i) { const int r = 128 * h + R[i]; const int tok = (u.mt * 256 + r < n) ? (lp[r] >> 1) : 0; v[h][i] = (unsigned)(tok * K_ + C[i]) * 2u; }
        } else {
#pragma unroll
            for (int h = 0; h < 2; ++h)
#pragma unroll
                for (int i = 0; i < 2; ++i) v[h][i] = (unsigned)((128 * h + R[i]) * K_ + C[i]) * 2u;
        }
    }
};
struct EpiGateUp {
    static constexpr bool PERM = true; EPI_NOSTATE
    bf16_t* H;
    __device__ __forceinline__ void operator()(const f32x4 (&acc)[2][2][4][2], const pg8::Unit& u, int wr, int wc, int fr, int fq, const State& est) const {
        const int row0 = u.pm * 256 + wr * 64 + fr, col0 = u.pn * 128 + wc * 32 + 8 * fq;
#pragma unroll
        for (int ai = 0; ai < 2; ++ai)
#pragma unroll
            for (int m = 0; m < 4; ++m) { bf16_t* rowp = H + (size_t)(row0 + ai * 128 + m * 16) * 512 + col0;
                const f32x4 g0 = acc[ai][0][m][0], g1 = acc[ai][0][m][1], u0 = acc[ai][1][m][0], u1 = acc[ai][1][m][1];
                u32x4 w; w.x = cvtpk(fsilu(g0[0]) * u0[0], fsilu(g0[1]) * u0[1]); w.y = cvtpk(fsilu(g0[2]) * u0[2], fsilu(g0[3]) * u0[3]);
                w.z = cvtpk(fsilu(g1[0]) * u1[0], fsilu(g1[1]) * u1[1]); w.w = cvtpk(fsilu(g1[2]) * u1[2], fsilu(g1[3]) * u1[3]);
                *(u32x4*)rowp = w; }
    }
};
constexpr int L_G2T = 131072;
struct EpiDown {
    static constexpr bool PERM = true;
    struct State { unsigned pk[2][4]; int n; };
    bf16_t* Y; const int* cnt; const int* list; const float* listw; const bf16_t* x1; const LAS float* g2t;
    __device__ __forceinline__ void pre(State& st, const pg8::Unit& u, int wr, int fr) const {
        st.n = cnt[u.e]; const unsigned* lp = (const unsigned*)listw + (size_t)u.e * T + u.mt * 256;
#pragma unroll
        for (int ai = 0; ai < 2; ++ai)
#pragma unroll
            for (int m = 0; m < 4; ++m) st.pk[ai][m] = lp[ai * 128 + wr * 64 + m * 16 + fr];
    }
    __device__ __forceinline__ void operator()(const f32x4 (&acc)[2][2][4][2], const pg8::Unit& u, int wr, int wc, int fr, int fq, const State& st) const {
        const int col0 = u.pn * 256 + wc * 32 + 8 * fq;
        unsigned pkv[2][4];
#pragma unroll
        for (int ai = 0; ai < 2; ++ai)
#pragma unroll
            for (int m = 0; m < 4; ++m) pkv[ai][m] = (u.mt * 256 + ai * 128 + wr * 64 + m * 16 + fr < st.n) ? st.pk[ai][m] : 0xFFFFu;
        u32x4 xr[2][4][2];
#pragma unroll
        for (int ai = 0; ai < 2; ++ai)
#pragma unroll
            for (int m = 0; m < 4; ++m) { const unsigned dst = pkv[ai][m] & 0xffffu; const bool s0 = (dst & 1u) == 0u;
#pragma unroll
                for (int bj = 0; bj < 2; ++bj) xr[ai][m][bj] = s0 ? NT_LD((const u32x4*)(x1 + (size_t)(dst >> 1) * DM + col0 + bj * 128)) : (u32x4){0u, 0u, 0u, 0u}; }
        __builtin_amdgcn_sched_barrier(0);
#pragma unroll
        for (int ai = 0; ai < 2; ++ai)
#pragma unroll
            for (int m = 0; m < 4; ++m) { const unsigned pk = pkv[ai][m]; const unsigned dst = pk & 0xffffu;
                if (dst != 0xFFFFu) { const float gw = bfhi(pk); bf16_t* rowp = Y + (size_t)dst * DM + col0; const LAS float* g2 = g2t + ((dst >> 1) >= (unsigned)SEQ ? 2048 : 0) + col0;
#pragma unroll
                    for (int bj = 0; bj < 2; ++bj) { const f32x4 ga = *(const LAS f32x4*)(g2 + bj * 128) * gw, gb = *(const LAS f32x4*)(g2 + bj * 128 + 4) * gw; const u32x4 x = xr[ai][m][bj];
                        const f32x4 v0 = (f32x4){bflo(x.x), bfhi(x.x), bflo(x.y), bfhi(x.y)} + acc[ai][bj][m][0] * ga, v1 = (f32x4){bflo(x.z), bfhi(x.z), bflo(x.w), bfhi(x.w)} + acc[ai][bj][m][1] * gb;
                        u32x4 w; w.x = cvtpk(v0[0], v0[1]); w.y = cvtpk(v0[2], v0[3]); w.z = cvtpk(v1[0], v1[1]); w.w = cvtpk(v1[2], v1[3]);
                        *(u32x4*)(rowp + bj * 128) = w; } } }
    }
};

constexpr int L_KWT = 0, L_VT = 36864, L_QS = 73728, L_KS = 107520, L_PS = 141312, L_F = 150528;
constexpr int L_WEXP = L_F, L_MT = L_F + 256, L_EI = L_F + 512, L_RDN = L_F + 768, L_BT = L_F + 1024, L_WK = L_F + 1280, L_NS = L_F + 1536, L_RSS = L_F + 2560, L_MCH = L_F + 4608, L_RN = L_F + 5248, L_GW = L_F + 5504, L_GA = L_GW + 1024, L_GB = L_GA + 1024, L_AL = L_GB + 1024;
static_assert(L_AL + 16 <= L_CTL, "mixer LDS map");

#define MLSTM_LOAD_RAW(cc) do { const int c_ = (cc), r0c_ = b * SEQ + c_ * 64, dp_ = tid & 127, tg_ = tid >> 7, d0_ = 2 * dp_, s0_ = 16 * tg_, tt0_ = c_ * 64 + s0_; \
          if (FULL) { _Pragma("unroll") for (int q = 0; q < 16; ++q) rawk[q] = NT_LD((const unsigned*)((const bf16_t*)(ws + WS_KC) + (size_t)(r0c_ + s0_ + q) * 1024 + h * 256 + d0_)); } \
          else { _Pragma("unroll") for (int q = 0; q < 19; ++q) { const int ti = tt0_ - 3 + q; rawk[q] = ti >= 0 ? *(const unsigned*)(PROJ + (size_t)(r0c_ + s0_ - 3 + q) * NPROJ + 1024 + h * 256 + d0_) : 0u; } } \
          (void)tt0_; } while (0)
#define MLSTM_LOAD_RAWV(cc) do { const int c_ = (cc), r0c_ = b * SEQ + c_ * 64, dp_ = tid & 127, tg_ = tid >> 7, d0_ = 2 * dp_, s0_ = 16 * tg_; \
          _Pragma("unroll") for (int q = 0; q < 16; ++q) rawv[q] = FULL ? NT_LD((const unsigned*)(PROJ + (size_t)(r0c_ + s0_ + q) * NPROJ + 2048 + h * 256 + d0_)) : *(const unsigned*)(PROJ + (size_t)(r0c_ + s0_ + q) * NPROJ + 2048 + h * 256 + d0_); } while (0)
#define MLSTM_LOAD_RAWQ(cc) do { const int c_ = (cc), r0c_ = b * SEQ + c_ * 64, dp_ = tid & 127, tg_ = tid >> 7, d0_ = 2 * dp_, s0_ = 16 * tg_, tt0_ = c_ * 64 + s0_; \
          _Pragma("unroll") for (int q = 0; q < 19; ++q) { const int ti = tt0_ - 3 + q; rawq[q] = ti >= 0 ? NT_LD((const unsigned*)(PROJ + (size_t)(r0c_ + s0_ - 3 + q) * NPROJ + h * 256 + d0_)) : 0u; } } while (0)
template <bool FULL>
__device__ __forceinline__ void mlstm_unit(const Args& a, LAS unsigned char* lds, int bh, int j) {
    int tid_o0 = threadIdx.x; asm volatile("" : "+v"(tid_o0));
    const int tid = tid_o0, lane = tid & 63, wave = __builtin_amdgcn_readfirstlane(tid >> 6), hh = lane >> 5, l31 = lane & 31;
    const int b = bh >> 2, h = bh & 3;
    unsigned char* ws = a.ws;
    const bf16_t* PROJ = (const bf16_t*)(ws + WS_PROJ);
    const float* BLAST = (const float*)(ws + WS_BLAST); const float* ALAST = (const float*)(ws + WS_ALAST);
    LAS float* mch = (LAS float*)(lds + L_MCH); LAS float* nsv = (LAS float*)(lds + L_NS);
    LAS float* WEXP = (LAS float*)(lds + L_WEXP); LAS float* MT = (LAS float*)(lds + L_MT); LAS float* EI = (LAS float*)(lds + L_EI); LAS float* RDN = (LAS float*)(lds + L_RDN);
    LAS float* BT = (LAS float*)(lds + L_BT); LAS float* WK = (LAS float*)(lds + L_WK); LAS float* RSS = (LAS float*)(lds + L_RSS); LAS float* RN = (LAS float*)(lds + L_RN);
    const int unit = bh * 32 + j;
    __syncthreads();
    float pa = 0.f, pb = 0.f, la_ = 0.f, lb_ = 0.f;
    if (wave == 0) { pa = BLAST[bh * 128 + 2 * lane]; pb = BLAST[bh * 128 + 2 * lane + 1]; la_ = ALAST[bh * 128 + 2 * lane]; lb_ = ALAST[bh * 128 + 2 * lane + 1]; }
    float nsv_v = 0.f, gw_v = 0.f, ga_v = 0.f, gb_v = 0.f, al_v = 0.f;
    if (tid < 256) { const int row = b * SEQ + j * 256 + tid;
        if (FULL && j > 0) nsv_v = ((const float*)(ws + WS_LNS))[(size_t)(unit - 1) * 256 + tid];
        gw_v = ((const float*)(ws + WS_GTW))[row * 4 + h]; ga_v = ((const float*)(ws + WS_GTA))[row * 4 + h]; gb_v = ((const float*)(ws + WS_GTB))[row * 4 + h]; }
    if (tid < 4) al_v = ALAST[bh * 128 + 4 * j + tid];
    u32x2 craw[8][4];
    if (FULL && j > 0) {
        const bf16_t* st = (const bf16_t*)(ws + WS_LST) + (size_t)(unit - 1) * 65536;
#pragma unroll
        for (int dt = 0; dt < 8; ++dt)
#pragma unroll
            for (int q = 0; q < 4; ++q) craw[dt][q] = NT_LD((const u32x2*)(st + ((dt * 4 + q) * 512 + tid) * 4));
    }
    __builtin_amdgcn_sched_barrier(0);
    if (wave == 0) {
        const float qa = la_ + pa, qb = lb_ + pb;
        float P = pa + pb, Q = fmaxf(qa + pb, qb);
#pragma unroll
        for (int o = 1; o < 64; o <<= 1) { const float oP = __shfl_up(P, o), oQ = __shfl_up(Q, o); if (lane >= o) { Q = fmaxf(oQ + P, Q); P = oP + P; } }
        float eP = __shfl_up(P, 1), eQ = __shfl_up(Q, 1); if (lane == 0) { eP = 0.f; eQ = -INFINITY; }
        const float m0 = fmaxf(eP, eQ), m1 = fmaxf(m0 + pa, qa);
        mch[2 * lane] = m0; mch[2 * lane + 1] = m1;
    }
    if (tid < 256) { nsv[tid] = nsv_v; ((LAS float*)(lds + L_GW))[tid] = gw_v; ((LAS float*)(lds + L_GA))[tid] = ga_v; ((LAS float*)(lds + L_GB))[tid] = gb_v; }
    if (tid < 4) ((LAS float*)(lds + L_AL))[tid] = al_v;
    __builtin_amdgcn_sched_barrier(0);
    f32x16 C[8];
    if (FULL && j > 0) {
#pragma unroll
        for (int dt = 0; dt < 8; ++dt)
#pragma unroll
            for (int q = 0; q < 4; ++q) { const u32x2 v = craw[dt][q]; C[dt][4 * q] = bflo(v.x); C[dt][4 * q + 1] = bfhi(v.x); C[dt][4 * q + 2] = bflo(v.y); C[dt][4 * q + 3] = bfhi(v.y); }
    } else {
#pragma unroll
        for (int dt = 0; dt < 8; ++dt)
#pragma unroll
            for (int r = 0; r < 16; ++r) C[dt][r] = 0.f;
    }
    float dtot_log = 0.f;
    unsigned rawk[19], rawv[16], rawq[19];
    if (!FULL) { const int c = 4 * j; MLSTM_LOAD_RAW(c); }
    __syncthreads();
#pragma unroll 1
    for (int i = 0; i < 4; ++i) {
        int tid_o = threadIdx.x; asm volatile("" : "+v"(tid_o));
        const int tid = tid_o, lane = tid & 63, hh = lane >> 5, l31 = lane & 31;
        const int c = 4 * j + i; const int r0c = b * SEQ + c * 64;
        const float mc = mch[c]; const float M63 = fmaxf(mc, ((const LAS float*)(lds + L_AL))[i]); const float decay = __expf(mc - M63);
        dtot_log += mc - M63;
        if (FULL) { MLSTM_LOAD_RAW(c); } MLSTM_LOAD_RAWV(c); if (FULL) MLSTM_LOAD_RAWQ(c);
        float cwk[4][2], cwq[4][2];
        { const float* cw = a.in[I_CONVQK]; const int d0 = 2 * (tid & 127);
#pragma unroll
          for (int q = 0; q < 4; ++q) { cwk[q][0] = cw[q * 2048 + 1024 + h * 256 + d0]; cwk[q][1] = cw[q * 2048 + 1024 + h * 256 + d0 + 1]; if (FULL) { cwq[q][0] = cw[q * 2048 + h * 256 + d0]; cwq[q][1] = cw[q * 2048 + h * 256 + d0 + 1]; } } }
        if (tid < 64) { const float w = ((const LAS float*)(lds + L_GW))[i * 64 + tid], am = ((const LAS float*)(lds + L_GA))[i * 64 + tid], bt = ((const LAS float*)(lds + L_GB))[i * 64 + tid];
            const float Mt = fmaxf(mc, am); WEXP[tid] = w; MT[tid] = Mt; EI[tid] = __expf(mc - Mt); BT[tid] = bt; WK[tid] = __expf(w - M63); }
        __syncthreads();
        {
            const int dp = tid & 127, tg = tid >> 7, d0 = 2 * dp, s0 = 16 * tg;
            const int tt0 = c * 64 + s0;
            const float* cw = a.in[I_CONVQK];
            {
                const float (&w)[4][2] = cwk;
                const unsigned (&raw)[19] = rawk;
                unsigned pa[8], pb[8]; float ka = 0.f, kb = 0.f;
#pragma unroll
                for (int s = 0; s < 16; ++s) { float x0 = 0.f, x1 = 0.f;
                    if (FULL) { x0 = bflo(raw[s]); x1 = bfhi(raw[s]); *(LAS unsigned*)(lds + L_KS + (s0 + s) * 528 + d0 * 2) = raw[s]; }
                    else {
#pragma unroll
                        for (int q = 0; q < 4; ++q) { x0 += w[q][0] * bflo(raw[s + q]); x1 += w[q][1] * bfhi(raw[s + q]); }
                        x0 = fsilu(x0) * 0.0625f; x1 = fsilu(x1) * 0.0625f;
                        const unsigned pk_ = cvtpk(x0, x1); *(unsigned*)((bf16_t*)(ws + WS_KC) + (size_t)(r0c + s0 + s) * 1024 + h * 256 + d0) = pk_;
                        x0 = bflo(pk_); x1 = bfhi(pk_); }
                    const float wk = WK[s0 + s]; x0 *= wk; x1 *= wk;
                    if (s & 1) { pa[s >> 1] = cvtpk(ka, x0); pb[s >> 1] = cvtpk(kb, x1); } else { ka = x0; kb = x1; } }
                *(LAS u32x4*)(lds + L_KWT + d0 * 144 + s0 * 2) = (u32x4){pa[0], pa[1], pa[2], pa[3]}; *(LAS u32x4*)(lds + L_KWT + d0 * 144 + s0 * 2 + 16) = (u32x4){pa[4], pa[5], pa[6], pa[7]};
                *(LAS u32x4*)(lds + L_KWT + (d0 + 1) * 144 + s0 * 2) = (u32x4){pb[0], pb[1], pb[2], pb[3]}; *(LAS u32x4*)(lds + L_KWT + (d0 + 1) * 144 + s0 * 2 + 16) = (u32x4){pb[4], pb[5], pb[6], pb[7]};
            }
            __builtin_amdgcn_sched_barrier(0);
            {
                const unsigned (&raw)[16] = rawv;
                unsigned pa[8], pb[8];
#pragma unroll
                for (int q = 0; q < 8; ++q) { pa[q] = (raw[2 * q] & 0xffffu) | (raw[2 * q + 1] << 16); pb[q] = (raw[2 * q] >> 16) | (raw[2 * q + 1] & 0xffff0000u); }
                *(LAS u32x4*)(lds + L_VT + d0 * 144 + s0 * 2) = (u32x4){pa[0], pa[1], pa[2], pa[3]}; *(LAS u32x4*)(lds + L_VT + d0 * 144 + s0 * 2 + 16) = (u32x4){pa[4], pa[5], pa[6], pa[7]};
                *(LAS u32x4*)(lds + L_VT + (d0 + 1) * 144 + s0 * 2) = (u32x4){pb[0], pb[1], pb[2], pb[3]}; *(LAS u32x4*)(lds + L_VT + (d0 + 1) * 144 + s0 * 2 + 16) = (u32x4){pb[4], pb[5], pb[6], pb[7]};
            }
            __builtin_amdgcn_sched_barrier(0);
            if (FULL) {
                const float (&w)[4][2] = cwq;
                const unsigned (&raw)[19] = rawq;
#pragma unroll
                for (int s = 0; s < 16; ++s) { float x0 = 0.f, x1 = 0.f;
#pragma unroll
                    for (int q = 0; q < 4; ++q) { x0 += w[q][0] * bflo(raw[s + q]); x1 += w[q][1] * bfhi(raw[s + q]); }
                    *(LAS unsigned*)(lds + L_QS + (s0 + s) * 528 + d0 * 2) = cvtpk(fsilu(x0), fsilu(x1)); }
            }
        }
        __syncthreads();
        if (FULL) {
            {
                const int tr = wave >> 1, tc0 = 2 * (wave & 1), fr = lane & 15, fq = lane >> 4;
                f32x4 s0 = {0.f, 0.f, 0.f, 0.f}, s1 = {0.f, 0.f, 0.f, 0.f};
#pragma unroll
                for (int ks = 0; ks < 8; ++ks) {
                    const bf16x8 af = *(const LAS bf16x8*)(lds + L_QS + (16 * tr + fr) * 528 + (32 * ks + 8 * fq) * 2);
                    const bf16x8 b0 = *(const LAS bf16x8*)(lds + L_KS + (16 * tc0 + fr) * 528 + (32 * ks + 8 * fq) * 2);
                    const bf16x8 b1 = *(const LAS bf16x8*)(lds + L_KS + (16 * (tc0 + 1) + fr) * 528 + (32 * ks + 8 * fq) * 2);
                    s0 = __builtin_amdgcn_mfma_f32_16x16x32_bf16(af, b0, s0, 0, 0, 0); s1 = __builtin_amdgcn_mfma_f32_16x16x32_bf16(af, b1, s1, 0, 0, 0);
                }
                const float we0 = WEXP[16 * tc0 + fr], we1 = WEXP[16 * (tc0 + 1) + fr];
#pragma unroll
                for (int r = 0; r < 4; ++r) { const int t = 16 * tr + 4 * fq + r; const float Mt = MT[t];
                    { const int s = 16 * tc0 + fr; const float ex = __expf(fminf(we0 - Mt, 0.f)); const float p = (s <= t) ? s0[r] * ex : 0.f; *(LAS bf16_t*)(lds + L_PS + t * 144 + s * 2) = (bf16_t)cvtpk(p, 0.f); }
                    { const int s = 16 * (tc0 + 1) + fr; const float ex = __expf(fminf(we1 - Mt, 0.f)); const float p = (s <= t) ? s1[r] * ex : 0.f; *(LAS bf16_t*)(lds + L_PS + t * 144 + s * 2) = (bf16_t)cvtpk(p, 0.f); } }
            }
            __syncthreads();
            u32x4 oreg[4];
#pragma unroll
            for (int q = 0; q < 4; ++q) { const int idx = q * 512 + tid, t = idx >> 5, ch = idx & 31; oreg[q] = NT_LD((const u32x4*)(PROJ + (size_t)(r0c + t) * NPROJ + 3072 + h * 256 + ch * 8)); }
            {
                const int t = tid >> 3, p = tid & 7;
                const u32x4 pv = *(const LAS u32x4*)(lds + L_PS + t * 144 + p * 16);
                float sp = (bflo(pv.x) + bfhi(pv.x)) + (bflo(pv.y) + bfhi(pv.y)) + (bflo(pv.z) + bfhi(pv.z)) + (bflo(pv.w) + bfhi(pv.w));
                float qn = 0.f;
#pragma unroll
                for (int q = 0; q < 4; ++q) { const u32x4 qv = *(const LAS u32x4*)(lds + L_QS + t * 528 + (32 * p + 8 * q) * 2); const LAS float* np = nsv + 32 * p + 8 * q;
                    qn += bflo(qv.x) * np[0] + bfhi(qv.x) * np[1] + bflo(qv.y) * np[2] + bfhi(qv.y) * np[3] + bflo(qv.z) * np[4] + bfhi(qv.z) * np[5] + bflo(qv.w) * np[6] + bfhi(qv.w) * np[7]; }
                sp += __shfl_xor(sp, 1); sp += __shfl_xor(sp, 2); sp += __shfl_xor(sp, 4);
                qn += __shfl_xor(qn, 1); qn += __shfl_xor(qn, 2); qn += __shfl_xor(qn, 4);
                if (p == 0) { const float den = sp + EI[t] * qn; RDN[t] = frcp(fmaxf(fabsf(den), __expf(-(BT[t] + MT[t])))); }
            }
            f32x16 nacc[2];
#pragma unroll
            for (int tt = 0; tt < 2; ++tt)
#pragma unroll
                for (int r = 0; r < 16; ++r) nacc[tt][r] = 0.f;
#pragma unroll
            for (int dt = 0; dt < 8; ++dt)
#pragma unroll
                for (int sp = 0; sp < 2; ++sp) {
                    __builtin_amdgcn_sched_barrier(0);
                    bf16x8 bfr; { u32x4 t4; t4.x = cvtpk(C[dt][8 * sp + 0], C[dt][8 * sp + 1]); t4.y = cvtpk(C[dt][8 * sp + 2], C[dt][8 * sp + 3]); t4.z = cvtpk(C[dt][8 * sp + 4], C[dt][8 * sp + 5]); t4.w = cvtpk(C[dt][8 * sp + 6], C[dt][8 * sp + 7]); bfr = __builtin_bit_cast(bf16x8, t4); }
#pragma unroll
                    for (int tt = 0; tt < 2; ++tt) {
                        const u32x2 lo = *(const LAS u32x2*)(lds + L_QS + (32 * tt + l31) * 528 + (32 * dt + 16 * sp + 4 * hh) * 2);
                        const u32x2 hi = *(const LAS u32x2*)(lds + L_QS + (32 * tt + l31) * 528 + (32 * dt + 16 * sp + 8 + 4 * hh) * 2);
                        const u32x4 a4 = {lo.x, lo.y, hi.x, hi.y};
                        nacc[tt] = __builtin_amdgcn_mfma_f32_32x32x16_bf16(__builtin_bit_cast(bf16x8, a4), bfr, nacc[tt], 0, 0, 0);
                    }
                }
#pragma unroll
            for (int tt = 0; tt < 2; ++tt)
#pragma unroll
                for (int r = 0; r < 16; ++r) nacc[tt][r] *= EI[32 * tt + (r & 3) + 8 * (r >> 2) + 4 * hh];
#pragma unroll
            for (int ks = 0; ks < 4; ++ks) {
                __builtin_amdgcn_sched_barrier(0);
                const bf16x8 bfr = *(const LAS bf16x8*)(lds + L_VT + (32 * wave + l31) * 144 + (16 * ks + 8 * hh) * 2);
#pragma unroll
                for (int tt = 0; tt < 2; ++tt) { const bf16x8 afr = *(const LAS bf16x8*)(lds + L_PS + (32 * tt + l31) * 144 + (16 * ks + 8 * hh) * 2);
                    nacc[tt] = __builtin_amdgcn_mfma_f32_32x32x16_bf16(afr, bfr, nacc[tt], 0, 0, 0); }
            }
#pragma unroll
            for (int q = 0; q < 4; ++q) { const int idx = q * 512 + tid, t = idx >> 5, ch = idx & 31; *(LAS u32x4*)(lds + L_KS + t * 528 + ch * 16) = oreg[q]; }
            __syncthreads();
#pragma unroll
            for (int tt = 0; tt < 2; ++tt)
#pragma unroll
                for (int r = 0; r < 16; ++r) { const int t = 32 * tt + (r & 3) + 8 * (r >> 2) + 4 * hh; const float hv = nacc[tt][r] * RDN[t]; nacc[tt][r] = hv;
                    const float q = half_sum31(hv * hv);
                    if (l31 == 31) RSS[wave * 64 + t] = q; }
            __syncthreads();
            if (tid < 64) { float q = 0.f;
#pragma unroll
                for (int w = 0; w < 8; ++w) q += RSS[w * 64 + tid];
                RN[tid] = rsqrtf(q * (1.f / 256.f) + EPS); }
            __syncthreads();
            {
                const int e = 32 * wave + l31; const float g = a.in[I_MHG][h * 256 + e];
#pragma unroll
                for (int tt = 0; tt < 2; ++tt)
#pragma unroll
                    for (int r = 0; r < 16; ++r) { const int t = 32 * tt + (r & 3) + 8 * (r >> 2) + 4 * hh;
                        const float o = bf1(*(const LAS bf16_t*)(lds + L_KS + t * 528 + e * 2));
                        *(LAS bf16_t*)(lds + L_QS + t * 528 + e * 2) = (bf16_t)cvtpk(nacc[tt][r] * RN[t] * g * fsigmoid(o), 0.f); }
            }
            __syncthreads();
            {
                bf16_t* ymr = (bf16_t*)(ws + WS_HN);
#pragma unroll
                for (int q = 0; q < 4; ++q) { const int idx = q * 512 + tid, t = idx >> 5, ch = idx & 31;
                    *(u32x4*)(ymr + (size_t)(r0c + t) * DM + h * 256 + ch * 8) = *(const LAS u32x4*)(lds + L_QS + t * 528 + ch * 16); }
            }
        }
        if (!FULL && i < 3) { MLSTM_LOAD_RAW(c + 1); }
#pragma unroll
        for (int dt = 0; dt < 8; ++dt)
#pragma unroll
            for (int r = 0; r < 16; ++r) C[dt][r] *= decay;
#pragma unroll
        for (int ks = 0; ks < 4; ++ks) {
            __builtin_amdgcn_sched_barrier(0);
            const bf16x8 bfr = *(const LAS bf16x8*)(lds + L_VT + (32 * wave + l31) * 144 + (16 * ks + 8 * hh) * 2);
#pragma unroll
            for (int dt = 0; dt < 8; ++dt) { const bf16x8 afr = *(const LAS bf16x8*)(lds + L_KWT + (32 * dt + l31) * 144 + (16 * ks + 8 * hh) * 2);
                C[dt] = __builtin_amdgcn_mfma_f32_32x32x16_bf16(afr, bfr, C[dt], 0, 0, 0); }
        }
        if (tid < 256) { float sk = 0.f;
#pragma unroll
            for (int q = 0; q < 8; ++q) { const u32x4 kv = *(const LAS u32x4*)(lds + L_KWT + tid * 144 + q * 16); sk += (bflo(kv.x) + bfhi(kv.x)) + (bflo(kv.y) + bfhi(kv.y)) + (bflo(kv.z) + bfhi(kv.z)) + (bflo(kv.w) + bfhi(kv.w)); }
            nsv[tid] = decay * nsv[tid] + sk; }
        __syncthreads();
    }
    if (!FULL) {
        bf16_t* st = (bf16_t*)(ws + WS_LST) + (size_t)unit * 65536;
#pragma unroll
        for (int dt = 0; dt < 8; ++dt)
#pragma unroll
            for (int q = 0; q < 4; ++q) *(u32x2*)(st + ((dt * 4 + q) * 512 + tid) * 4) = (u32x2){cvtpk(C[dt][4 * q], C[dt][4 * q + 1]), cvtpk(C[dt][4 * q + 2], C[dt][4 * q + 3])};
        if (tid < 256) ((float*)(ws + WS_LNS))[(size_t)unit * 256 + tid] = nsv[tid];
        if (tid == 0) ((float*)(ws + WS_DTOT))[unit] = __expf(dtot_log);
    }
}

constexpr int L_XS = 0, L_SEG = 69632, L_WL = L_SEG + 16384;
static_assert(L_WL + 2 * 128 * 272 <= L_CTL, "lru LDS map");
__device__ __forceinline__ void lru_unit(const Args& a, LAS unsigned char* lds, int b, int j, int n, bool load_w) {
    int tid_o = threadIdx.x; asm volatile("" : "+v"(tid_o));
    const int tid = tid_o, lane = tid & 63, wave = __builtin_amdgcn_readfirstlane(tid >> 6), hh = lane >> 5, l31 = lane & 31;
    unsigned char* ws = a.ws;
    const bf16_t* PROJ = (const bf16_t*)(ws + WS_PROJ);
    const int r0 = b * SEQ + j * 256, c0 = n * 128;
    const int unit = (b * 32 + j) * 8 + n;
    LAS float* SEG = (LAS float*)(lds + L_SEG);
    __syncthreads();
    u32x4 wl[8];
    if (load_w) { const bf16_t* WL = (const bf16_t*)(ws + WS_WLRU) + (size_t)n * 2 * 128 * 128;
#pragma unroll
        for (int q = 0; q < 8; ++q) { const int idx = q * 512 + tid, row = idx >> 4, ch = idx & 15;
            wl[q] = *(const u32x4*)(WL + (size_t)row * 128 + ch * 8); }
    }
    {
        const int cp = tid & 63, tg = tid >> 6, c = 2 * cp, s0 = 32 * tg;
        const float* cw = a.in[I_LCW]; const float* cb = a.in[I_LCB];
        float w[4][2];
#pragma unroll
        for (int q = 0; q < 4; ++q) { w[q][0] = cw[q * 1024 + c0 + c]; w[q][1] = cw[q * 1024 + c0 + c + 1]; }
        const float b0 = cb[c0 + c], b1 = cb[c0 + c + 1];
        unsigned raw[35];
#pragma unroll
        for (int q = 0; q < 35; ++q) { const int ti = j * 256 + s0 - 3 + q; raw[q] = ti >= 0 ? NT_LD((const unsigned*)(PROJ + (size_t)(r0 + s0 - 3 + q) * NPROJ + 4096 + c0 + c)) : 0u; }
        __builtin_amdgcn_sched_barrier(0);
        if (load_w) {
#pragma unroll
            for (int q = 0; q < 8; ++q) { const int idx = q * 512 + tid, row = idx >> 4, ch = idx & 15; *(LAS u32x4*)(lds + L_WL + row * 272 + ch * 16) = wl[q]; }
        }
#pragma unroll
        for (int s = 0; s < 32; ++s) { float x0 = b0, x1 = b1;
#pragma unroll
            for (int q = 0; q < 4; ++q) { x0 += w[q][0] * bflo(raw[s + q]); x1 += w[q][1] * bfhi(raw[s + q]); }
            *(LAS unsigned*)(lds + L_XS + (s0 + s) * 272 + c * 2) = cvtpk(x0, x1); }
    }
    __syncthreads();
    float gba[4], gbx[4], glam[4];
#pragma unroll
    for (int nt = 0; nt < 4; ++nt) { const int c = c0 + 32 * nt + l31; gba[nt] = a.in[I_BLA][c]; gbx[nt] = a.in[I_BLX][c]; glam[nt] = a.in[I_LAM][c]; }
    f32x16 ar[4], ai[4];
#pragma unroll
    for (int nt = 0; nt < 4; ++nt)
#pragma unroll
        for (int r = 0; r < 16; ++r) { ar[nt][r] = 0.f; ai[nt][r] = 0.f; }
    {
        const int tau = 16 * ((l31 >> 2) & 1) + 4 * (l31 >> 3) + (l31 & 3);
#pragma unroll
        for (int ks = 0; ks < 8; ++ks) {
            const bf16x8 afr = *(const LAS bf16x8*)(lds + L_XS + (32 * wave + tau) * 272 + (16 * ks + 8 * hh) * 2);
#pragma unroll
            for (int nt = 0; nt < 4; ++nt) {
                const bf16x8 br = *(const LAS bf16x8*)(lds + L_WL + (32 * nt + l31) * 272 + (16 * ks + 8 * hh) * 2);
                const bf16x8 bi = *(const LAS bf16x8*)(lds + L_WL + (128 + 32 * nt + l31) * 272 + (16 * ks + 8 * hh) * 2);
                ar[nt] = __builtin_amdgcn_mfma_f32_32x32x16_bf16(afr, br, ar[nt], 0, 0, 0); ai[nt] = __builtin_amdgcn_mfma_f32_32x32x16_bf16(afr, bi, ai[nt], 0, 0, 0);
            }
        }
    }
#pragma unroll
    for (int nt = 0; nt < 4; ++nt) {
        __builtin_amdgcn_sched_barrier(0);
        const int d = 32 * nt + l31;
        const float ba = gba[nt], bx = gbx[nt], lsl = flogsigmoid(glam[nt]);
        float A = 1.f, H = 0.f;
#pragma unroll
        for (int r = 0; r < 16; ++r) {
            const int t = 32 * wave + 16 * hh + r;
            const float rg = fsigmoid(ar[nt][r] + ba), ig = fsigmoid(ai[nt][r] + bx);
            const float la = 8.f * rg * lsl; const float av = __expf(la);
            const float xr = bf1(*(const LAS bf16_t*)(lds + L_XS + t * 272 + d * 2));
            const float x2 = 2.f * la; const float om = (x2 > -0.02f) ? -x2 * (1.f + x2 * (0.5f + x2 * (1.f / 6.f))) : 1.f - av * av;
            const float u = __builtin_amdgcn_sqrtf(om) * (ig * xr);
            ar[nt][r] = av; ai[nt][r] = u;
            A *= av; H = av * H + u;
        }
        SEG[((2 * wave + hh) * 128 + d) * 2] = A; SEG[((2 * wave + hh) * 128 + d) * 2 + 1] = H;
    }
    __syncthreads();
    if (tid < 128) {
        float hc = 0.f, At = 1.f;
#pragma unroll
        for (int sg = 0; sg < 16; ++sg) { const float A = SEG[(sg * 128 + tid) * 2], H = SEG[(sg * 128 + tid) * 2 + 1]; SEG[(sg * 128 + tid) * 2] = hc; SEG[(sg * 128 + tid) * 2 + 1] = At; hc = A * hc + H; At *= A; }
        ((float*)(ws + WS_LRUA))[(size_t)unit * 128 + tid] = At; ((float*)(ws + WS_LRUH))[(size_t)unit * 128 + tid] = hc;
    }
    __syncthreads();
#pragma unroll 1
    for (int round = 0; round < 2; ++round) {
#pragma unroll
        for (int nt = 0; nt < 4; ++nt) { const int d = 32 * nt + l31;
            float v = SEG[((2 * wave + hh) * 128 + d) * 2 + round];
#pragma unroll
            for (int r = 0; r < 16; ++r) { const int t = 32 * wave + 16 * hh + r;
                v = round ? v * ar[nt][r] : ar[nt][r] * v + ai[nt][r];
                *(LAS bf16_t*)(lds + L_XS + t * 272 + d * 2) = (bf16_t)cvtpk(v, 0.f); } }
        __syncthreads();
        bf16_t* dstb = (bf16_t*)(ws + (round ? WS_ACUM : WS_HLOC));
#pragma unroll
        for (int q = 0; q < 8; ++q) { const int idx = q * 512 + tid, t = idx >> 4, ch = idx & 15;
            *(u32x4*)(dstb + (size_t)(r0 + t) * 1024 + c0 + ch * 8) = *(const LAS u32x4*)(lds + L_XS + t * 272 + ch * 16); }
        __syncthreads();
    }
}
__device__ __forceinline__ void lru_out_unit(const Args& a, int b, int j, int n) {
    int tid_o = threadIdx.x; asm volatile("" : "+v"(tid_o));
    const int tid = tid_o, d8 = tid & 15;
    unsigned char* ws = a.ws;
    const bf16_t* PROJ = (const bf16_t*)(ws + WS_PROJ); const bf16_t* HL = (const bf16_t*)(ws + WS_HLOC); const bf16_t* AC = (const bf16_t*)(ws + WS_ACUM);
    const int r0 = b * SEQ + j * 256, c0 = n * 128 + 8 * d8;
    const float* cp = (const float*)(ws + WS_LRUC) + (size_t)(b * 32 + j) * 1024 + c0; const float* gp = a.in[I_LNG] + c0;
    const f32x4 ca = *(const f32x4*)cp, cb = *(const f32x4*)(cp + 4), ga = *(const f32x4*)gp, gb = *(const f32x4*)(gp + 4);
    u32x4 hl[8], ac[8], gr[8];
#pragma unroll
    for (int q = 0; q < 8; ++q) { const size_t t = (size_t)(r0 + (tid >> 4) + 32 * q);
        hl[q] = NT_LD((const u32x4*)(HL + t * 1024 + c0)); ac[q] = NT_LD((const u32x4*)(AC + t * 1024 + c0)); gr[q] = NT_LD((const u32x4*)(PROJ + t * NPROJ + 5120 + c0)); }
    bf16_t* ymr = (bf16_t*)(ws + WS_HN);
#pragma unroll
    for (int q = 0; q < 8; ++q) { const size_t t = (size_t)(r0 + (tid >> 4) + 32 * q);
        f32x4 ya = (f32x4){bflo(hl[q].x), bfhi(hl[q].x), bflo(hl[q].y), bfhi(hl[q].y)} + (f32x4){bflo(ac[q].x), bfhi(ac[q].x), bflo(ac[q].y), bfhi(ac[q].y)} * ca;
        f32x4 yb = (f32x4){bflo(hl[q].z), bfhi(hl[q].z), bflo(hl[q].w), bfhi(hl[q].w)} + (f32x4){bflo(ac[q].z), bfhi(ac[q].z), bflo(ac[q].w), bfhi(ac[q].w)} * cb;
        ya = ya * (f32x4){fgelu_tanh(bflo(gr[q].x)), fgelu_tanh(bfhi(gr[q].x)), fgelu_tanh(bflo(gr[q].y)), fgelu_tanh(bfhi(gr[q].y))};
        yb = yb * (f32x4){fgelu_tanh(bflo(gr[q].z)), fgelu_tanh(bfhi(gr[q].z)), fgelu_tanh(bflo(gr[q].w)), fgelu_tanh(bfhi(gr[q].w))};
        float ss = (ya.x * ya.x + ya.y * ya.y) + (ya.z * ya.z + ya.w * ya.w) + (yb.x * yb.x + yb.y * yb.y) + (yb.z * yb.z + yb.w * yb.w);
        ss += __shfl_xor(ss, 1); ss += __shfl_xor(ss, 2); ss += __shfl_xor(ss, 4); ss += __shfl_xor(ss, 8);
        const float rn = rsqrtf(ss * (1.f / 128.f) + EPS);
        ya = ya * rn * ga; yb = yb * rn * gb;
        *(u32x4*)(ymr + t * DM + 1024 + c0) = (u32x4){cvtpk(ya.x, ya.y), cvtpk(ya.z, ya.w), cvtpk(yb.x, yb.y), cvtpk(yb.z, yb.w)}; }
}

__device__ __forceinline__ void mixer_scan(const Args& a, int vcu, int G) {
    unsigned char* ws = a.ws; int tid_o = threadIdx.x; asm volatile("" : "+v"(tid_o)); const int tid = tid_o;
    const float* DT = (const float*)(ws + WS_DTOT);
    if (tid < 256) for (int g = vcu * 256 + tid; g < 65536; g += G * 256) {
        const int bh = g >> 13, i8 = g & 8191; bf16_t* base = (bf16_t*)(ws + WS_LST) + (size_t)bh * 32 * 65536 + (size_t)i8 * 8;
        f32x4 Sa = {0.f, 0.f, 0.f, 0.f}, Sb = {0.f, 0.f, 0.f, 0.f}; u32x4 Lr[31];
#pragma unroll
        for (int j = 0; j < 31; ++j) Lr[j] = NT_LD((const u32x4*)(base + (size_t)j * 65536));
        float dj[31];
#pragma unroll
        for (int j = 0; j < 31; ++j) dj[j] = DT[bh * 32 + j];
#pragma unroll
        for (int j = 0; j < 31; ++j) { const float d = dj[j]; const u32x4 L = Lr[j];
            Sa = d * Sa + (f32x4){bflo(L.x), bfhi(L.x), bflo(L.y), bfhi(L.y)}; Sb = d * Sb + (f32x4){bflo(L.z), bfhi(L.z), bflo(L.w), bfhi(L.w)};
            *(u32x4*)(base + (size_t)j * 65536) = (u32x4){cvtpk(Sa.x, Sa.y), cvtpk(Sa.z, Sa.w), cvtpk(Sb.x, Sb.y), cvtpk(Sb.z, Sb.w)}; }
    }
    if ((tid >> 6) == 5) for (int task = vcu; task < 72; task += G) { const int bb = task / 36, n = task % 36, lane = tid & 63; const float* sh2 = (const float*)(ws + WS_MOD) + (size_t)bb * 12288 + 6144;
        float sh[32], wv[32];
#pragma unroll
        for (int q = 0; q < 32; ++q) { const int k = lane + 64 * q; sh[q] = sh2[k]; wv[q] = n < 4 ? a.in[I_WGRP][k * 4 + n] : a.in[I_WRT][k * 32 + (n - 4)]; }
        float p = 0.f;
#pragma unroll
        for (int q = 0; q < 32; ++q) p += sh[q] * wv[q];
        p = wave_sum(p);
        if (lane == 0) ((float*)(ws + WS_CVEC))[bb * 48 + n] = p + (n < 4 ? a.in[I_BGRP][n] : a.in[I_BRT][n - 4]); }
    if (tid >= 264 && tid < 266) for (int g = vcu * 2 + (tid - 264); g < 8 * 64; g += G * 2) {
        const int bh = g >> 6, i4 = g & 63; float* base = (float*)(ws + WS_LNS) + (size_t)bh * 32 * 256 + (size_t)i4 * 4;
        f32x4 S = {0.f, 0.f, 0.f, 0.f};
        f32x4 Lv[31]; float dv[31];
#pragma unroll
        for (int j = 0; j < 31; ++j) { Lv[j] = *(const f32x4*)(base + (size_t)j * 256); dv[j] = DT[bh * 32 + j]; }
#pragma unroll
        for (int j = 0; j < 31; ++j) { S = dv[j] * S + Lv[j]; *(f32x4*)(base + (size_t)j * 256) = S; }
    }
    if (tid >= 256 && tid < 264) for (int g = vcu * 8 + (tid - 256); g < 2048; g += G * 8) {
        const int b = g >> 10, ch = g & 1023, n = ch >> 7, d = ch & 127; float hc = 0.f;
        const float* LA = (const float*)(ws + WS_LRUA); const float* LH = (const float*)(ws + WS_LRUH); float* LC = (float*)(ws + WS_LRUC);
        float la[32], lh[32];
#pragma unroll
        for (int j = 0; j < 32; ++j) { const size_t u = (size_t)((b * 32 + j) * 8 + n) * 128 + d; la[j] = LA[u]; lh[j] = LH[u]; }
#pragma unroll
        for (int j = 0; j < 32; ++j) { LC[(size_t)(b * 32 + j) * 1024 + ch] = hc; hc = la[j] * hc + lh[j]; }
    }
}

__device__ __forceinline__ void p5_hn2_route(const Args& a, LAS unsigned char* lds, int vcu, int G) {
    int tid_o = threadIdx.x; asm volatile("" : "+v"(tid_o));
    const int tid = tid_o, lane = tid & 63, wave = __builtin_amdgcn_readfirstlane(tid >> 6), fr = lane & 15, kq = lane >> 4;
    unsigned char* ws = a.ws;
    int par = 0;
    const float* mod = (const float*)(ws + WS_MOD); const float* cvec = (const float*)(ws + WS_CVEC);
    const bf16_t* WRH = (const bf16_t*)(ws + WS_WRH); const bf16_t* WRL = (const bf16_t*)(ws + WS_WRL);
    int* cnt = (int*)(ws + WS_CTL); int* list = (int*)(ws + WS_LIST); float* route = (float*)(ws + WS_ROUTE);
    for (int task = vcu; task < T / 32; task += G) {
        int lane_o = tid_o & 63; asm volatile("" : "+v"(lane_o));
        const int lane = lane_o, fr = lane & 15, kq = lane >> 4;
        const int row0 = task * 32, b = row0 / SEQ;
        const float* sh2 = mod + (size_t)b * 12288 + 6144; const float* sc2 = mod + (size_t)b * 12288 + 8192;
        LAS unsigned char* lb = lds + (par ? 65536 : 0); par ^= 1;
        LAS float* part = (LAS float*)lb;
        LAS float* rstds = (LAS float*)(lb + 49152);
        LAS float* lgs = (LAS float*)(lb + 49152 + 128);
        const bf16_t* X1 = (const bf16_t*)(ws + WS_X1B);
        f32x4 acc[2][3];
#pragma unroll
        for (int rt = 0; rt < 2; ++rt)
#pragma unroll
            for (int nt = 0; nt < 3; ++nt) acc[rt][nt] = (f32x4){0.f, 0.f, 0.f, 0.f};
        {
            u32x4 xb[8][2];
#pragma unroll
            for (int st = 0; st < 8; ++st)
#pragma unroll
                for (int rt = 0; rt < 2; ++rt) xb[st][rt] = *(const u32x4*)(X1 + (size_t)(row0 + 16 * rt + fr) * DM + 256 * wave + 32 * st + 8 * kq);
            bf16x8 Bhs[3][3], Bls[3][3]; f32x4 s0s[3], s1s[3];
#define RT_LOADB(set, stp) do { const int c0_ = 256 * wave + 32 * (stp) + 8 * kq; s0s[set] = *(const f32x4*)(sc2 + c0_); s1s[set] = *(const f32x4*)(sc2 + c0_ + 4); \
                _Pragma("unroll") for (int nt = 0; nt < 3; ++nt) { const int fo_ = (((wave * 8 + (stp)) * 3 + nt) * 64 + lane) * 8; Bhs[set][nt] = *(const bf16x8*)(WRH + fo_); Bls[set][nt] = *(const bf16x8*)(WRL + fo_); } } while (0)
            RT_LOADB(0, 0); RT_LOADB(1, 1);
#pragma unroll
            for (int st = 0; st < 8; ++st) {
                __builtin_amdgcn_sched_barrier(0);
                if (st < 6) RT_LOADB((st + 2) % 3, st + 2);
                const f32x4 s0 = s0s[st % 3] + 1.f, s1 = s1s[st % 3] + 1.f;
                bf16x8 Ah[2], Al[2];
#pragma unroll
                for (int rt = 0; rt < 2; ++rt) {
                    const u32x4 r4 = xb[st][rt];
                    const f32x4 x0 = (f32x4){bflo(r4.x), bfhi(r4.x), bflo(r4.y), bfhi(r4.y)} * s0, x1 = (f32x4){bflo(r4.z), bfhi(r4.z), bflo(r4.w), bfhi(r4.w)} * s1;
                    u32x4 h; h.x = cvtpk(x0.x, x0.y); h.y = cvtpk(x0.z, x0.w); h.z = cvtpk(x1.x, x1.y); h.w = cvtpk(x1.z, x1.w);
                    u32x4 l; l.x = cvtpk(x0.x - bflo(h.x), x0.y - bfhi(h.x)); l.y = cvtpk(x0.z - bflo(h.y), x0.w - bfhi(h.y)); l.z = cvtpk(x1.x - bflo(h.z), x1.y - bfhi(h.z)); l.w = cvtpk(x1.z - bflo(h.w), x1.w - bfhi(h.w));
                    Ah[rt] = __builtin_bit_cast(bf16x8, h); Al[rt] = __builtin_bit_cast(bf16x8, l);
                }
#pragma unroll
                for (int nt = 0; nt < 3; ++nt) {
                    const bf16x8 Bh = Bhs[st % 3][nt], Bl = Bls[st % 3][nt];
#pragma unroll
                    for (int rt = 0; rt < 2; ++rt) {
                        acc[rt][nt] = __builtin_amdgcn_mfma_f32_16x16x32_bf16(Ah[rt], Bh, acc[rt][nt], 0, 0, 0);
                        acc[rt][nt] = __builtin_amdgcn_mfma_f32_16x16x32_bf16(Al[rt], Bh, acc[rt][nt], 0, 0, 0);
                        acc[rt][nt] = __builtin_amdgcn_mfma_f32_16x16x32_bf16(Ah[rt], Bl, acc[rt][nt], 0, 0, 0);
                    }
                }
            }
        }
#undef RT_LOADB
        __builtin_amdgcn_sched_barrier(0);
        {
            u32x4 v[4][4]; float rs[4];
#pragma unroll
            for (int r = 0; r < 4; ++r)
#pragma unroll
                for (int jj = 0; jj < 4; ++jj) v[r][jj] = NT_LD((const u32x4*)(X1 + (size_t)(row0 + wave * 4 + r) * DM + 8 * lane + 512 * jj));
#pragma unroll
            for (int r = 0; r < 4; ++r) { float ssum = 0.f;
#pragma unroll
                for (int jj = 0; jj < 4; ++jj) { const u32x4 q = v[r][jj]; const float a0 = bflo(q.x), a1 = bfhi(q.x), a2 = bflo(q.y), a3 = bfhi(q.y), a4 = bflo(q.z), a5 = bfhi(q.z), a6 = bflo(q.w), a7 = bfhi(q.w);
                    ssum += ((a0 * a0 + a1 * a1) + (a2 * a2 + a3 * a3)) + ((a4 * a4 + a5 * a5) + (a6 * a6 + a7 * a7)); }
                rs[r] = rsqrtf(wave_sum(ssum) * (1.f / DM) + EPS); if (lane == 0) rstds[wave * 4 + r] = rs[r]; }
#pragma unroll
            for (int jj = 0; jj < 4; ++jj) { __builtin_amdgcn_sched_barrier(0);
                const f32x4 sha = *(const f32x4*)(sh2 + 8 * lane + 512 * jj), shb = *(const f32x4*)(sh2 + 8 * lane + 512 * jj + 4);
                const f32x4 sca = *(const f32x4*)(sc2 + 8 * lane + 512 * jj) + 1.f, scb = *(const f32x4*)(sc2 + 8 * lane + 512 * jj + 4) + 1.f;
#pragma unroll
                for (int r = 0; r < 4; ++r) { const u32x4 q = v[r][jj];
                    const f32x4 ha = (f32x4){bflo(q.x), bfhi(q.x), bflo(q.y), bfhi(q.y)} * rs[r] * sca + sha, hb = (f32x4){bflo(q.z), bfhi(q.z), bflo(q.w), bfhi(q.w)} * rs[r] * scb + shb;
                    *(u32x4*)((bf16_t*)(ws + WS_HN) + (size_t)(row0 + wave * 4 + r) * DM + 8 * lane + 512 * jj) = (u32x4){cvtpk(ha.x, ha.y), cvtpk(ha.z, ha.w), cvtpk(hb.x, hb.y), cvtpk(hb.z, hb.w)}; } }
        }
#pragma unroll
        for (int rt = 0; rt < 2; ++rt)
#pragma unroll
            for (int nt = 0; nt < 3; ++nt)
#pragma unroll
                for (int r = 0; r < 4; ++r) part[(wave * 32 + 16 * rt + 4 * kq + r) * 48 + 16 * nt + fr] = acc[rt][nt][r];
        __syncthreads();
        for (int idx = tid; idx < 32 * 36; idx += 512) { const int r = idx / 36, n = idx % 36; float q = 0.f;
#pragma unroll
            for (int w = 0; w < 8; ++w) q += part[(w * 32 + r) * 48 + n];
            lgs[r * 40 + n] = rstds[r] * q + cvec[b * 48 + n]; }
        __syncthreads();
        if (tid < 32) {
            const int t = row0 + tid; const LAS float* lg = lgs + tid * 40;
            int g = 0; float mx = lg[0];
#pragma unroll
            for (int i = 1; i < 4; ++i) { const float x = lg[i]; if (x > mx) { mx = x; g = i; } }
            float sg = 0.f;
#pragma unroll
            for (int i = 0; i < 4; ++i) sg += __expf(lg[i] - mx);
            const float pg = 1.f / sg;
            int e0 = 0; float m0 = lg[4 + g * 8];
            for (int i = 1; i < 8; ++i) { const float x = lg[4 + g * 8 + i]; if (x > m0) { m0 = x; e0 = i; } }
            int e1 = -1; float m1 = -INFINITY;
            for (int i = 0; i < 8; ++i) { const float x = lg[4 + g * 8 + i]; if (i != e0 && x > m1) { m1 = x; e1 = i; } }
            const float x1 = __expf(m1 - m0); const float w0 = pg / (1.f + x1), w1 = pg * x1 / (1.f + x1);
            const int E0 = g * 8 + e0, E1 = g * 8 + e1;
            *(f32x4*)(route + (size_t)t * 4) = (f32x4){w0, w1, (float)E0, (float)E1};
            LAS int* lcnt = (LAS int*)(lb + 49152 + 128 + 5120); LAS int* lbase = lcnt + 32;
            lcnt[tid] = 0;
            LDS_WAIT(); asm volatile("" ::: "memory");
            const int rk0 = __hip_atomic_fetch_add(lcnt + E0, 1, __ATOMIC_RELAXED, __HIP_MEMORY_SCOPE_WORKGROUP);
            const int rk1 = __hip_atomic_fetch_add(lcnt + E1, 1, __ATOMIC_RELAXED, __HIP_MEMORY_SCOPE_WORKGROUP);
            LDS_WAIT(); asm volatile("" ::: "memory");
            const int lc = lcnt[tid];
            lbase[tid] = lc ? atomicAdd(&cnt[tid], lc) : 0;
            LDS_WAIT(); asm volatile("" ::: "memory");
            float* listw = (float*)(ws + WS_LISTW);
            { const size_t p0 = (size_t)E0 * T + lbase[E0] + rk0, p1 = (size_t)E1 * T + lbase[E1] + rk1;
              list[p0] = t * 2; list[p1] = t * 2 + 1;
              ((unsigned*)listw)[p0] = (cvtpk(0.f, w0) & 0xffff0000u) | (unsigned)(t * 2); ((unsigned*)listw)[p1] = (cvtpk(0.f, w1) & 0xffff0000u) | (unsigned)(t * 2 + 1); }
        }
    }
}

__device__ __forceinline__ void p9_final(const Args& a, int vcu, int G, float* dstbase) {
    int tid_o = threadIdx.x; asm volatile("" : "+v"(tid_o));
    const int tid = tid_o, lane = tid & 63, wave = __builtin_amdgcn_readfirstlane(tid >> 6);
    unsigned char* ws = a.ws; const float* mod = (const float*)(ws + WS_MOD); const bf16_t* YS = (const bf16_t*)(ws + WS_YS);
    const bf16_t* X1 = (const bf16_t*)(ws + WS_X1B);
    for (int rp = vcu * 8 + wave; rp < T / 2; rp += G * 8) {
        const int b = (2 * rp) / SEQ; const float* g2 = mod + (size_t)b * 12288 + 10240;
        u32x4 y0[2][4], y1[2][4];
#pragma unroll
        for (int q = 0; q < 2; ++q)
#pragma unroll
            for (int jj = 0; jj < 4; ++jj) { const int row = 2 * rp + q; y0[q][jj] = NT_LD((const u32x4*)(YS + (size_t)(2 * row) * DM + 8 * lane + 512 * jj)); y1[q][jj] = NT_LD((const u32x4*)(YS + (size_t)(2 * row + 1) * DM + 8 * lane + 512 * jj)); }
#pragma unroll
        for (int q = 0; q < 2; ++q) {
            const int row = 2 * rp + q; f32x4 v[4][2]; float s = 0.f;
#pragma unroll
            for (int jj = 0; jj < 4; ++jj) { const u32x4 p0 = y0[q][jj], p1 = y1[q][jj];
                v[jj][0] = (f32x4){bflo(p0.x) + bflo(p1.x), bfhi(p0.x) + bfhi(p1.x), bflo(p0.y) + bflo(p1.y), bfhi(p0.y) + bfhi(p1.y)};
                v[jj][1] = (f32x4){bflo(p0.z) + bflo(p1.z), bfhi(p0.z) + bfhi(p1.z), bflo(p0.w) + bflo(p1.w), bfhi(p0.w) + bfhi(p1.w)};
#pragma unroll
                for (int z = 0; z < 2; ++z) s += (v[jj][z].x * v[jj][z].x + v[jj][z].y * v[jj][z].y) + (v[jj][z].z * v[jj][z].z + v[jj][z].w * v[jj][z].w); }
            const float rstd = rsqrtf(wave_sum(s) * (1.f / DM) + EPS);
#pragma unroll
            for (int jj = 0; jj < 4; ++jj) { const f32x4 fa = *(const f32x4*)(a.in[I_FG] + 8 * lane + 512 * jj), fb = *(const f32x4*)(a.in[I_FG] + 8 * lane + 512 * jj + 4);
                float* dr = dstbase + (size_t)row * DM + 8 * lane + 512 * jj; NT_ST(v[jj][0] * rstd * fa, (f32x4*)dr); NT_ST(v[jj][1] * rstd * fb, (f32x4*)(dr + 4)); }
        }
    }
}
}
namespace fk {
#define XB_TMO      128
#define XB_XCNT(j)  (256  + 64 * (j))
#define XB_XSUB(j)  (1280 + 64 * (j))
#define XB_XGEN(j)  (2304 + 64 * (j))
#define XB_TOP      3328
#define XB_TOPGEN   3392
#define XCD_BAR_WORDS 3456
#define XB_SPIN_CAP (1u << 18)

__device__ __forceinline__ unsigned xb_ld(unsigned* p)              { return __hip_atomic_load(p, __ATOMIC_RELAXED, __HIP_MEMORY_SCOPE_AGENT); }
__device__ __forceinline__ unsigned xb_add(unsigned* p, unsigned v) { return __hip_atomic_fetch_add(p, v, __ATOMIC_RELAXED, __HIP_MEMORY_SCOPE_AGENT); }
__device__ __forceinline__ unsigned xb_xcc_id() { return (unsigned)__builtin_amdgcn_s_getreg((3 << 11) | 20) & 0xFu; }
#define XB_SPIN(cond, bar) do { unsigned _sp = 0; while (cond) { __builtin_amdgcn_s_sleep(1); \
    if ((++_sp & 255u) == 0u) { if (xb_ld(&(bar)[XB_TMO])) break; if (_sp > XB_SPIN_CAP) { atomicAdd(&(bar)[XB_TMO], 1u); break; } } } } while (0)

struct XcdBarrier {
    unsigned* bar; unsigned x;
    volatile LAS unsigned* st;
};

__device__ __forceinline__ XcdBarrier xcd_barrier_post(unsigned* bar, volatile LAS unsigned* st) {
    XcdBarrier b; b.bar = bar; b.x = xb_xcc_id(); b.st = st;
    if (threadIdx.x == 0) (void)xb_add(&bar[XB_XCNT(b.x)], 1u);
    return b;
}
__device__ __forceinline__ void xcd_barrier_complete(unsigned* bar, unsigned x, unsigned& nloc, unsigned& nx) {
    const unsigned G = gridDim.x * gridDim.y * gridDim.z;
    unsigned sum, cnt, mine, sp = 0u;
    for (;;) {
        sum = 0u; cnt = 0u; mine = 0u;
#pragma unroll
        for (unsigned j = 0; j < 16; ++j) { const unsigned c = xb_ld(&bar[XB_XCNT(j)]); sum += c; cnt += (c > 0u) ? 1u : 0u; mine = (j == x) ? c : mine; }
        if (sum == G) break;
        __builtin_amdgcn_s_sleep(1);
        if ((++sp & 255u) == 0u) { if (xb_ld(&bar[XB_TMO])) break; if (sp > XB_SPIN_CAP) { atomicAdd(&bar[XB_TMO], 1u); break; } }
    }
    nloc = mine > 0u ? mine : 1u; nx = cnt > 0u ? cnt : 1u;
}

__device__ __forceinline__ void xcd_barrier(const XcdBarrier& b) {
    asm volatile("s_waitcnt vmcnt(0)" ::: "memory");
    __syncthreads();
    if (threadIdx.x == 0) {
        unsigned* bar = b.bar;
        __builtin_amdgcn_s_waitcnt(0);
        unsigned nloc = b.st[0], nx = b.st[1];
        if (nloc == 0u) { xcd_barrier_complete(bar, b.x, nloc, nx); b.st[0] = nloc; b.st[1] = nx; }
        const unsigned old = xb_add(&bar[XB_XSUB(b.x)], 1u);
        const unsigned gen = old / nloc;
        if (old + 1u == (gen + 1u) * nloc) {
            __builtin_amdgcn_fence(__ATOMIC_RELEASE, "agent");
            asm volatile("s_waitcnt vmcnt(0)" ::: "memory");
            const unsigned og = xb_add(&bar[XB_TOP], 1u);
            const unsigned tg = og / nx;
            if (og + 1u == (tg + 1u) * nx) xb_add(&bar[XB_TOPGEN], 1u);
            else XB_SPIN(xb_ld(&bar[XB_TOPGEN]) == tg, bar);
            __builtin_amdgcn_fence(__ATOMIC_ACQUIRE, "agent");
            xb_add(&bar[XB_XGEN(b.x)], 1u);
            asm volatile("s_waitcnt vmcnt(0)" ::: "memory");
        } else {
            XB_SPIN(xb_ld(&bar[XB_XGEN(b.x)]) == gen, bar);
            __builtin_amdgcn_fence(__ATOMIC_ACQUIRE, "agent");
            asm volatile("s_waitcnt vmcnt(0)" ::: "memory");
        }
    }
    __syncthreads();
}
}
namespace fk {
constexpr int NPHASE = 11;
#ifndef NCONV
#define NCONV 36
#endif
#ifndef CONV_ITEMS
#define CONV_ITEMS 20320
#endif
__global__ void __launch_bounds__(512, 2) fwd(Args a) {
    extern __shared__ __attribute__((aligned(16))) unsigned char lds_raw[];
    LAS unsigned char* lds = (LAS unsigned char*)lds_raw;
    const int G = gridDim.x, bx = blockIdx.x, tid = threadIdx.x;
    const int vcu = (G % 8 == 0) ? (bx % 8) * (G / 8) + bx / 8 : bx;
    const int lo = a.ph_lo, hi = a.ph_hi;
    unsigned char* ws = a.ws;
    volatile LAS unsigned* bst = (volatile LAS unsigned*)(lds + L_CTL + 512);
    if (tid < 2) bst[tid] = 0u;
    __syncthreads();
    XcdBarrier bar; bar.bar = (unsigned*)(ws + WS_BAR); bar.x = 0; bar.st = bst;
    if (hi - lo > 1) bar = xcd_barrier_post((unsigned*)(ws + WS_BAR), bst);
#ifndef PH_ONLY
#define PH_ONLY -1
#endif
#define IN(k) ((PH_ONLY < 0 || PH_ONLY == (k)) && lo <= (k) && (k) < hi)
#define GSYNC() xcd_barrier(bar)
#define SYNC(k) do { if (IN(k) && IN((k) + 1)) GSYNC(); } while (0)
#ifndef REP_PHASE
#define REP_PHASE -1
#endif
#ifndef REP_SKIPL
#define REP_SKIPL 0
#endif
#define REP(k) _Pragma("unroll 1") for (int rep_ = 0; rep_ < ((REP_PHASE == (k)) ? 2 : 1); ++rep_)
#define RSYNC() do { if (rep_) GSYNC(); } while (0)
    const int nconv = (G == 256 && IN(0) && IN(2)) ? NCONV : 0;
    REP(0) { RSYNC(); if (IN(0)) { p0_prologue(a, lds, vcu, G, nconv); } } SYNC(0);
    REP(1) { RSYNC(); if (IN(1)) { p1_hn_gates(a, lds, vcu, G); } } SYNC(1);
    REP(2) { RSYNC(); if (IN(2)) {
        const int it_mid = nconv ? TR_EARLY + CONV_ITEMS : TR_ALL;
        if (bx < G - nconv) { const bool early = (bx & 7) < 4;
            if (nconv && early && !rep_) { p2_convert(a, lds, bx * 8 + (tid >> 6), (G - nconv) * 8, it_mid, TR_ALL); __syncthreads(); }
            DenseSched S; S.init(ws + WS_HN, ws + WS_WIN, T, NPROJ, DM, G - nconv, bx); EpiProj E{(bf16_t*)(ws + WS_PROJ), NPROJ}; pg8::gemm_phase<EpiProj, DenseSched>(lds, DM, S, E);
            if (nconv && !early && !rep_) p2_convert(a, lds, bx * 8 + (tid >> 6), (G - nconv) * 8, it_mid, TR_ALL); }
        else if (!rep_) { p2_convert(a, lds, (bx - (G - nconv)) * 8 + (tid >> 6), nconv * 8, TR_EARLY, it_mid);
#ifdef CONV_DUP
            p2_convert(a, lds, (bx - (G - nconv)) * 8 + (tid >> 6), nconv * 8, TR_EARLY, it_mid);
#endif
        }
    } } SYNC(2);
    REP(34) { RSYNC(); REP(3) { RSYNC(); if (IN(3)) {
                 if ((vcu & 1) && !(REP_SKIPL && rep_)) { for (int u = vcu, pn_ = -1; u < 512; u += G) { lru_unit(a, lds, u >> 8, (u >> 3) & 31, u & 7, (u & 7) != pn_); pn_ = u & 7; } }
                 for (int u = vcu; u < 256; u += G) mlstm_unit<false>(a, lds, u >> 5, u & 31);
                 if (!(vcu & 1) && !(REP_SKIPL && rep_)) { for (int u = vcu, pn_ = -1; u < 512; u += G) { lru_unit(a, lds, u >> 8, (u >> 3) & 31, u & 7, (u & 7) != pn_); pn_ = u & 7; } }
    } } SYNC(3);
    if (IN(4)) { mixer_scan(a, vcu, G); } } SYNC(4);
    REP(5) { RSYNC(); if (IN(5)) {
                 if (vcu & 1) { for (int u = vcu; u < 512; u += G) lru_out_unit(a, u >> 8, (u >> 3) & 31, u & 7); }
                 for (int u = vcu; u < 256; u += G) mlstm_unit<true>(a, lds, u >> 5, u & 31);
                 if (!(vcu & 1)) { for (int u = vcu; u < 512; u += G) lru_out_unit(a, u >> 8, (u >> 3) & 31, u & 7); }
    } } SYNC(5);
    REP(6) { RSYNC(); if (IN(6)) { __syncthreads(); DenseSched S; S.init(ws + WS_HN, ws + WS_WOUT, T, DM, DM, G, bx); EpiX1 E{a.in[I_X], (const float*)(ws + WS_MOD), (bf16_t*)(ws + WS_X1B)}; pg8::gemm_phase<EpiX1, DenseSched>(lds, DM, S, E); } } SYNC(6);
    REP(7) { if (rep_) { GSYNC(); if (bx == 0 && tid < 32) ((int*)(ws + WS_CTL))[tid] = 0; GSYNC(); }
        if (IN(7)) { p5_hn2_route(a, lds, vcu, G); } } SYNC(7);
    if (IN(8) || IN(9)) {
        LAS int* tp = (LAS int*)(lds + L_CTL); const int* cnt = (const int*)(ws + WS_CTL);
        __syncthreads();
        for (int i = tid; i < 4096; i += 512) ((LAS float*)(lds + L_G2T))[i] = ((const float*)(ws + WS_MOD))[(size_t)(i >> 11) * 12288 + 10240 + (i & 2047)];
        if (tid == 0) { int s = 0; for (int e = 0; e < 32; ++e) { tp[e] = s; s += (cnt[e] + 255) >> 8; } tp[32] = s; }
        __syncthreads();
        if (tid < 192) { int e = 0; for (int q = 1; q < 32; ++q) e += (tp[q] <= tid) ? 1 : 0; ((LAS unsigned short*)(tp + 160))[tid] = (unsigned short)e; }
        __syncthreads();
    }
    if (IN(8)) { const LAS int* tp = (const LAS int*)(lds + L_CTL); const int nGU = tp[32] * 4, R = nGU / G, rem = nGU - R * G, Ne = G - rem;
        { MoeSched<4, true> S{tp, (const int*)(ws + WS_CTL), (const int*)(ws + WS_LIST), (const char*)(ws + WS_HN), (const char*)(ws + WS_WGU), DM, vcu, G, R * G};
          EpiGateUp E{(bf16_t*)(ws + WS_HEXP)}; pg8::gemm_phase<EpiGateUp, MoeSched<4, true>>(lds, DM, S, E); }
        if (rem > 0) {
            GSYNC();
            if (vcu < rem) { MoeSched<4, true> S{tp, (const int*)(ws + WS_CTL), (const int*)(ws + WS_LIST), (const char*)(ws + WS_HN), (const char*)(ws + WS_WGU), DM, R * G + vcu, G, nGU};
                EpiGateUp E{(bf16_t*)(ws + WS_HEXP)}; pg8::gemm_phase<EpiGateUp, MoeSched<4, true>>(lds, DM, S, E); }
            else if (R >= 1) { MoeSched<8, false> S{tp, (const int*)(ws + WS_CTL), (const int*)(ws + WS_LIST), (const char*)(ws + WS_HEXP), (const char*)(ws + WS_WDN), 512, vcu - rem, Ne, 2 * Ne};
                EpiDown E{(bf16_t*)(ws + WS_YS), (const int*)(ws + WS_CTL), (const int*)(ws + WS_LIST), (const float*)(ws + WS_LISTW), (const bf16_t*)(ws + WS_X1B), (const LAS float*)(lds + L_G2T)}; pg8::gemm_phase<EpiDown, MoeSched<8, false>>(lds, 512, S, E); }
        }
    } SYNC(8);
    if (IN(9)) { const LAS int* tp = (const LAS int*)(lds + L_CTL); const int nGU = tp[32] * 4, R = nGU / G, rem = nGU - R * G, Ne = G - rem;
        MoeSched<8, false> S{tp, (const int*)(ws + WS_CTL), (const int*)(ws + WS_LIST), (const char*)(ws + WS_HEXP), (const char*)(ws + WS_WDN), 512, ((rem > 0 && R >= 1) ? 2 * Ne : 0) + vcu, G, tp[32] * 8};
        EpiDown E{(bf16_t*)(ws + WS_YS), (const int*)(ws + WS_CTL), (const int*)(ws + WS_LIST), (const float*)(ws + WS_LISTW), (const bf16_t*)(ws + WS_X1B), (const LAS float*)(lds + L_G2T)}; pg8::gemm_phase<EpiDown, MoeSched<8, false>>(lds, 512, S, E); } SYNC(9);
#if REP_PHASE == 10
    if (IN(10)) { p9_final(a, vcu, G, (float*)(ws + WS_WGU)); GSYNC(); }
#endif
#if REP_PHASE == 99
    for (int q = 0; q < 20; ++q) GSYNC();
#endif
    if (IN(10)) { p9_final(a, vcu, G, a.out); }
#undef IN
#undef SYNC
}

static int g_grid = 0;
static bool setup() {
    if (g_grid) return g_grid > 0;
    int dev = 0, cus = 0, per_cu = 0;
    if (hipGetDevice(&dev) != hipSuccess || hipDeviceGetAttribute(&cus, hipDeviceAttributeMultiprocessorCount, dev) != hipSuccess) { g_grid = -1; return false; }
    if (hipFuncSetAttribute((const void*)fwd, hipFuncAttributeMaxDynamicSharedMemorySize, LDS_BYTES) != hipSuccess) { fprintf(stderr, "hipFuncSetAttribute failed\n"); g_grid = -1; return false; }
    if (hipOccupancyMaxActiveBlocksPerMultiprocessor(&per_cu, (const void*)fwd, 512, LDS_BYTES) != hipSuccess || per_cu < 1) { fprintf(stderr, "occupancy query: %d\n", per_cu); (void)hipGetLastError(); g_grid = -1; return false; }
    g_grid = cus;
    return true;
}
static void run(void* const* d_in, float* out, unsigned char* ws, hipStream_t st, int lo, int hi, bool coop) {
    if (!setup()) return;
    (void)hipMemsetAsync(ws + WS_CTL, 0, CTL_ZERO_BYTES, st);
    Args a{};
    for (int i = 0; i < 25; ++i) a.in[i] = (const float*)d_in[i];
    a.out = out; a.ws = ws;
    if (coop) { a.ph_lo = lo; a.ph_hi = hi;
        hipLaunchKernelGGL(fwd, dim3(g_grid), dim3(512), LDS_BYTES, st, a);
    } else {
        for (int p = lo; p < hi; ++p) { a.ph_lo = p; a.ph_hi = p + 1; hipLaunchKernelGGL(fwd, dim3(g_grid), dim3(512), LDS_BYTES, st, a); }
    }
}
}
#ifndef DBG_STAGE
#define DBG_STAGE 0
#endif
#ifndef N_LAUNCHES
#define N_LAUNCHES 1
#endif
#if DBG_STAGE
namespace dbg {
template <typename TIn> __global__ void k_sample(const TIn* src, int ld, int col0, int ncols, int stride, float* dst) {
    const int i = blockIdx.x; const size_t row = (size_t)i * stride;
    for (int c = threadIdx.x; c < ncols; c += blockDim.x) { float v; if (sizeof(TIn) == 2) v = __builtin_bit_cast(float, (unsigned)(*(const unsigned short*)&src[row * ld + col0 + c]) << 16); else v = (float)(*(const float*)&src[row * ld + col0 + c]); dst[(size_t)i * ncols + c] = v; }
}
__global__ void k_cmp(const float* smp, int sld, int scol0, int n, int stride, const float* ref, int ldr, int rcol0, const float* rowscale, float* acc) {
    __shared__ float r0[256], r1[256];
    const int i = blockIdx.x; const size_t row = (size_t)i * stride; const float sc = rowscale ? rowscale[row] : 1.f;
    float d2 = 0.f, f2 = 0.f;
    for (int c = threadIdx.x; c < n; c += blockDim.x) { const float r = ref[row * ldr + rcol0 + c] * sc, s = smp[(size_t)i * sld + scol0 + c]; const float d = s - r; d2 += d * d; f2 += r * r; }
    r0[threadIdx.x] = d2; r1[threadIdx.x] = f2; __syncthreads();
    for (int o = 128; o > 0; o >>= 1) { if (threadIdx.x < o) { r0[threadIdx.x] += r0[threadIdx.x + o]; r1[threadIdx.x] += r1[threadIdx.x + o]; } __syncthreads(); }
    if (threadIdx.x == 0) { atomicAdd(&acc[0], r0[0]); atomicAdd(&acc[1], r1[0]); }
}
__global__ void k_scale(float* out, const float* acc, int nchk, int raw, float tol) {
    float delta = 0.f;
    if (raw >= 0) { const float e = sqrtf(acc[2 * raw] / fmaxf(acc[2 * raw + 1], 1e-30f)); delta = 4.f * fminf(e, 2.f); if (!(e == e)) delta = 9.f; }
    else for (int i = 0; i < nchk; ++i) { const float e = sqrtf(acc[2 * i] / fmaxf(acc[2 * i + 1], 1e-30f)); if (!(e <= tol)) { delta = 0.1f * (i + 1) + 0.05f * ((e == e) ? fminf(e, 1.f) : 1.f); break; } }
    const size_t idx = (size_t)blockIdx.x * blockDim.x + threadIdx.x;
    out[idx] *= (1.f + delta);
}
struct Ctx { unsigned char* ws; float* out; float* smp; float* acc; };
#ifndef DBG_RAW
#define DBG_RAW -1
#endif
#ifndef DBG_TOL
#define DBG_TOL 0.02f
#endif
constexpr size_t SM0 = 0, SM1 = 2 * 1024 * 1024 + 65536;
static void hook(int stage, void* vctx, hipStream_t st) {
    Ctx& c = *(Ctx*)vctx; unsigned char* ws = c.ws;
    const float* bufA = (const float*)(ws + nv::W_A); const float* proj = (const float*)(ws + nv::W_B); const float* ymr = (const float*)(ws + nv::W_C);
#if DBG_STAGE == 3
    if (stage == 2) k_cmp<<<964, 256, 0, st>>>(c.smp + SM0, 2048, 0, 2048, 17, bufA, 2048, 0, nullptr, c.acc + 0);
    if (stage == 3) { k_cmp<<<529, 256, 0, st>>>(c.smp + SM1, 6144, 0, 4096, 31, proj, nv::INW, 0, nullptr, c.acc + 2);
                      k_cmp<<<529, 256, 0, st>>>(c.smp + SM1, 6144, 4096, 2048, 31, proj, nv::INW, 4104, nullptr, c.acc + 4); }
#elif DBG_STAGE == 6
    if (stage == 6) { k_cmp<<<964, 256, 0, st>>>(c.smp + SM0, 2048, 0, 1024, 17, ymr, 2048, 0, nullptr, c.acc + 0);
                      k_cmp<<<964, 256, 0, st>>>(c.smp + SM0, 2048, 1024, 1024, 17, ymr, 2048, 1024, nullptr, c.acc + 2); }
#elif DBG_STAGE == 7
    if (stage == 7) k_cmp<<<964, 256, 0, st>>>(c.smp + SM0, 2048, 0, 2048, 17, c.out, 2048, 0, nullptr, c.acc + 0);
#elif DBG_STAGE == 8
    if (stage == 8) k_cmp<<<964, 256, 0, st>>>(c.smp + SM0, 2048, 0, 2048, 17, bufA, 2048, 0, nullptr, c.acc + 0);
    if (stage == 9) { k_cmp<<<964, 256, 0, st>>>(c.smp + SM1, 4, 0, 2, 17, (const float*)(ws + nv::W_R4), 4, 0, nullptr, c.acc + 2);
                      k_cmp<<<964, 256, 0, st>>>(c.smp + SM1, 4, 2, 2, 17, (const float*)(ws + nv::W_R4), 4, 2, nullptr, c.acc + 4); }
#elif DBG_STAGE == 10
    if (stage == 10) k_cmp<<<1928, 256, 0, st>>>(c.smp + SM0, 2048, 0, 2048, 17, proj + (size_t)4 * nv::T_ * 512, 2048, 0, (const float*)(ws + nv::W_GW), c.acc + 0);
#endif
}
}
#endif

extern "C" void kernel_launch(void* const* d_in, const int* in_sizes, int n_in, void* d_out, int out_size, void* d_ws, size_t ws_size, hipStream_t stream) {
    if (n_in != 25 || ws_size < fk::WS_END) { fprintf(stderr, "kernel_launch: unexpected n_in %d / ws_size %zu\n", n_in, ws_size); return; }
    unsigned char* ws = (unsigned char*)d_ws; float* out = (float*)d_out;
#if DBG_STAGE == 0
    fk::run(d_in, out, ws, stream, 0, fk::NPHASE, N_LAUNCHES == 1);
#else
    if (ws_size < nv::W_END + 24 * nv::MiB_) { fprintf(stderr, "debug build: ws too small\n"); return; }
    float* smp = (float*)(ws + ws_size - 24 * nv::MiB_); float* acc = smp + 6 * 1024 * 1024 - 64;
    (void)hipMemsetAsync(acc, 0, 256, stream);
#if DBG_STAGE == 3
    fk::run(d_in, out, ws, stream, 0, 3, N_LAUNCHES == 1);
    dbg::k_sample<unsigned short><<<964, 256, 0, stream>>>((const unsigned short*)(ws + fk::WS_HN), 2048, 0, 2048, 17, smp + dbg::SM0);
    dbg::k_sample<unsigned short><<<529, 256, 0, stream>>>((const unsigned short*)(ws + fk::WS_PROJ), 6144, 0, 6144, 31, smp + dbg::SM1);
    const int nchk = 3;
#elif DBG_STAGE == 6
    fk::run(d_in, out, ws, stream, 0, 6, N_LAUNCHES == 1);
    dbg::k_sample<unsigned short><<<964, 256, 0, stream>>>((const unsigned short*)(ws + fk::WS_HN), 2048, 0, 2048, 17, smp + dbg::SM0);
    const int nchk = 2;
#elif DBG_STAGE == 7
    fk::run(d_in, out, ws, stream, 0, 7, N_LAUNCHES == 1);
    dbg::k_sample<float><<<964, 256, 0, stream>>>(out, 2048, 0, 2048, 17, smp + dbg::SM0);
    const int nchk = 1;
#elif DBG_STAGE == 8
    fk::run(d_in, out, ws, stream, 0, 8, N_LAUNCHES == 1);
    dbg::k_sample<unsigned short><<<964, 256, 0, stream>>>((const unsigned short*)(ws + fk::WS_HN), 2048, 0, 2048, 17, smp + dbg::SM0);
    dbg::k_sample<float><<<964, 256, 0, stream>>>((const float*)(ws + fk::WS_ROUTE), 4, 0, 4, 17, smp + dbg::SM1);
    const int nchk = 3;
#elif DBG_STAGE == 10
    fk::run(d_in, out, ws, stream, 0, 10, N_LAUNCHES == 1);
    dbg::k_sample<unsigned short><<<1928, 256, 0, stream>>>((const unsigned short*)(ws + fk::WS_YS), 2048, 0, 2048, 17, smp + dbg::SM0);
    const int nchk = 1;
#endif
    nv::In I; { const float** p = (const float**)&I; for (int i = 0; i < 25; ++i) p[i] = (const float*)d_in[i]; }
    dbg::Ctx ctx{ws, out, smp, acc};
    nv::run(I, out, ws, stream, dbg::hook, &ctx);
    dbg::k_scale<<<(fk::T * fk::DM) / 256, 256, 0, stream>>>(out, acc, nchk, DBG_RAW, DBG_TOL);
#endif
}
```
